# Optimizing an MI355X kernel written in HIP

```python
import math
import jax, jax.numpy as jnp
from jax import lax
import numpy as np

D_MODEL = 1024
BATCH = 8
SEQ = 4096
DEPTH = 4

CTX_LEN = 256
GRID_W = 64
HEAD_DIM = 64
HY_WIDTH = D_MODEL // 4
GQA_HEADS = (D_MODEL // 2) // HEAD_DIM
GQA_KV_HEADS = 2
NA_HEADS = (D_MODEL // 4) // HEAD_DIM
NA_KH = 8
NA_KW = 16
Q_BLOCK = 128
ROPE_THETA = 10000.0
HY_EMB_DIM = 33
HY_FILTER_WIDTH = 64
HY_SHORT = 3
HY_DECAY_TARGET = 1e-2
HY_FAST_DECAY = 0.3
HY_SLOW_DECAY = 1.5
FFN_HIDDEN = int(math.ceil(8 * D_MODEL / 3 / 256)) * 256
NORM_EPS = 1e-6
ATTN_SCALE = HEAD_DIM ** -0.5

HY_COLS = 3 * HY_WIDTH
GQA_Q_COLS = GQA_HEADS * HEAD_DIM
GQA_KV_COLS = GQA_KV_HEADS * HEAD_DIM
NA_COLS = NA_HEADS * HEAD_DIM
IN_COLS = HY_COLS + GQA_Q_COLS + 2 * GQA_KV_COLS + 3 * NA_COLS
MIX_WIDTH = HY_WIDTH + GQA_Q_COLS + NA_COLS
SPLIT_POINTS = [int(v) for v in np.cumsum([HY_COLS, GQA_Q_COLS, GQA_KV_COLS, GQA_KV_COLS, NA_COLS, NA_COLS])]

kernel_name = 'hybrid_hyena_gqa_natten_dit'


def rms_norm(x, g):
    xf = x.astype(jnp.float32)
    y = xf * lax.rsqrt(jnp.mean(xf * xf, axis=-1, keepdims=True) + NORM_EPS)
    return (y * g.astype(jnp.float32)).astype(x.dtype)


def modulate(h, shift, scale):
    return h * (1 + scale) + shift


def axial_rope_tables(L):
    pos = jnp.arange(L)
    row = (pos // GRID_W).astype(jnp.float32)
    col = (pos % GRID_W).astype(jnp.float32)
    n_f = HEAD_DIM // 4
    inv = ROPE_THETA ** (-jnp.arange(n_f, dtype=jnp.float32) / n_f)
    ang = jnp.concatenate([row[:, None] * inv, col[:, None] * inv], axis=-1)
    return jnp.cos(ang), jnp.sin(ang)


def apply_rope(x, cos, sin):
    x1, x2 = jnp.split(x, 2, axis=-1)
    c = cos[None, :, None, :]
    s = sin[None, :, None, :]
    return jnp.concatenate([x1 * c - x2 * s, x1 * s + x2 * c], axis=-1).astype(x.dtype)


def split_proj(p):
    B, L, _ = p.shape
    hy, q, k, v, nq, nk, nv = jnp.split(p, SPLIT_POINTS, axis=-1)
    return (hy,
            q.reshape(B, L, GQA_HEADS, HEAD_DIM),
            k.reshape(B, L, GQA_KV_HEADS, HEAD_DIM),
            v.reshape(B, L, GQA_KV_HEADS, HEAD_DIM),
            nq.reshape(B, L, NA_HEADS, HEAD_DIM),
            nk.reshape(B, L, NA_HEADS, HEAD_DIM),
            nv.reshape(B, L, NA_HEADS, HEAD_DIM))


def attend(q, k, v):
    B, Lq, H, hd = q.shape
    kvh = k.shape[2]
    qg = q.reshape(B, Lq, kvh, H // kvh, hd)
    s = jnp.einsum('bqkgd,bskd->bkgqs', qg, k).astype(jnp.float32) * ATTN_SCALE
    p = jax.nn.softmax(s, axis=-1).astype(v.dtype)
    o = jnp.einsum('bkgqs,bskd->bqkgd', p, v)
    return o.reshape(B, Lq, H * hd)


def gqa_latent(q, k, v):
    B, S, H, hd = q.shape
    nb = S // Q_BLOCK
    qb = jnp.moveaxis(q.reshape(B, nb, Q_BLOCK, H, hd), 1, 0)
    o = lax.map(lambda qi: attend(qi, k, v), qb)
    return jnp.moveaxis(o, 0, 1).reshape(B, S, H * hd)


def natten_latent(q, k, v, kc, vc, rpb):
    B, S, H, hd = q.shape
    rows = S // GRID_W
    kh = min(NA_KH, rows)
    kw = NA_KW
    qg = q.reshape(B, rows, GRID_W, H, hd)
    kg = k.reshape(B, rows, GRID_W, H, hd)
    vg = v.reshape(B, rows, GRID_W, H, hd)
    cols = jnp.arange(GRID_W)
    cs = jnp.clip(cols - kw // 2, 0, GRID_W - kw)
    key_cols = cs[:, None] + jnp.arange(kw)[None, :]
    dcol = key_cols - cols[:, None] + (NA_KW - 1)

    def row_block(r):
        rs = jnp.clip(r - kh // 2, 0, rows - kh)
        kr = lax.dynamic_slice_in_dim(kg, rs, kh, axis=1)
        vr = lax.dynamic_slice_in_dim(vg, rs, kh, axis=1)
        kwin = kr[:, :, key_cols]
        vwin = vr[:, :, key_cols]
        qr = lax.dynamic_index_in_dim(qg, r, axis=1, keepdims=False)
        drow = rs + jnp.arange(kh) - r + (NA_KH - 1)
        bias = rpb[:, drow[None, :, None], dcol[:, None, :]]
        s_loc = jnp.einsum('bwhd,biwjhd->bhwij', qr, kwin).astype(jnp.float32) * ATTN_SCALE
        s_loc = (s_loc + bias.astype(jnp.float32)).reshape(B, H, GRID_W, kh * kw)
        s_ctx = jnp.einsum('bwhd,bchd->bhwc', qr, kc).astype(jnp.float32) * ATTN_SCALE
        p = jax.nn.softmax(jnp.concatenate([s_loc, s_ctx], axis=-1), axis=-1).astype(v.dtype)
        p_loc = p[..., :kh * kw].reshape(B, H, GRID_W, kh, kw)
        p_ctx = p[..., kh * kw:]
        return (jnp.einsum('bhwij,biwjhd->bwhd', p_loc, vwin)
                + jnp.einsum('bhwc,bchd->bwhd', p_ctx, vc))

    o = lax.map(row_block, jnp.arange(rows))
    return jnp.moveaxis(o, 0, 1).reshape(B, S, H * hd)


def hyena_filter(L, w1, b1, w2, b2, w3, b3, w_out, freq):
    f32 = jnp.float32
    t = jnp.linspace(0.0, 1.0, L, dtype=f32)[:, None]
    bands = (HY_EMB_DIM - 1) // 2
    w = 2.0 * math.pi * jnp.arange(L, dtype=f32)[:, None] / L
    fr = jnp.linspace(1e-4, bands - 1, bands, dtype=f32)[None, :]
    z = jnp.concatenate([t, jnp.cos(fr * w), -jnp.sin(fr * w)], axis=-1)
    om = freq.astype(f32)
    h = jnp.sin(om * (z @ w1.astype(f32) + b1.astype(f32)))
    h = jnp.sin(om * (h @ w2.astype(f32) + b2.astype(f32)))
    h = jnp.sin(om * (h @ w3.astype(f32) + b3.astype(f32)))
    h = h @ w_out.astype(f32)
    deltas = jnp.linspace(math.log(HY_DECAY_TARGET) / HY_SLOW_DECAY,
                          math.log(HY_DECAY_TARGET) / HY_FAST_DECAY, HY_WIDTH, dtype=f32)
    decay = jnp.exp(-t * jnp.abs(deltas))
    h_fwd = h[:, :HY_WIDTH] * decay
    h_bwd = h[:, HY_WIDTH:] * decay
    return jnp.concatenate([h_fwd, jnp.zeros((1, HY_WIDTH), f32), h_bwd[:0:-1]], axis=0)


def fft_long_conv(u, filt2):
    L = u.shape[1]
    uf = jnp.fft.rfft(u.astype(jnp.float32), n=2 * L, axis=1)
    ff = jnp.fft.rfft(filt2, n=2 * L, axis=0)
    y = jnp.fft.irfft(uf * ff[None], n=2 * L, axis=1)[:, :L]
    return y.astype(u.dtype)


def short_conv(u, w, b):
    L = u.shape[1]
    pad = HY_SHORT // 2
    up = jnp.pad(u, ((0, 0), (pad, HY_SHORT - 1 - pad), (0, 0)))
    return sum(up[:, i:i + L] * w[i] for i in range(HY_SHORT)) + b


def hyena_mixer(u, filt2, conv_w, conv_b, skip):
    u = short_conv(u, conv_w, conv_b)
    v, x1, x2 = jnp.split(u, 3, axis=-1)
    v = v * x1
    return x2 * (fft_long_conv(v, filt2) + v * skip)


def swiglu(h, w_in_ffn, w_out_ffn):
    g, u = jnp.split(h @ w_in_ffn, 2, axis=-1)
    return (jax.nn.silu(g) * u) @ w_out_ffn


def setup_inputs(seed: int = 0) -> dict:
    key = jax.random.key(seed)
    ks = iter(jax.random.split(key, 32))

    def nrm(shape, s):
        return jax.random.normal(next(ks), shape, jnp.float32) * s

    D = D_MODEL
    L = DEPTH
    F = HY_FILTER_WIDTH
    return {
        'x': nrm((BATCH, SEQ, D), 1.0),
        'c': nrm((BATCH, D), 1.0),
        'ctx': nrm((BATCH, CTX_LEN, D), 1.0),
        'c_ctx': nrm((D,), 1.0),
        'w_mod': nrm((L, D, 6 * D), 0.5 * D ** -0.5),
        'b_mod': nrm((L, 6 * D), 0.02),
        'g_mix': 1.0 + nrm((L, D), 0.05),
        'g_ffn': 1.0 + nrm((L, D), 0.05),
        'w_in': nrm((L, D, IN_COLS), D ** -0.5),
        'w_out': nrm((L, MIX_WIDTH, D), MIX_WIDTH ** -0.5),
        'hy_conv_w': nrm((L, HY_SHORT, HY_COLS), 0.5),
        'hy_conv_b': nrm((L, HY_COLS), 0.02),
        'hy_f_w1': nrm((L, HY_EMB_DIM, F), HY_EMB_DIM ** -0.5),
        'hy_f_b1': nrm((L, F), 0.1),
        'hy_f_w2': nrm((L, F, F), F ** -0.5),
        'hy_f_b2': nrm((L, F), 0.1),
        'hy_f_w3': nrm((L, F, F), F ** -0.5),
        'hy_f_b3': nrm((L, F), 0.1),
        'hy_f_wout': nrm((L, F, 2 * HY_WIDTH), 0.05 * F ** -0.5),
        'hy_f_freq': 1.0 + nrm((L, F), 0.05),
        'hy_skip': nrm((L, HY_WIDTH), 0.5),
        'qk_g_q': 1.0 + nrm((L, HEAD_DIM), 0.05),
        'qk_g_k': 1.0 + nrm((L, HEAD_DIM), 0.05),
        'na_rpb': nrm((L, NA_HEADS, 2 * NA_KH - 1, 2 * NA_KW - 1), 0.1),
        'w_ffn_in': nrm((L, D, 2 * FFN_HIDDEN), D ** -0.5),
        'w_ffn_out': nrm((L, FFN_HIDDEN, D), FFN_HIDDEN ** -0.5),
        'g_final': 1.0 + nrm((D,), 0.05),
    }


def reference(x, c, ctx, c_ctx, w_mod, b_mod, g_mix, g_ffn, w_in, w_out, hy_conv_w, hy_conv_b,
              hy_f_w1, hy_f_b1, hy_f_w2, hy_f_b2, hy_f_w3, hy_f_b3, hy_f_wout, hy_f_freq, hy_skip,
              qk_g_q, qk_g_k, na_rpb, w_ffn_in, w_ffn_out, g_final):
    S = x.shape[1]
    Lc = ctx.shape[1]
    cos, sin = axial_rope_tables(S)
    silu_c = jax.nn.silu(c)
    silu_cc = jax.nn.silu(c_ctx)
    xl, xc = x, ctx
    for l in range(DEPTH):
        last = l == DEPTH - 1
        mod_l = (silu_c @ w_mod[l] + b_mod[l])[:, None, :]
        mod_c = silu_cc @ w_mod[l] + b_mod[l]
        sh1, sc1, gt1, sh2, sc2, gt2 = jnp.split(mod_l, 6, axis=-1)
        csh1, csc1, cgt1, csh2, csc2, cgt2 = jnp.split(mod_c, 6, axis=-1)

        pl = modulate(rms_norm(xl, g_mix[l]), sh1, sc1) @ w_in[l]
        pc = modulate(rms_norm(xc, g_mix[l]), csh1, csc1) @ w_in[l]
        hy_l, q_l, k_l, v_l, nq_l, nk_l, nv_l = split_proj(pl)
        hy_c, q_c, k_c, v_c, nq_c, nk_c, nv_c = split_proj(pc)

        q_l = apply_rope(rms_norm(q_l, qk_g_q[l]), cos, sin)
        k_l = apply_rope(rms_norm(k_l, qk_g_k[l]), cos, sin)
        k_c = rms_norm(k_c, qk_g_k[l])
        gqa_l = gqa_latent(q_l, jnp.concatenate([k_c, k_l], axis=1),
                           jnp.concatenate([v_c, v_l], axis=1))
        na_l = natten_latent(nq_l, nk_l, nv_l, nk_c, nv_c, na_rpb[l])
        filt_l = hyena_filter(S, hy_f_w1[l], hy_f_b1[l], hy_f_w2[l], hy_f_b2[l], hy_f_w3[l],
                              hy_f_b3[l], hy_f_wout[l], hy_f_freq[l])
        hyo_l = hyena_mixer(hy_l, filt_l, hy_conv_w[l], hy_conv_b[l], hy_skip[l])

        mix_l = jnp.concatenate([hyo_l, gqa_l, na_l], axis=-1) @ w_out[l]
        xl = xl + gt1 * mix_l
        xl = xl + gt2 * swiglu(modulate(rms_norm(xl, g_ffn[l]), sh2, sc2), w_ffn_in[l], w_ffn_out[l])

        if not last:
            q_c = rms_norm(q_c, qk_g_q[l])
            gqa_c = attend(q_c, k_c, v_c)
            na_c = attend(nq_c, nk_c, nv_c)
            filt_c = hyena_filter(Lc, hy_f_w1[l], hy_f_b1[l], hy_f_w2[l], hy_f_b2[l], hy_f_w3[l],
                                  hy_f_b3[l], hy_f_wout[l], hy_f_freq[l])
            hyo_c = hyena_mixer(hy_c, filt_c, hy_conv_w[l], hy_conv_b[l], hy_skip[l])
            mix_c = jnp.concatenate([hyo_c, gqa_c, na_c], axis=-1) @ w_out[l]
            xc = xc + cgt1 * mix_c
            xc = xc + cgt2 * swiglu(modulate(rms_norm(xc, g_ffn[l]), csh2, csc2),
                                    w_ffn_in[l], w_ffn_out[l])
    return rms_norm(xl, g_final)
```

```cpp
#include <hip/hip_runtime.h>
#include <hip/hip_bf16.h>
#include <hip/hip_cooperative_groups.h>
#include <cstdio>
#include <cstdint>
#include <cmath>
namespace cg = cooperative_groups;
#ifndef PR_SYNC
#define PR_SYNC 1
#endif
#ifndef PR_MIX
#define PR_MIX 1
#endif
#ifndef PR_HY
#define PR_HY 1
#endif
#ifndef PR_HYEPI
#define PR_HYEPI 1
#endif
#ifndef PR_P0
#define PR_P0 1
#endif
#ifndef PR_NA
#define PR_NA 1
#endif
#ifndef PR_NORM
#define PR_NORM 1
#endif
#ifndef PR_FFI
#define PR_FFI 1
#endif
#ifndef PR_GQA
#define PR_GQA 1
#endif
#define GSYNC() do { for (int s_ = 0; s_ < PR_SYNC; ++s_) xcd_barrier(xbar); } while (0)

constexpr int DMODEL = 1024, NB = 8, SEQ = 4096, NLAY = 4, CTX = 256;
constexpr int ML = NB * SEQ, MC = NB * CTX, MT = ML + MC;
constexpr int INC = 2304, FFH = 2816, MODW = 6 * DMODEL;
constexpr float NORM_EPS = 1e-6f;
constexpr float QSCALE = 0.125f * 1.4426950408889634f;
constexpr float LOG2E = 1.4426950408889634f;

#define LAS __attribute__((address_space(3)))
#define GAS __attribute__((address_space(1)))
typedef unsigned v4u __attribute__((ext_vector_type(4)));
typedef unsigned v2u __attribute__((ext_vector_type(2)));
typedef float f32x16 __attribute__((ext_vector_type(16)));
typedef float f32x4v __attribute__((ext_vector_type(4)));
typedef short bf16x8v __attribute__((ext_vector_type(8)));

__device__ __forceinline__ unsigned f2bf(float f) { unsigned u = __builtin_bit_cast(unsigned, f); return (u + 0x7fffu + ((u >> 16) & 1u)) >> 16; }
__device__ __forceinline__ unsigned pk2(float lo, float hi) { return f2bf(lo) | (f2bf(hi) << 16); }
__device__ __forceinline__ float bf2f(unsigned short u) { return __builtin_bit_cast(float, (unsigned)u << 16); }
__device__ __forceinline__ int opq(int v) { asm volatile("" : "+v"(v)); return v; }
__device__ __forceinline__ float wave_sum(float v) {
#pragma unroll
    for (int o = 1; o < 64; o <<= 1) v += __shfl_xor(v, o);
    return v;
}

namespace pg8 {
#define PG8_LAS __attribute__((address_space(3)))
typedef unsigned short bf16_t;
typedef short bf16x8 __attribute__((ext_vector_type(8)));
typedef float f32x4 __attribute__((ext_vector_type(4)));
typedef unsigned u32x4 __attribute__((ext_vector_type(4)));
constexpr int BM = 256, BK = 64, HALF = 128, HTB = HALF * BK * 2  , STAGE_BYTES = 8 * HTB, NXCD = 8, WGM = 8;

__host__ __device__ __forceinline__ int lds_byte(int r, int c) { const int st = (r >> 4) * 2 + (c >> 5), rr = r & 15, cc = c & 31, ob = rr * 64 + cc * 2; return st * 1024 + (ob ^ (((ob >> 9) & 1) << 5)); }
__host__ __device__ __forceinline__ void stage_rc(int b, int& R, int& C) { const int st = b / 1024, sb = b % 1024, swz = sb ^ (((sb >> 9) & 1) << 5); R = (st >> 1) * 16 + swz / 64; C = (st & 1) * 32 + (swz % 64) / 2; }
__host__ __device__ __forceinline__ int perm32(int rho) { const int n = rho >> 4, i = rho & 15; return 8 * (i >> 2) + 4 * n + (i & 3); }

struct Unit { int pm, pn; };
struct Gemm { const bf16_t* A; const bf16_t* Bt; int M, N, K; };

struct StaticOrder {
    int nM, nN, nwg, G, c;
    __host__ __device__ void init(int M, int N, int G_, int c_) { nM = M / BM; nN = N / BM; nwg = nM * nN; G = G_; c = c_; }
    __host__ __device__ bool next(int i, Unit& u) const {
        const long L = (long)i * G + c; if (L >= nwg) return false;
        int wgid = (int)L; { const int q = nwg / NXCD, r = nwg % NXCD, xcd = wgid % NXCD, off = wgid / NXCD; wgid = (xcd < r ? xcd * (q + 1) : r * (q + 1) + (xcd - r) * q) + off; }
        const int nig = WGM * nN, gid = wgid / nig, fm = gid * WGM, gsz = (nM - fm) < WGM ? (nM - fm) : WGM;
        u.pm = fm + ((wgid % nig) % gsz); u.pn = (wgid % nig) / gsz; return true;
    }
    __device__ __forceinline__ void a_ready(const Unit&) const {}
    __device__ __forceinline__ void done(const Unit&) const {}
};

struct OneUnit { int pm, pn;
    __host__ __device__ bool next(int i, Unit& u) const { if (i > 0) return false; u.pm = pm; u.pn = pn; return true; }
    __device__ __forceinline__ void a_ready(const Unit&) const {}
    __device__ __forceinline__ void done(const Unit&) const {} };
__device__ __forceinline__ unsigned cvt_pk_bf16(float lo, float hi) { unsigned r; asm volatile("v_cvt_pk_bf16_f32 %0, %1, %2" : "=v"(r) : "v"(lo), "v"(hi)); return r; }

__device__ __forceinline__ void rows_rstd(const float* RSS, int rowbase, int fq, float (&rs)[2][4]) {
    float part[2][4];
#pragma unroll
    for (int ai = 0; ai < 2; ++ai)
#pragma unroll
        for (int m = 0; m < 4; ++m) part[ai][m] = RSS[(size_t)fq * MT + rowbase + ai * HALF + m * 16];
#pragma unroll
    for (int ai = 0; ai < 2; ++ai)
#pragma unroll
        for (int m = 0; m < 4; ++m) { float ss = part[ai][m]; ss += __shfl_xor(ss, 16); ss += __shfl_xor(ss, 32); rs[ai][m] = rsqrtf(ss * (1.0f / DMODEL) + NORM_EPS); }
}

struct EpiInProj {
    static constexpr bool PERM = true, AFTER_DRAIN = false;
    bf16_t* P; const float* gq; const float* gk; const float* rope;
    const float* RSS; const float* cv;
    __device__ __forceinline__ void operator()(const f32x4 (&acc)[2][2][4][2], const Unit& u, int wr, int wc, int fr, int fq) const {
        asm volatile("" : "+v"(fr), "+v"(fq));
        const int pn = u.pn;
        int mode = 0;
        if (pn == 3 || pn == 4) mode = 1; else if (pn == 5) mode = (wc < 2) ? 2 : 0; else if (pn == 6) mode = 3;
        const int colbase = pn * 256 + 64 * wc + 8 * fq;
        const int bidx_ = (u.pm * BM < ML) ? ((u.pm * BM) >> 12) : 8;
        f32x4 cvv[2][2];
#pragma unroll
        for (int bj = 0; bj < 2; ++bj)
#pragma unroll
            for (int n = 0; n < 2; ++n) cvv[bj][n] = *(const f32x4*)(cv + (size_t)bidx_ * INC + pn * 256 + 128 * bj + 32 * wc + 8 * fq + 4 * n);
        float rsv[2][4]; rows_rstd(RSS, u.pm * BM + wr * 64 + fr, fq, rsv);
        float gv[2][2][4];
        if (mode == 1 || mode == 2) { const float* g = (mode == 1) ? gq : gk;
#pragma unroll
            for (int bj = 0; bj < 2; ++bj)
#pragma unroll
                for (int n = 0; n < 2; ++n) { const f32x4 t = *(const f32x4*)(g + 32 * bj + 8 * fq + 4 * n); gv[bj][n][0] = t[0]; gv[bj][n][1] = t[1]; gv[bj][n][2] = t[2]; gv[bj][n][3] = t[3]; } }
#pragma unroll
        for (int ai = 0; ai < 2; ++ai)
#pragma unroll
            for (int m = 0; m < 4; ++m) {
                const int row = u.pm * BM + ai * HALF + wr * 64 + m * 16 + fr;
                const float rs_ = rsv[ai][m];
                float v[2][2][4];
#pragma unroll
                for (int bj = 0; bj < 2; ++bj)
#pragma unroll
                    for (int n = 0; n < 2; ++n)
#pragma unroll
                        for (int j = 0; j < 4; ++j) v[bj][n][j] = acc[ai][bj][m][n][j] * rs_ + cvv[bj][n][j];
                if (mode == 1 || mode == 2) {
                    float ss = 0.f;
#pragma unroll
                    for (int bj = 0; bj < 2; ++bj)
#pragma unroll
                        for (int n = 0; n < 2; ++n)
#pragma unroll
                            for (int j = 0; j < 4; ++j) ss += v[bj][n][j] * v[bj][n][j];
                    ss += __shfl_xor(ss, 16); ss += __shfl_xor(ss, 32);
                    const float rstd = rsqrtf(ss * (1.0f / 64.0f) + NORM_EPS);
#pragma unroll
                    for (int bj = 0; bj < 2; ++bj)
#pragma unroll
                        for (int n = 0; n < 2; ++n)
#pragma unroll
                            for (int j = 0; j < 4; ++j) v[bj][n][j] = v[bj][n][j] * rstd * gv[bj][n][j];
                    if (row < ML) {
                        const int s = row & (SEQ - 1); const int pos = (fq < 2) ? (s >> 6) : (s & 63);
                        const float* rp = rope + (pos * 16 + (fq & 1) * 8) * 2;
#pragma unroll
                        for (int n = 0; n < 2; ++n) { const f32x4 c0 = *(const f32x4*)(rp + 8 * n), c1 = *(const f32x4*)(rp + 8 * n + 4);
                            const float cs[4] = {c0[0], c0[2], c1[0], c1[2]}, sn[4] = {c0[1], c0[3], c1[1], c1[3]};
#pragma unroll
                            for (int j = 0; j < 4; ++j) { const float x1 = v[0][n][j], x2 = v[1][n][j]; v[0][n][j] = x1 * cs[j] - x2 * sn[j]; v[1][n][j] = x1 * sn[j] + x2 * cs[j]; } }
                    }
                }
                if (mode == 1 || mode == 3) {
#pragma unroll
                    for (int bj = 0; bj < 2; ++bj)
#pragma unroll
                        for (int n = 0; n < 2; ++n)
#pragma unroll
                            for (int j = 0; j < 4; ++j) v[bj][n][j] *= QSCALE;
                }
                bf16_t* rowp = P + (size_t)row * INC + colbase;
#pragma unroll
                for (int bj = 0; bj < 2; ++bj) { u32x4 w; w.x = cvt_pk_bf16(v[bj][0][0], v[bj][0][1]); w.y = cvt_pk_bf16(v[bj][0][2], v[bj][0][3]); w.z = cvt_pk_bf16(v[bj][1][0], v[bj][1][1]); w.w = cvt_pk_bf16(v[bj][1][2], v[bj][1][3]);
                    *(u32x4*)(rowp + 32 * bj) = w; }
            }
    }
};

struct EpiResid {
    static constexpr bool PERM = true, AFTER_DRAIN = false;
    const float* rin_l; const float* rin_c; float* rout_l; float* rout_c; const float* gate;
    bf16_t* XNo; float* RSS; const float* gnext; const float* scnext; int wantA;
    PG8_LAS float* xs;
    __device__ __forceinline__ void operator()(const f32x4 (&acc)[2][2][4][2], const Unit& u, int wr, int wc, int fr, int fq) const {
        asm volatile("" : "+v"(fr), "+v"(fq));
        const int row0 = u.pm * BM; const bool lat = row0 < ML;
        const int bidx = lat ? (row0 >> 12) : 8;
        const float* rin = lat ? rin_l : rin_c - (size_t)ML * DMODEL; float* rout = lat ? rout_l : rout_c - (size_t)ML * DMODEL;
        const int col0 = u.pn * BM + wc * 32 + 8 * fq;
        f32x4 gt[2][2], gs[2][2];
#pragma unroll
        for (int bj = 0; bj < 2; ++bj)
#pragma unroll
            for (int n = 0; n < 2; ++n) { gt[bj][n] = *(const f32x4*)(gate + (size_t)bidx * MODW + col0 + bj * HALF + 4 * n);
                if (wantA) gs[bj][n] = *(const f32x4*)(gnext + col0 + bj * HALF + 4 * n) * (*(const f32x4*)(scnext + (size_t)bidx * MODW + col0 + bj * HALF + 4 * n) + 1.0f);
                else gs[bj][n] = (f32x4){0.f, 0.f, 0.f, 0.f}; }
#pragma unroll
        for (int ai = 0; ai < 2; ++ai)
#pragma unroll
            for (int m = 0; m < 4; ++m) { const int row = row0 + ai * HALF + wr * 64 + m * 16 + fr; const size_t ro = (size_t)row * DMODEL + col0;
                float ss = 0.f;
#pragma unroll
                for (int bj = 0; bj < 2; ++bj) { f32x4 xn[2];
#pragma unroll
                    for (int n = 0; n < 2; ++n) { const f32x4 xi = *(const f32x4*)(rin + ro + bj * HALF + 4 * n);
                        xn[n] = xi + gt[bj][n] * acc[ai][bj][m][n];
                        *(f32x4*)(rout + ro + bj * HALF + 4 * n) = xn[n];
                        ss += (xn[n][0] * xn[n][0] + xn[n][1] * xn[n][1]) + (xn[n][2] * xn[n][2] + xn[n][3] * xn[n][3]); }
                    if (wantA) { const f32x4 a0 = xn[0] * gs[bj][0], a1 = xn[1] * gs[bj][1];
                        u32x4 w; w.x = cvt_pk_bf16(a0[0], a0[1]); w.y = cvt_pk_bf16(a0[2], a0[3]); w.z = cvt_pk_bf16(a1[0], a1[1]); w.w = cvt_pk_bf16(a1[2], a1[3]);
                        *(u32x4*)(XNo + ro + bj * HALF) = w; } }
                if (wantA) { ss += __shfl_xor(ss, 16); ss += __shfl_xor(ss, 32);
                    if (fq == 0) xs[(ai * HALF + wr * 64 + m * 16 + fr) * 4 + wc] = ss; } }
        if (wantA) {
            asm volatile("s_waitcnt lgkmcnt(0)\n\ts_barrier" ::: "memory");
            const int t = (wr * 4 + wc) * 64 + fq * 16 + fr;
            if (t < 256) { const f32x4 p = *(const PG8_LAS f32x4*)(xs + 4 * t); RSS[(size_t)u.pn * MT + row0 + t] = (p[0] + p[1]) + (p[2] + p[3]); }
        }
    }
};

struct EpiSwiglu {
    static constexpr bool PERM = true, AFTER_DRAIN = false;
    bf16_t* ACT; const float* RSS; const float* cv;
    __device__ __forceinline__ void operator()(const f32x4 (&acc)[2][2][4][2], const Unit& u, int wr, int wc, int fr, int fq) const {
        asm volatile("" : "+v"(fr), "+v"(fq));
        const int col0 = u.pn * HALF + wc * 32 + 8 * fq;
        const int bidx_ = (u.pm * BM < ML) ? ((u.pm * BM) >> 12) : 8;
        f32x4 cvv[2][2];
#pragma unroll
        for (int bj = 0; bj < 2; ++bj)
#pragma unroll
            for (int n = 0; n < 2; ++n) cvv[bj][n] = *(const f32x4*)(cv + (size_t)bidx_ * (2 * FFH) + u.pn * 256 + 128 * bj + 32 * wc + 8 * fq + 4 * n);
        float rsv[2][4]; rows_rstd(RSS, u.pm * BM + wr * 64 + fr, fq, rsv);
#pragma unroll
        for (int ai = 0; ai < 2; ++ai)
#pragma unroll
            for (int m = 0; m < 4; ++m) { const int row = u.pm * BM + ai * HALF + wr * 64 + m * 16 + fr;
                const float rs_ = rsv[ai][m];
                float o[2][4];
#pragma unroll
                for (int n = 0; n < 2; ++n)
#pragma unroll
                    for (int j = 0; j < 4; ++j) { const float g = acc[ai][0][m][n][j] * rs_ + cvv[0][n][j], uu = acc[ai][1][m][n][j] * rs_ + cvv[1][n][j];
                        o[n][j] = g * __builtin_amdgcn_rcpf(1.0f + __expf(-g)) * uu; }
                u32x4 w; w.x = cvt_pk_bf16(o[0][0], o[0][1]); w.y = cvt_pk_bf16(o[0][2], o[0][3]); w.z = cvt_pk_bf16(o[1][0], o[1][1]); w.w = cvt_pk_bf16(o[1][2], o[1][3]);
                *(u32x4*)(ACT + (size_t)row * FFH + col0) = w; }
    }
};

template <class Epi, class Sched, bool ALIGN_EPI = false, bool SP2 = false>
__device__ __forceinline__ void gemm_phase(PG8_LAS unsigned char* lds, const Gemm g, const Sched& S, const Epi& E) {
    int tid_o = threadIdx.x; asm volatile("" : "+v"(tid_o));
    const int tid = tid_o, wid = __builtin_amdgcn_readfirstlane(tid >> 6), lane = tid & 63, wr = wid >> 2, wc = wid & 3, fr = lane & 15, fq = lane >> 4;
    const int K = g.K, nt = K / BK;
    unsigned voffA[2], voffB[2];
#pragma unroll
    for (int i = 0; i < 2; ++i) { int R, C; stage_rc(tid * 16 + i * 8192, R, C); const int Rb = Epi::PERM ? ((R & ~31) + perm32(R & 31)) : R;
        voffA[i] = (unsigned)(R * K + C) * 2u; voffB[i] = (unsigned)(Rb * K + C) * 2u; }
    const size_t kstep = (size_t)(BK * 2);
    const size_t hstep = (size_t)HALF * K * 2;
    const size_t tstep = 2 * hstep;
    const unsigned ldsw = (unsigned)wid * 1024u;
    const int aoff = lds_byte(wr * 64 + fr, fq * 8), boff = lds_byte(wc * 32 + fr, fq * 8);
#define PG8_SA(b, h) (((b) * 2 + (h)) * HTB)
#define PG8_SB(b, h) ((4 + (b) * 2 + (h)) * HTB)
#define PG8_STAGE(bufoff, gbase, voff) do { _Pragma("unroll") for (int _i = 0; _i < 2; ++_i) \
        __builtin_amdgcn_global_load_lds((const unsigned*)((const char*)(gbase) + (voff)[_i]), (PG8_LAS unsigned*)(lds + (bufoff) + ldsw + _i * 8192), 16, 0, 0); } while (0)
#define PG8_LDA(dst, b, h) do { _Pragma("unroll") for (int m = 0; m < 4; ++m) _Pragma("unroll") for (int k = 0; k < 2; ++k) dst[m][k] = *(const PG8_LAS bf16x8*)(lds + PG8_SA(b, h) + aoff + m * 2048 + k * 1024); } while (0)
#define PG8_LDB(dst, b, h) do { _Pragma("unroll") for (int n = 0; n < 2; ++n) _Pragma("unroll") for (int k = 0; k < 2; ++k) dst[n][k] = *(const PG8_LAS bf16x8*)(lds + PG8_SB(b, h) + boff + n * 2048 + k * 1024); } while (0)
#define PG8_MMA(ai, bj, At, Bt) do { __builtin_amdgcn_s_setprio(1); _Pragma("unroll") for (int m = 0; m < 4; ++m) _Pragma("unroll") for (int n = 0; n < 2; ++n) _Pragma("unroll") for (int k = 0; k < 2; ++k) \
        acc[ai][bj][m][n] = __builtin_amdgcn_mfma_f32_16x16x32_bf16(Bt[n][k], At[m][k], acc[ai][bj][m][n], 0, 0, 0); __builtin_amdgcn_s_setprio(0); } while (0)
#define PG8_WAIT_V(n) asm volatile("s_waitcnt vmcnt(" #n ")" ::: "memory")
#define PG8_WAIT_L(n) asm volatile("s_waitcnt lgkmcnt(" #n ")" ::: "memory")
#define PG8_BAR __builtin_amdgcn_s_barrier()
#define PG8_SCHED __builtin_amdgcn_sched_barrier(0)
    Unit cur, nxt; int ui = 0;
    if (!S.next(0, cur)) return;
    f32x4 acc[2][2][4][2];
#pragma unroll
    for (int a = 0; a < 2; ++a)
#pragma unroll
        for (int b = 0; b < 2; ++b)
#pragma unroll
            for (int m = 0; m < 4; ++m)
#pragma unroll
                for (int n = 0; n < 2; ++n) acc[a][b][m][n] = (f32x4){0.f, 0.f, 0.f, 0.f};
    bf16x8 At[4][2], B0[2][2], B1[2][2];
    const char* cA = (const char*)g.A + (size_t)cur.pm * tstep; const char* cB = (const char*)g.Bt + (size_t)cur.pn * tstep;
    S.a_ready(cur);
    if constexpr (SP2) {
        PG8_STAGE(PG8_SB(0, 0), cB, voffB); PG8_STAGE(PG8_SB(0, 1), cB + hstep, voffB); PG8_STAGE(PG8_SA(0, 0), cA, voffA); PG8_STAGE(PG8_SA(0, 1), cA + hstep, voffA);
        if (wr == 1) PG8_BAR;
        PG8_WAIT_V(2); PG8_BAR;
        PG8_STAGE(PG8_SB(1, 0), cB + kstep, voffB); PG8_STAGE(PG8_SA(1, 0), cA + kstep, voffA); PG8_STAGE(PG8_SB(1, 1), cB + hstep + kstep, voffB);
        PG8_WAIT_V(6); PG8_BAR;
    } else {
        PG8_STAGE(PG8_SB(0, 0), cB, voffB); PG8_STAGE(PG8_SA(0, 0), cA, voffA); PG8_STAGE(PG8_SB(0, 1), cB + hstep, voffB); PG8_STAGE(PG8_SA(0, 1), cA + hstep, voffA);
        if (wr == 1) PG8_BAR;
        PG8_WAIT_V(4); PG8_BAR;
        PG8_STAGE(PG8_SB(1, 0), cB + kstep, voffB); PG8_STAGE(PG8_SA(1, 0), cA + kstep, voffA); PG8_STAGE(PG8_SB(1, 1), cB + hstep + kstep, voffB);
        PG8_WAIT_V(6); PG8_BAR;
    }
    for (;;) {
        const bool has_next = S.next(ui + 1, nxt);
        const char* nA = has_next ? (const char*)g.A + (size_t)nxt.pm * tstep : cA; const char* nB = has_next ? (const char*)g.Bt + (size_t)nxt.pn * tstep : cB;
        for (int t = 0; t < nt; t += 2) {
            const bool last = (t == nt - 2);
            const char* a1 = cA + (size_t)(t + 1) * kstep;
            const char* a2 = last ? nA : cA + (size_t)(t + 2) * kstep; const char* b2 = last ? nB : cB + (size_t)(t + 2) * kstep;
            const char* a3 = a2 + kstep; const char* b3 = b2 + kstep;
            if (last && has_next) S.a_ready(nxt);
            if constexpr (SP2) {
            PG8_LDB(B0, 0, 0); PG8_LDB(B1, 0, 1); PG8_SCHED; PG8_LDA(At, 0, 0); PG8_STAGE(PG8_SA(1, 1), a1 + hstep, voffA);
            PG8_WAIT_V(8); PG8_WAIT_L(0); PG8_BAR; PG8_MMA(0, 0, At, B0); PG8_MMA(0, 1, At, B1); PG8_BAR; PG8_SCHED;
            PG8_LDA(At, 0, 1); PG8_STAGE(PG8_SB(0, 0), b2, voffB); PG8_STAGE(PG8_SB(0, 1), b2 + hstep, voffB); PG8_STAGE(PG8_SA(0, 0), a2, voffA);
            PG8_WAIT_V(8); PG8_WAIT_L(0); PG8_BAR; PG8_MMA(1, 0, At, B0); PG8_MMA(1, 1, At, B1); PG8_BAR; PG8_SCHED;
            PG8_LDB(B0, 1, 0); PG8_LDB(B1, 1, 1); PG8_SCHED; PG8_LDA(At, 1, 0); PG8_STAGE(PG8_SA(0, 1), a2 + hstep, voffA);
            PG8_WAIT_V(8); PG8_WAIT_L(0); PG8_BAR; PG8_MMA(0, 0, At, B0); PG8_MMA(0, 1, At, B1); PG8_BAR; PG8_SCHED;
            PG8_LDA(At, 1, 1); PG8_STAGE(PG8_SB(1, 0), b3, voffB); PG8_STAGE(PG8_SB(1, 1), b3 + hstep, voffB); PG8_STAGE(PG8_SA(1, 0), a3, voffA);
            PG8_WAIT_V(8); PG8_WAIT_L(0); PG8_BAR; PG8_MMA(1, 0, At, B0); PG8_MMA(1, 1, At, B1); PG8_BAR; PG8_SCHED;
            } else {
            PG8_LDB(B0, 0, 0); PG8_SCHED; PG8_LDA(At, 0, 0); PG8_STAGE(PG8_SA(1, 1), a1 + hstep, voffA);
            PG8_WAIT_L(8); PG8_BAR; PG8_WAIT_L(0); PG8_MMA(0, 0, At, B0); PG8_BAR; PG8_SCHED;
            PG8_LDB(B1, 0, 1); PG8_STAGE(PG8_SB(0, 0), b2, voffB);
            PG8_BAR; PG8_WAIT_L(0); PG8_MMA(0, 1, At, B1); PG8_BAR;
            PG8_LDA(At, 0, 1); PG8_STAGE(PG8_SA(0, 0), a2, voffA);
            PG8_BAR; PG8_WAIT_L(0); PG8_MMA(1, 0, At, B0); PG8_BAR; PG8_SCHED;
            PG8_STAGE(PG8_SB(0, 1), b2 + hstep, voffB);
            PG8_WAIT_V(6); PG8_BAR; PG8_MMA(1, 1, At, B1); PG8_BAR;
            PG8_LDB(B0, 1, 0); PG8_SCHED; PG8_LDA(At, 1, 0); PG8_STAGE(PG8_SA(0, 1), a2 + hstep, voffA);
            PG8_WAIT_L(8); PG8_BAR; PG8_WAIT_L(0); PG8_MMA(0, 0, At, B0); PG8_BAR; PG8_SCHED;
            PG8_LDB(B1, 1, 1); PG8_STAGE(PG8_SB(1, 0), b3, voffB);
            PG8_BAR; PG8_WAIT_L(0); PG8_MMA(0, 1, At, B1); PG8_BAR;
            PG8_LDA(At, 1, 1); PG8_STAGE(PG8_SA(1, 0), a3, voffA);
            PG8_BAR; PG8_WAIT_L(0); PG8_MMA(1, 0, At, B0); PG8_BAR; PG8_SCHED;
            PG8_STAGE(PG8_SB(1, 1), b3 + hstep, voffB);
            PG8_WAIT_V(6); PG8_BAR; PG8_MMA(1, 1, At, B1); PG8_BAR;
            }
        }
        if constexpr (ALIGN_EPI) { if (wr == 0) PG8_BAR; }
        if constexpr (!Epi::AFTER_DRAIN) { E(acc, cur, wr, wc, fr, fq); S.done(cur); }
        if (!has_next) break;
#pragma unroll
        for (int a = 0; a < 2; ++a)
#pragma unroll
            for (int b = 0; b < 2; ++b)
#pragma unroll
                for (int m = 0; m < 4; ++m)
#pragma unroll
                    for (int n = 0; n < 2; ++n) acc[a][b][m][n] = (f32x4){0.f, 0.f, 0.f, 0.f};
        cur = nxt; cA = nA; cB = nB; ++ui;
        if constexpr (ALIGN_EPI) { if (wr == 1) PG8_BAR; }
    }
    PG8_WAIT_V(0);
    if constexpr (!ALIGN_EPI) { if (wr == 0) PG8_BAR; }
    PG8_BAR;
    if constexpr (Epi::AFTER_DRAIN) { E.fused(acc, cur, wr, wc, fr, fq, lds, wid, lane); S.done(cur); }
#undef PG8_SA
#undef PG8_SB
#undef PG8_STAGE
#undef PG8_LDA
#undef PG8_LDB
#undef PG8_MMA
#undef PG8_WAIT_V
#undef PG8_WAIT_L
#undef PG8_BAR
#undef PG8_SCHED
}
}

namespace attn_body {
using bf16=__hip_bfloat16;
using bf16x8=__attribute__((ext_vector_type(8)))short;
using s16x4=__attribute__((ext_vector_type(4)))short;
using f32x16=__attribute__((ext_vector_type(16)))float;
using u32x4=__attribute__((ext_vector_type(4)))unsigned;
constexpr int D=64, PP=2304, OP=1024;
constexpr int NW=8,QBLK=32,QB=QBLK*NW,KVBLK=64;
__device__ __forceinline__ int crow(int r,int hi){return (r&3)+8*(r>>2)+4*hi;}
#define SBAR() __builtin_amdgcn_sched_barrier(0)
__device__ __forceinline__ void cmask(f32x16&p0,f32x16&p1,int jb,int qrel,int hi){
  const float NEG=-INFINITY; int kb=64*jb+4*hi;
  #pragma unroll
  for(int r=0;r<16;++r){int kv=kb+(r&3)+8*(r>>2); if(kv>qrel)p0[r]=NEG; if(kv+32>qrel)p1[r]=NEG;}
}

constexpr int NSLOT=3, SLOTB=8192;
constexpr int LDS_K=0, LDS_V=NSLOT*SLOTB, LDS_WS=2*NSLOT*SLOTB, LDS_OST=LDS_WS+NW*64*4, LDS_BYTES=LDS_OST+NW*4096;
constexpr float C2=0.125f*1.4426950408889634f;

__device__ __forceinline__ void na_hook(f32x16&p0,f32x16&p1,int t,int r0,int qrow,int qcol,int hi,const float*bias){
  if(t<4)return;
  const float NEG=-INFINITY; const int kr=r0+t-4; int rs=qrow-4; rs=rs<0?0:(rs>56?56:rs);
  if(kr<rs||kr>rs+7){
    #pragma unroll
    for(int r=0;r<16;++r){p0[r]=NEG;p1[r]=NEG;}
    return; }
  int cs=qcol-8; cs=cs<0?0:(cs>48?48:cs);
  const float*bt=bias+(kr-qrow+7)*31+15-qcol;
  #pragma unroll
  for(int r=0;r<16;++r){ const int kc=(r&3)+8*(r>>2)+4*hi;
    const bool v0=(unsigned)(kc-cs)<16u, v1=(unsigned)(kc+32-cs)<16u;
    const float b0=v0?bt[kc]:0.f, b1=v1?bt[kc+32]:0.f;
    p0[r]=v0?p0[r]+b0:NEG; p1[r]=v1?p1[r]+b1:NEG; }
}
__device__ __forceinline__ void glds16(const void*gsrc,unsigned lds_dst){unsigned keep;
  asm volatile("s_mov_b32 %0, m0\n\ts_mov_b32 m0, %2\n\ts_nop 0\n\tglobal_load_lds_dwordx4 %1, off\n\ts_mov_b32 m0, %0":"=&s"(keep):"v"(gsrc),"s"(lds_dst):"memory");}
__device__ __forceinline__ float max3f(float a,float b,float c){float r;asm("v_max3_f32 %0, %1, %2, %3":"=v"(r):"v"(a),"v"(b),"v"(c));return r;}
__device__ __forceinline__ float max2f(float a,float b){float r;asm("v_max_f32_e32 %0, %1, %2":"=v"(r):"v"(a),"v"(b));return r;}
__device__ __forceinline__ float fadd_s(float a,float b){float r;asm("v_add_f32_e32 %0, %1, %2":"=v"(r):"v"(a),"v"(b));return r;}
__device__ __forceinline__ float fsub_s(float a,float b){float r;asm("v_sub_f32_e32 %0, %1, %2":"=v"(r):"v"(a),"v"(b));return r;}
typedef float f32x2_t __attribute__((ext_vector_type(2))); typedef __bf16 bf16x2_t __attribute__((ext_vector_type(2)));
__device__ __forceinline__ unsigned cvtpk_s(float lo,float hi){f32x2_t v={lo,hi};bf16x2_t b=__builtin_convertvector(v,bf16x2_t);return __builtin_bit_cast(unsigned,b);}
#define WAIT_BAR(N) asm volatile("s_waitcnt vmcnt(" #N ") lgkmcnt(0)\n\ts_barrier":::"memory")

__device__ __forceinline__ void qkt(f32x16&p0,f32x16&p1,const char*Kslot,const bf16x8*qr,const f32x16&negm,int r32,int hi){
  const char*kb=Kslot+hi*1024+r32*16;
  #pragma unroll
  for(int d0=0;d0<4;++d0){
    const bf16x8 b0=*reinterpret_cast<const bf16x8*>(kb+d0*2048);
    const bf16x8 b1=*reinterpret_cast<const bf16x8*>(kb+d0*2048+512);
    if(d0==0){p0=__builtin_amdgcn_mfma_f32_32x32x16_bf16(b0,qr[0],negm,0,0,0);p1=__builtin_amdgcn_mfma_f32_32x32x16_bf16(b1,qr[0],negm,0,0,0);}
    else{p0=__builtin_amdgcn_mfma_f32_32x32x16_bf16(b0,qr[d0],p0,0,0,0);p1=__builtin_amdgcn_mfma_f32_32x32x16_bf16(b1,qr[d0],p1,0,0,0);}}
}
typedef __attribute__((address_space(3))) const char* lds_cptr;
typedef short v4i16_t __attribute__((ext_vector_type(4)));
__device__ __forceinline__ void kload8(bf16x8*kf,lds_cptr kp){
  kf[0]=*(const __attribute__((address_space(3))) bf16x8*)(kp);      kf[1]=*(const __attribute__((address_space(3))) bf16x8*)(kp+512);
  kf[2]=*(const __attribute__((address_space(3))) bf16x8*)(kp+2048); kf[3]=*(const __attribute__((address_space(3))) bf16x8*)(kp+2560);
  kf[4]=*(const __attribute__((address_space(3))) bf16x8*)(kp+4096); kf[5]=*(const __attribute__((address_space(3))) bf16x8*)(kp+4608);
  kf[6]=*(const __attribute__((address_space(3))) bf16x8*)(kp+6144); kf[7]=*(const __attribute__((address_space(3))) bf16x8*)(kp+6656);
}
__device__ __forceinline__ void kload2(bf16x8*kf,lds_cptr kp,int j){ kf[2*j]=*(const __attribute__((address_space(3))) bf16x8*)(kp+j*2048); kf[2*j+1]=*(const __attribute__((address_space(3))) bf16x8*)(kp+j*2048+512); }
__device__ __forceinline__ s16x4 vtr(lds_cptr p){ return __builtin_bit_cast(s16x4,__builtin_amdgcn_ds_read_tr16_b64_v4i16((__attribute__((address_space(3))) v4i16_t*)p)); }
__device__ __forceinline__ float rowmax(const f32x16&p0,const f32x16&p1){
  float a=max3f(p0[0],p0[1],p1[0]),b=max3f(p0[2],p0[3],p1[1]);a=max3f(a,p1[2],p1[3]);
  #pragma unroll
  for(int r=4;r<16;r+=4){a=max3f(a,p0[r],p0[r+1]);b=max3f(b,p0[r+2],p0[r+3]);a=max3f(a,p1[r],p1[r+1]);b=max3f(b,p1[r+2],p1[r+3]);}
  const float m=max2f(a,b);
  auto rr=__builtin_amdgcn_permlane32_swap(__float_as_uint(m),__float_as_uint(m),false,false);
  return max2f(__uint_as_float(rr[0]),__uint_as_float(rr[1]));
}
__device__ __forceinline__ void pv(f32x16*o,int vb,bf16x8 pa0,bf16x8 pa1,bf16x8 pa2,bf16x8 pa3){
  #pragma unroll
  for(int d0=0;d0<2;++d0){s16x4 lo[4],hi[4];
    #pragma unroll
    for(int ks=0;ks<4;++ks){
      asm volatile("ds_read_b64_tr_b16 %0,%1 offset:%c2":"=&v"(lo[ks]):"v"(vb),"i"(d0*4096+ks*1024):"memory");
      asm volatile("ds_read_b64_tr_b16 %0,%1 offset:%c2":"=&v"(hi[ks]):"v"(vb),"i"(d0*4096+ks*1024+512):"memory");}
    asm volatile("s_waitcnt lgkmcnt(0)":::"memory");SBAR();
    #define PK(k) (bf16x8){lo[k][0],lo[k][1],lo[k][2],lo[k][3],hi[k][0],hi[k][1],hi[k][2],hi[k][3]}
    o[d0]=__builtin_amdgcn_mfma_f32_32x32x16_bf16(pa0,PK(0),o[d0],0,0,0);
    o[d0]=__builtin_amdgcn_mfma_f32_32x32x16_bf16(pa1,PK(1),o[d0],0,0,0);
    o[d0]=__builtin_amdgcn_mfma_f32_32x32x16_bf16(pa2,PK(2),o[d0],0,0,0);
    o[d0]=__builtin_amdgcn_mfma_f32_32x32x16_bf16(pa3,PK(3),o[d0],0,0,0);
    #undef PK
  }
}

#ifndef ATTN_STORE16
#define ATTN_STORE16(p,v) (*(u32x4*)(p)=(v))
#endif
template<int THRL,int MODE> __device__ __forceinline__ void attn_unit(const bf16*Qu,const bf16*__restrict__ Kb,const bf16*__restrict__ Vb,bf16*Ou,int krow_c,int krow_l,int tclamp,int NT,int na_r0,int na_qrow0,const float*na_bias,char*shm,float fixm=0.f){
  int tid_o=threadIdx.x; asm volatile("":"+v"(tid_o)); const int tid=tid_o,lane=tid&63,r32=lane&31,hi=lane>>5; const int wid=__builtin_amdgcn_readfirstlane(tid>>6);
  const bf16*Qw=Qu+(long)(wid*QBLK)*PP;
  const bf16*Kh=Kb,*Vh=Vb;
  #define KROW(t) (((t)<4)?(krow_c+64*(t)):(krow_l+64*(((t)-4)<tclamp?((t)-4):tclamp)))
  const unsigned lds0=(unsigned)(uintptr_t)shm;
  float*wsf=(float*)(shm+LDS_WS)+wid*64;
  const bf16*ksrc=Kh+(long)lane*PP+wid*8;
  const bf16*vsrc=Vh+(long)(16*(wid&3)+(lane>>2))*PP+(wid>>2)*32+(lane&3)*8;
  const unsigned kdst=lds0+LDS_K+wid*1024, vdst=lds0+LDS_V+wid*1024;
  #define DMA_K(t,slot) glds16(ksrc+(long)KROW(t)*PP,(unsigned)__builtin_amdgcn_readfirstlane(kdst+(slot)))
  #define DMA_V(t,slot) glds16(vsrc+(long)KROW(t)*PP,(unsigned)__builtin_amdgcn_readfirstlane(vdst+(slot)))
  const int vb0=(int)(lds0+LDS_V)+((lane>>4)&1)*32+(lane&3)*8+(4*hi+((lane&15)>>2))*64;
  const char*Kbase=shm+LDS_K; bf16x8 kf[8];
  const lds_cptr shm3=(lds_cptr)shm; const lds_cptr kp0=shm3+LDS_K+hi*1024+r32*16; const lds_cptr vp0=shm3+LDS_V+((lane>>4)&1)*32+(lane&3)*8+(4*hi+((lane&15)>>2))*64;
  DMA_K(0,0);DMA_V(0,0);DMA_K(1,SLOTB);
  bf16x8 qr[4];
  #pragma unroll
  for(int d0=0;d0<4;++d0)qr[d0]=*reinterpret_cast<const bf16x8*>(&Qw[(long)r32*PP+d0*16+hi*8]);
  float mhat=0.f,l_reg=0.f;f32x16 o[2];o[0]=f32x16{};o[1]=f32x16{};f32x16 negm=f32x16{};asm volatile("":"+v"(negm));
  const int na_qrow=na_qrow0+(wid>>1), na_qcol=32*(wid&1)+r32;
  #define CMASK(P0,P1,t) do{ if(MODE==1) na_hook(P0,P1,(t),na_r0,na_qrow,na_qcol,hi,na_bias); }while(0)
  bool resc=false;
  #define START(P0,P1) do{ const float rm=(MODE==2)?fixm:rowmax(P0,P1); resc=false; \
    { const float dl=rm; mhat=fadd_s(mhat,dl); \
      _Pragma("unroll") for(int r=0;r<16;++r){P0[r]=fsub_s(P0[r],dl);P1[r]=fsub_s(P1[r],dl);} \
      _Pragma("unroll") for(int r=0;r<16;++r)negm[r]=-mhat; asm volatile("":"+v"(negm)); } \
    _Pragma("unroll") for(int r=0;r<16;++r)P0[r]=__builtin_amdgcn_exp2f(P0[r]); }while(0)
  #define RESC() do{ if(resc){ asm volatile("s_waitcnt lgkmcnt(0)":::"memory"); \
      _Pragma("unroll") for(int d_=0;d_<2;++d_) _Pragma("unroll") for(int r=0;r<16;++r)o[d_][r]*=wsf[crow(r,hi)]; } }while(0)
  f32x16 pA0,pA1,pB0,pB1;
  int sl_prev=0,sl_cur=0,sl_next=SLOTB;
  #define ROT() do{sl_prev=sl_cur;sl_cur=sl_next;sl_next=(sl_next==(NSLOT-1)*SLOTB)?0:sl_next+SLOTB;}while(0)
  DMA_K(2,2*SLOTB);
  WAIT_BAR(3);
  qkt(pA0,pA1,Kbase,qr,negm,r32,hi);asm volatile("s_nop 15\n\ts_nop 7":"+v"(pA0),"+v"(pA1));CMASK(pA0,pA1,0);
  START(pA0,pA1);
  _Pragma("unroll") for(int r=0;r<16;++r)pA1[r]=__builtin_amdgcn_exp2f(pA1[r]);
  WAIT_BAR(0);
  DMA_K(3,0);DMA_V(1,SLOTB);
  ROT();
  kload8(kf,kp0+sl_cur);
  WAIT_BAR(2);
  s16x4 vlo[8],vhi[8]; u32x4 pw0,pw1,pw2,pw3;
  #define PKW(P,B) cvtpk_s(P[B],P[B+1])
  #define PAF(k) __builtin_bit_cast(bf16x8,pw##k)
  #define VFR(i) (bf16x8){vlo[i][0],vlo[i][1],vlo[i][2],vlo[i][3],vhi[i][0],vhi[i][1],vhi[i][2],vhi[i][3]}
  #define PIN(x) asm volatile("":"+v"(x))
  #define MX3(a,b,c) __builtin_fmaxf(__builtin_fmaxf((a),(b)),(c))
  #define GAPA(MF,A0,A1,A2,A3,W0,W1,PW) do{ MF; sacc2+=(f32x2_t){A0,A1}; sacc2+=(f32x2_t){A2,A3}; PIN(sacc2); W0; W1; PIN(PW); SBAR(); }while(0)
  #define EX(v) __builtin_amdgcn_exp2f(v)
  #define GAPB(MF,X,B) do{ MF; X[B]=EX(X[B]); X[B+1]=EX(X[B+1]); X[B+2]=EX(X[B+2]); X[B+3]=EX(X[B+3]); PIN(X); SBAR(); }while(0)
  #define VRD(i) do{ vlo[i]=vtr(vp_+(((i)>>2)*4096+((i)&3)*1024)); vhi[i]=vtr(vp_+(((i)>>2)*4096+((i)&3)*1024+512)); }while(0)
  #define KRD(G,j) do{ if(G){ kload2(kf,kp0+sl_next,j); SBAR(); } }while(0)
  #define STEP(C0,C1,P0,P1,t,GK,GV,GL) do{ SBAR(); \
    const lds_cptr vp_=vp0+sl_prev; \
    VRD(0); SBAR(); f32x2_t sacc2={P0[0],P0[1]}; \
    GAPA(C0=__builtin_amdgcn_mfma_f32_32x32x16_bf16(kf[0],qr[0],negm,0,0,0), P0[2],P0[3],P0[4],P0[5],     pw0[0]=PKW(P0,0), pw0[1]=PKW(P0,2), pw0); \
    VRD(4); SBAR(); GAPA(C1=__builtin_amdgcn_mfma_f32_32x32x16_bf16(kf[1],qr[0],negm,0,0,0), P0[6],P0[7],P0[8],P0[9],     pw0[2]=PKW(P0,4), pw0[3]=PKW(P0,6), pw0); \
    VRD(1); SBAR(); GAPA(C0=__builtin_amdgcn_mfma_f32_32x32x16_bf16(kf[2],qr[1],C0,0,0,0),   P0[10],P0[11],P0[12],P0[13], pw1[0]=PKW(P0,8), pw1[1]=PKW(P0,10), pw1); \
    VRD(5); SBAR(); GAPA(C1=__builtin_amdgcn_mfma_f32_32x32x16_bf16(kf[3],qr[1],C1,0,0,0),   P0[14],P0[15],P1[0],P1[1],   pw1[2]=PKW(P0,12),pw1[3]=PKW(P0,14), pw1); \
    VRD(2); SBAR(); GAPA(C0=__builtin_amdgcn_mfma_f32_32x32x16_bf16(kf[4],qr[2],C0,0,0,0),   P1[2],P1[3],P1[4],P1[5],     pw2[0]=PKW(P1,0), pw2[1]=PKW(P1,2), pw2); \
    VRD(6); SBAR(); GAPA(C1=__builtin_amdgcn_mfma_f32_32x32x16_bf16(kf[5],qr[2],C1,0,0,0),   P1[6],P1[7],P1[8],P1[9],     pw2[2]=PKW(P1,4), pw2[3]=PKW(P1,6), pw2); \
    VRD(3); SBAR(); GAPA(C0=__builtin_amdgcn_mfma_f32_32x32x16_bf16(kf[6],qr[3],C0,0,0,0),   P1[10],P1[11],P1[12],P1[13], pw3[0]=PKW(P1,8), pw3[1]=PKW(P1,10), pw3); \
    VRD(7); SBAR(); GAPA(C1=__builtin_amdgcn_mfma_f32_32x32x16_bf16(kf[7],qr[3],C1,0,0,0),   P1[14],P1[15],0.f,0.f,       pw3[2]=PKW(P1,12),pw3[3]=PKW(P1,14), pw3); \
    l_reg+=(sacc2[0]+sacc2[1]); \
    if(GK){DMA_K((t)+3,sl_cur);} if(GV){DMA_V((t)+1,sl_next);} \
    CMASK(C0,C1,t); \
    resc=false; if(MODE!=2){ float a=MX3(C0[0],C0[1],C1[0]),b=MX3(C0[2],C0[3],C1[1]); a=MX3(a,C1[2],C1[3]); \
      _Pragma("unroll") for(int r=4;r<16;r+=4){a=MX3(a,C0[r],C0[r+1]);b=MX3(b,C0[r+2],C0[r+3]);a=MX3(a,C1[r],C1[r+1]);b=MX3(b,C1[r+2],C1[r+3]);} \
      float rm=__builtin_fmaxf(a,b); { auto rr=__builtin_amdgcn_permlane32_swap(__float_as_uint(rm),__float_as_uint(rm),false,false); rm=__builtin_fmaxf(__uint_as_float(rr[0]),__uint_as_float(rr[1])); } \
      resc=false; \
      if(__builtin_expect(__any(rm>(float)THRL),0)){ const float dl=__builtin_fmaxf(rm,0.f); mhat+=dl; \
        _Pragma("unroll") for(int r=0;r<16;++r){C0[r]-=dl;C1[r]-=dl;} \
        _Pragma("unroll") for(int r=0;r<16;++r)negm[r]=-mhat; asm volatile("":"+v"(negm)); \
        const float f=__builtin_amdgcn_exp2f(-dl); l_reg*=f; if(hi==0)wsf[r32]=f; resc=true; } } \
    SBAR(); \
    GAPB(o[0]=__builtin_amdgcn_mfma_f32_32x32x16_bf16(PAF(0),VFR(0),o[0],0,0,0), C0,0); \
    GAPB(o[1]=__builtin_amdgcn_mfma_f32_32x32x16_bf16(PAF(0),VFR(4),o[1],0,0,0), C0,4); \
    KRD(GL,0); GAPB(o[0]=__builtin_amdgcn_mfma_f32_32x32x16_bf16(PAF(1),VFR(1),o[0],0,0,0), C0,8); \
    KRD(GL,1); GAPB(o[1]=__builtin_amdgcn_mfma_f32_32x32x16_bf16(PAF(1),VFR(5),o[1],0,0,0), C0,12); \
    KRD(GL,2); GAPB(o[0]=__builtin_amdgcn_mfma_f32_32x32x16_bf16(PAF(2),VFR(2),o[0],0,0,0), C1,0); \
    KRD(GL,3); GAPB(o[1]=__builtin_amdgcn_mfma_f32_32x32x16_bf16(PAF(2),VFR(6),o[1],0,0,0), C1,4); \
    GAPB(o[0]=__builtin_amdgcn_mfma_f32_32x32x16_bf16(PAF(3),VFR(3),o[0],0,0,0), C1,8); \
    GAPB(o[1]=__builtin_amdgcn_mfma_f32_32x32x16_bf16(PAF(3),VFR(7),o[1],0,0,0), C1,12); \
    }while(0)
  int t=1;
  for(;t+5<NT;t+=2){
    STEP(pB0,pB1,pA0,pA1,t,true,true,true);     WAIT_BAR(2); RESC(); ROT();
    STEP(pA0,pA1,pB0,pB1,t+1,true,true,true);   WAIT_BAR(2); RESC(); ROT();
  }
  #define ENDW(tt) do{ if((tt)+3<NT){WAIT_BAR(2);} else if((tt)+2<NT){WAIT_BAR(1);} else {WAIT_BAR(0);} }while(0)
  for(;t+1<NT;t+=2){
    STEP(pB0,pB1,pA0,pA1,t,(t+3<NT),(t+1<NT),(t+1<NT));       ENDW(t);   RESC(); ROT();
    STEP(pA0,pA1,pB0,pB1,t+1,(t+4<NT),(t+2<NT),(t+2<NT));     ENDW(t+1); RESC(); ROT();
  }
  STEP(pB0,pB1,pA0,pA1,NT-1,false,false,false); RESC();
  { float sacc=pB0[0]+pB0[1]; _Pragma("unroll") for(int r=2;r<16;++r)sacc+=pB0[r]; _Pragma("unroll") for(int r=0;r<16;++r)sacc+=pB1[r]; l_reg+=sacc;
    pw0=(u32x4){PKW(pB0,0),PKW(pB0,2),PKW(pB0,4),PKW(pB0,6)};pw1=(u32x4){PKW(pB0,8),PKW(pB0,10),PKW(pB0,12),PKW(pB0,14)};pw2=(u32x4){PKW(pB1,0),PKW(pB1,2),PKW(pB1,4),PKW(pB1,6)};pw3=(u32x4){PKW(pB1,8),PKW(pB1,10),PKW(pB1,12),PKW(pB1,14)};
    SBAR(); pv(o,vb0+sl_cur,PAF(0),PAF(1),PAF(2),PAF(3)); }
  #undef PKW
  #undef PAF
  #undef VFR
  #undef PIN
  #undef MX3
  #undef GAPA
  #undef GAPB
  #undef EX
  #undef VRD
  #undef KRD
  #undef STEP
  #undef ENDW
  {auto rr=__builtin_amdgcn_permlane32_swap(__float_as_uint(l_reg),__float_as_uint(l_reg),false,false);l_reg=__uint_as_float(rr[0])+__uint_as_float(rr[1]);}
  if(hi==0)wsf[32+r32]=l_reg;asm volatile("s_waitcnt lgkmcnt(0)":::"memory");
  float rli[16];
  #pragma unroll
  for(int r=0;r<16;++r)rli[r]=__builtin_amdgcn_rcpf(wsf[32+crow(r,hi)]);
  bf16*Ow=Ou+(long)(wid*QBLK)*OP;
  { bf16*stg=(bf16*)(shm+LDS_OST)+wid*2048;
    #pragma unroll
    for(int r=0;r<16;++r){const int orow=crow(r,hi);
      #pragma unroll
      for(int d0=0;d0<2;++d0)stg[orow*64+d0*32+r32]=__float2bfloat16(o[d0][r]*rli[r]);}
    asm volatile("s_waitcnt lgkmcnt(0)":::"memory");
    #pragma unroll
    for(int i=0;i<4;++i){const int row=i*8+(lane>>3),ch=lane&7; const u32x4 v=*(const u32x4*)(stg+row*64+ch*8); ATTN_STORE16(Ow+(long)row*OP+ch*8,v);} }
  asm volatile("s_waitcnt lgkmcnt(0)\n\ts_barrier":::"memory");
  #undef DMA_K
  #undef KROW
  #undef DMA_V
  #undef CMASK
  #undef START
  #undef RESC
  #undef ROT
}
#undef SBAR
#undef WAIT_BAR
}

#define XB_TMO      128
#define XB_XCNT(j)  (256  + 64 * (j))
#define XB_XSUB(j)  (1280 + 64 * (j))
#define XB_XGEN(j)  (2304 + 64 * (j))
#define XB_TOP      3328
#define XB_TOPGEN   3392
#define XCD_BAR_WORDS 3456
#define XB_SPIN_CAP (1u << 18)

__device__ __forceinline__ unsigned xb_ld(unsigned* p)              { return __hip_atomic_load(p, __ATOMIC_RELAXED, __HIP_MEMORY_SCOPE_AGENT); }
__device__ __forceinline__ unsigned xb_add(unsigned* p, unsigned v) { return __hip_atomic_fetch_add(p, v, __ATOMIC_RELAXED, __HIP_MEMORY_SCOPE_AGENT); }
__device__ __forceinline__ unsigned xb_xcc_id() { return (unsigned)__builtin_amdgcn_s_getreg((3 << 11) | 20) & 0xFu; }
#define XB_SPIN(cond, bar) do { unsigned _sp = 0; while (cond) { __builtin_amdgcn_s_sleep(1); \
    if ((++_sp & 255u) == 0u) { if (xb_ld(&(bar)[XB_TMO])) break; if (_sp > XB_SPIN_CAP) { atomicAdd(&(bar)[XB_TMO], 1u); break; } } } } while (0)

struct XcdBarrier {
    unsigned* bar; unsigned x;
    volatile LAS unsigned* st;
};

__device__ __forceinline__ XcdBarrier xcd_barrier_post(unsigned* bar, volatile LAS unsigned* st) {
    XcdBarrier b; b.bar = bar; b.x = xb_xcc_id(); b.st = st;
    if (threadIdx.x == 0) (void)xb_add(&bar[XB_XCNT(b.x)], 1u);
    return b;
}
__device__ __forceinline__ void xcd_barrier_complete(unsigned* bar, unsigned x, unsigned& nloc, unsigned& nx) {
    const unsigned G = gridDim.x * gridDim.y * gridDim.z;
    unsigned sum, cnt, mine, sp = 0u;
    for (;;) {
        sum = 0u; cnt = 0u; mine = 0u;
#pragma unroll
        for (unsigned j = 0; j < 16; ++j) { const unsigned c = xb_ld(&bar[XB_XCNT(j)]); sum += c; cnt += (c > 0u) ? 1u : 0u; mine = (j == x) ? c : mine; }
        if (sum == G) break;
        __builtin_amdgcn_s_sleep(1);
        if ((++sp & 255u) == 0u) { if (xb_ld(&bar[XB_TMO])) break; if (sp > XB_SPIN_CAP) { atomicAdd(&bar[XB_TMO], 1u); break; } }
    }
    nloc = mine > 0u ? mine : 1u; nx = cnt > 0u ? cnt : 1u;
}

__device__ __forceinline__ void xcd_barrier(const XcdBarrier& b) {
    asm volatile("s_waitcnt vmcnt(0)" ::: "memory");
    __syncthreads();
    if (threadIdx.x == 0) {
        unsigned* bar = b.bar;
        __builtin_amdgcn_s_waitcnt(0);
        unsigned nloc = b.st[0], nx = b.st[1];
        if (nloc == 0u) { xcd_barrier_complete(bar, b.x, nloc, nx); b.st[0] = nloc; b.st[1] = nx; }
        const unsigned old = xb_add(&bar[XB_XSUB(b.x)], 1u);
        const unsigned gen = old / nloc;
        if (old + 1u == (gen + 1u) * nloc) {
            __builtin_amdgcn_fence(__ATOMIC_RELEASE, "agent");
            asm volatile("s_waitcnt vmcnt(0)" ::: "memory");
            const unsigned og = xb_add(&bar[XB_TOP], 1u);
            const unsigned tg = og / nx;
            if (og + 1u == (tg + 1u) * nx) xb_add(&bar[XB_TOPGEN], 1u);
            else XB_SPIN(xb_ld(&bar[XB_TOPGEN]) == tg, bar);
            __builtin_amdgcn_fence(__ATOMIC_ACQUIRE, "agent");
            xb_add(&bar[XB_XGEN(b.x)], 1u);
            asm volatile("s_waitcnt vmcnt(0)" ::: "memory");
        } else {
            XB_SPIN(xb_ld(&bar[XB_XGEN(b.x)]) == gen, bar);
            __builtin_amdgcn_fence(__ATOMIC_ACQUIRE, "agent");
            asm volatile("s_waitcnt vmcnt(0)" ::: "memory");
        }
    }
    __syncthreads();
}

__device__ __forceinline__ void sb_arrive(unsigned* ctr, int tid) {
    asm volatile("s_waitcnt vmcnt(0)" ::: "memory");
    __syncthreads();
    if (tid == 0) { __builtin_amdgcn_fence(__ATOMIC_RELEASE, "agent"); asm volatile("s_waitcnt vmcnt(0)" ::: "memory"); (void)xb_add(ctr, 1u); }
}
__device__ __forceinline__ void sb_wait(unsigned* ctr, unsigned need, unsigned* tmo, int tid) {
    if (tid == 0) { unsigned sp = 0u;
        while (xb_ld(ctr) < need) { __builtin_amdgcn_s_sleep(2); if (((++sp) & 1023u) == 0u) { if (xb_ld(tmo)) break; if (sp > (1u << 22)) { atomicAdd(tmo, 1u); break; } } }
        __builtin_amdgcn_fence(__ATOMIC_ACQUIRE, "agent"); asm volatile("s_waitcnt vmcnt(0)" ::: "memory"); }
    __syncthreads();
}

typedef unsigned short bf16_t;
constexpr size_t SZ_WIN = (size_t)INC * DMODEL * 2, SZ_WOUT = (size_t)DMODEL * DMODEL * 2, SZ_WFI = (size_t)2 * FFH * DMODEL * 2, SZ_WFO = (size_t)DMODEL * FFH * 2;
constexpr size_t WS_WIN = 0;
constexpr size_t WS_WOUT = WS_WIN + NLAY * SZ_WIN;
constexpr size_t WS_WFI = WS_WOUT + NLAY * SZ_WOUT;
constexpr size_t WS_WFO = WS_WFI + NLAY * SZ_WFI;
constexpr size_t WS_MOD = WS_WFO + NLAY * SZ_WFO;
constexpr size_t WS_ROPE = WS_MOD + (size_t)NLAY * 9 * MODW * 4;
constexpr size_t WS_HF = WS_ROPE + 64 * 16 * 2 * 4;
constexpr size_t WS_HC = WS_HF + (size_t)NLAY * 256 * 8192 * 2;
constexpr size_t WS_F = WS_HC + (size_t)NLAY * 256 * 512 * 4;
constexpr size_t WS_XN = WS_F + (size_t)256 * 8 * 1024 * 16;
constexpr size_t WS_P = WS_XN + (size_t)MT * DMODEL * 2;
constexpr size_t WS_MIX = WS_P + (size_t)MT * INC * 2;
constexpr size_t WS_XC = WS_MIX + (size_t)MT * DMODEL * 2;
constexpr size_t WS_UT = WS_XC + (size_t)MC * DMODEL * 4;
constexpr size_t WS_X2T = WS_UT + (size_t)NB * 256 * SEQ * 2;
constexpr size_t WS_CTL = WS_X2T + (size_t)NB * 256 * SEQ * 2;
constexpr size_t CTL_BYTES = 65536;
constexpr size_t WS_RSS = WS_CTL + CTL_BYTES;
constexpr size_t WS_CVI = WS_RSS + (size_t)4 * MT * 4;
constexpr size_t WS_CVF = WS_CVI + (size_t)NLAY * 9 * INC * 4;
constexpr size_t WS_YT = WS_CVF + (size_t)NLAY * 9 * 2 * FFH * 4;
constexpr size_t WS_ACTC = WS_YT + (size_t)NB * 256 * SEQ * 2;
constexpr size_t WS_END = WS_ACTC + (size_t)MC * FFH * 2;
static_assert(WS_END <= (size_t)4 * NB * SEQ * DMODEL * 4, "workspace must fit 4x the largest tensor");
static_assert((size_t)MT * FFH * 2 <= (size_t)MT * INC * 2 + (size_t)MT * DMODEL * 2, "ACT overlay");
static_assert(WS_ROPE % 256 == 0 && WS_HF % 256 == 0 && WS_F % 256 == 0 && WS_XN % 256 == 0 && WS_P % 256 == 0 && WS_MIX % 256 == 0 && WS_UT % 256 == 0, "alignment");

constexpr int LDS_BYTES = 147456;
constexpr int NA_BIAS_OFF = 98304;

struct KArgs { const float* in[27]; float* out; unsigned char* ws; };

__device__ __forceinline__ void transpose_item(const float* W, int N, int K, bf16_t* WT, int k0, int n0, int drow0, LAS float* scr, int lane) {
#pragma unroll 8
    for (int i = 0; i < 32; ++i) { const int kk = 2 * i + (lane >> 5); scr[kk * 33 + (lane & 31)] = W[(size_t)(k0 + kk) * N + n0 + (lane & 31)]; }
    asm volatile("s_waitcnt lgkmcnt(0)" ::: "memory");
    const int c = lane & 7;
#pragma unroll
    for (int j = 0; j < 4; ++j) { const int n = (lane >> 3) + 8 * j; const LAS float* s = scr + (8 * c) * 33 + n;
        v4u o; o.x = pk2(s[0 * 33], s[1 * 33]); o.y = pk2(s[2 * 33], s[3 * 33]); o.z = pk2(s[4 * 33], s[5 * 33]); o.w = pk2(s[6 * 33], s[7 * 33]);
        *(v4u*)(WT + (size_t)(drow0 + n) * K + k0 + 8 * c) = o; }
    asm volatile("s_waitcnt lgkmcnt(0)" ::: "memory");
}

__device__ __forceinline__ void norm_row(const float* xrow, const float* g, const float* shift, const float* scale, bf16_t* orow, int lane) {
    const f32x4v* xr = (const f32x4v*)xrow + lane;
    f32x4v v[4]; float s = 0.f;
#pragma unroll
    for (int j = 0; j < 4; ++j) { v[j] = xr[64 * j]; s += (v[j].x * v[j].x + v[j].y * v[j].y) + (v[j].z * v[j].z + v[j].w * v[j].w); }
    const float rstd = rsqrtf(wave_sum(s) * (1.f / DMODEL) + NORM_EPS);
    unsigned long long* o8 = (unsigned long long*)orow + lane;
#pragma unroll
    for (int j = 0; j < 4; ++j) { const f32x4v gg = ((const f32x4v*)g)[lane + 64 * j], sh = ((const f32x4v*)shift)[lane + 64 * j], sc = ((const f32x4v*)scale)[lane + 64 * j];
        const f32x4v y = v[j] * rstd * gg * (sc + 1.0f) + sh;
        o8[64 * j] = (unsigned long long)pk2(y.x, y.y) | ((unsigned long long)pk2(y.z, y.w) << 32); }
}

__device__ __forceinline__ void norm_phase(const float* xl, const float* xc, const float* g, const float* mod, int shoff, int scoff, bf16_t* XN, int mrows, int gw, int NGW, int lane) {
    for (int m = gw; m < mrows; m += NGW) {
        const bool lat = m < ML; const int bidx = lat ? (m >> 12) : 8;
        const float* xrow = lat ? xl + (size_t)m * DMODEL : xc + (size_t)(m - ML) * DMODEL;
        norm_row(xrow, g, mod + (size_t)bidx * MODW + shoff, mod + (size_t)bidx * MODW + scoff, XN + (size_t)m * DMODEL, lane);
    }
}

__device__ __forceinline__ void prep0_phase(const float* xl, const float* xc, const float* g, const float* mod, bf16_t* XN, float* RSS, int gw, int NGW, int lane) {
    for (int m = gw; m < MT; m += NGW) {
        const bool lat = m < ML; const int bidx = lat ? (m >> 12) : 8;
        const float* xrow = lat ? xl + (size_t)m * DMODEL : xc + (size_t)(m - ML) * DMODEL;
        const f32x4v* xr = (const f32x4v*)xrow + lane; const f32x4v* sc = (const f32x4v*)(mod + (size_t)bidx * MODW + DMODEL);
        unsigned long long* o8 = (unsigned long long*)(XN + (size_t)m * DMODEL) + lane;
        float s = 0.f;
#pragma unroll
        for (int j = 0; j < 4; ++j) { const f32x4v v = xr[64 * j]; s += (v.x * v.x + v.y * v.y) + (v.z * v.z + v.w * v.w);
            const f32x4v y = v * ((const f32x4v*)g)[lane + 64 * j] * (sc[lane + 64 * j] + 1.0f);
            o8[64 * j] = (unsigned long long)pk2(y.x, y.y) | ((unsigned long long)pk2(y.z, y.w) << 32); }
        const float tot = wave_sum(s);
        if (lane < 4) RSS[(size_t)lane * MT + m] = (lane == 0) ? tot : 0.f;
    }
}

__device__ __forceinline__ void cvec_phase(const bf16_t* Win_t, const bf16_t* Wfi_t, const float* MOD, float* CVI, float* CVF, LAS unsigned char* lds, int bx, int G, int tid, int wid, int lane) {
    LAS float* sh = (LAS float*)lds;
    for (int l = 0; l < NLAY; ++l) {
        __syncthreads();
        for (int i = tid; i < 2 * 9 * 1024; i += 512) { const int which = i / 9216, rem = i % 9216, b = rem >> 10, k = rem & 1023; sh[i] = MOD[((size_t)l * 9 + b) * MODW + (which ? 3 * DMODEL : 0) + k]; }
        __syncthreads();
        for (int row = bx * 8 + wid; row < INC + 2 * FFH; row += G * 8) {
            const int which = row >= INC, n = which ? row - INC : row;
            const bf16_t* wrow = which ? Wfi_t + ((size_t)l * 2 * FFH + n) * DMODEL : Win_t + ((size_t)l * INC + n) * DMODEL;
            const v4u w0 = *(const v4u*)(wrow + lane * 8), w1 = *(const v4u*)(wrow + 512 + lane * 8);
            float wf[16];
            wf[0] = __builtin_bit_cast(float, w0.x << 16); wf[1] = __builtin_bit_cast(float, w0.x & 0xffff0000u); wf[2] = __builtin_bit_cast(float, w0.y << 16); wf[3] = __builtin_bit_cast(float, w0.y & 0xffff0000u);
            wf[4] = __builtin_bit_cast(float, w0.z << 16); wf[5] = __builtin_bit_cast(float, w0.z & 0xffff0000u); wf[6] = __builtin_bit_cast(float, w0.w << 16); wf[7] = __builtin_bit_cast(float, w0.w & 0xffff0000u);
            wf[8] = __builtin_bit_cast(float, w1.x << 16); wf[9] = __builtin_bit_cast(float, w1.x & 0xffff0000u); wf[10] = __builtin_bit_cast(float, w1.y << 16); wf[11] = __builtin_bit_cast(float, w1.y & 0xffff0000u);
            wf[12] = __builtin_bit_cast(float, w1.z << 16); wf[13] = __builtin_bit_cast(float, w1.z & 0xffff0000u); wf[14] = __builtin_bit_cast(float, w1.w << 16); wf[15] = __builtin_bit_cast(float, w1.w & 0xffff0000u);
            float mine = 0.f;
            for (int b = 0; b < 9; ++b) { const LAS float* p = sh + (which * 9 + b) * 1024 + lane * 8; float sacc = 0.f;
#pragma unroll
                for (int i = 0; i < 8; ++i) sacc += wf[i] * p[i] + wf[8 + i] * p[512 + i];
                sacc = wave_sum(sacc); if (lane == b) mine = sacc; }
            if (lane < 9) { if (which) CVF[((size_t)l * 9 + lane) * (2 * FFH) + n] = mine; else CVI[((size_t)l * 9 + lane) * INC + n] = mine; }
        }
    }
    __syncthreads();
}

__device__ __forceinline__ void fbuild_phase(const bf16_t* Hf, bf16_t* F, int gtid, int gthreads) {
    for (int idx = gtid; idx < 256 * 1024; idx += gthreads) {
        const int c = idx >> 10, qi = idx & 1023, B = 8 * (qi - 512) + 4088;
        const bf16_t* h = Hf + (size_t)c * 8192;
        v4u lo = (v4u){0u, 0u, 0u, 0u}, hi;
        if (B >= 0) lo = *(const v4u*)(h + B);
        hi = *(const v4u*)(h + B + 8);
        if (B == 0) lo.x &= 0xffff0000u;
        if (B == -8) hi.x &= 0xffff0000u;
        const unsigned d[8] = {lo.x, lo.y, lo.z, lo.w, hi.x, hi.y, hi.z, hi.w};
#pragma unroll
        for (int r = 0; r < 8; ++r) { unsigned o[4];
#pragma unroll
            for (int j = 0; j < 4; ++j) { const int e0 = r + 8 - 2 * j, e1 = e0 - 1;
                const unsigned a = (d[e0 >> 1] >> (16 * (e0 & 1))) & 0xffffu, b = (d[e1 >> 1] >> (16 * (e1 & 1))) & 0xffffu; o[j] = a | (b << 16); }
            *(v4u*)(F + (((size_t)(c * 8 + r)) * 1024 + qi) * 8) = (v4u){o[0], o[1], o[2], o[3]}; }
    }
}

__device__ __forceinline__ void filter_rows(const KArgs& a, bf16_t* Hf, float* Hc, int gw, int NGW, int lane) {
    constexpr int R = 8;
    for (int it = gw; it < NLAY * (SEQ + CTX) / R; it += NGW) {
        const int l = it / ((SEQ + CTX) / R), rr = (it % ((SEQ + CTX) / R)) * R; const bool isc = rr >= SEQ; const int t0 = isc ? rr - SEQ : rr, L = isc ? CTX : SEQ;
        float tn[R], z[R], h[R], s[R];
#pragma unroll
        for (int r = 0; r < R; ++r) { const int t = t0 + r; tn[r] = (float)t / (float)(L - 1); const float w = 6.283185307179586f * (float)t / (float)L;
            z[r] = 0.f;
            if (lane == 0) z[r] = tn[r];
            else if (lane <= 16) { const float fr = 1e-4f + (float)(lane - 1) * ((15.0f - 1e-4f) / 15.0f); z[r] = cosf(fr * w); }
            else if (lane <= 32) { const float fr = 1e-4f + (float)(lane - 17) * ((15.0f - 1e-4f) / 15.0f); z[r] = -sinf(fr * w); } }
        const float* w1 = a.in[12] + (size_t)l * 33 * 64; const float* w2 = a.in[14] + (size_t)l * 64 * 64; const float* w3 = a.in[16] + (size_t)l * 64 * 64; const float* wo = a.in[18] + (size_t)l * 64 * 512;
        const float om = a.in[19][l * 64 + lane];
#pragma unroll
        for (int r = 0; r < R; ++r) s[r] = a.in[13][l * 64 + lane];
#pragma unroll 3
        for (int k = 0; k < 33; ++k) { const float wv = w1[k * 64 + lane];
#pragma unroll
            for (int r = 0; r < R; ++r) s[r] += __shfl(z[r], k) * wv; }
#pragma unroll
        for (int r = 0; r < R; ++r) { h[r] = sinf(om * s[r]); s[r] = a.in[15][l * 64 + lane]; }
#pragma unroll 4
        for (int k = 0; k < 64; ++k) { const float wv = w2[k * 64 + lane];
#pragma unroll
            for (int r = 0; r < R; ++r) s[r] += __shfl(h[r], k) * wv; }
#pragma unroll
        for (int r = 0; r < R; ++r) { h[r] = sinf(om * s[r]); s[r] = a.in[17][l * 64 + lane]; }
#pragma unroll 4
        for (int k = 0; k < 64; ++k) { const float wv = w3[k * 64 + lane];
#pragma unroll
            for (int r = 0; r < R; ++r) s[r] += __shfl(h[r], k) * wv; }
#pragma unroll
        for (int r = 0; r < R; ++r) h[r] = sinf(om * s[r]);
        float o[R][8];
#pragma unroll
        for (int r = 0; r < R; ++r)
#pragma unroll
            for (int i = 0; i < 8; ++i) o[r][i] = 0.f;
#pragma unroll 2
        for (int k = 0; k < 64; ++k) { float hk[R];
#pragma unroll
            for (int r = 0; r < R; ++r) hk[r] = __shfl(h[r], k);
#pragma unroll
            for (int i = 0; i < 8; ++i) { const float wv = wo[k * 512 + lane + 64 * i];
#pragma unroll
                for (int r = 0; r < R; ++r) o[r][i] += hk[r] * wv; } }
        const float d0 = -4.605170185988091f / 1.5f, d1 = -4.605170185988091f / 0.3f;
#pragma unroll
        for (int i = 0; i < 8; ++i) { const int n = lane + 64 * i, c = n & 255; const bool bwd = n >= 256;
            const float delta = d0 + (float)c * ((d1 - d0) / 255.0f);
#pragma unroll
            for (int r = 0; r < R; ++r) { const int t = t0 + r; const float val = o[r][i] * expf(-tn[r] * fabsf(delta));
                if (!bwd || t > 0) { if (isc) Hc[((size_t)l * 256 + c) * 512 + 256 + (bwd ? -t : t)] = val; else Hf[((size_t)l * 256 + c) * 8192 + 4096 + (bwd ? -t : t)] = (bf16_t)f2bf((t == 0) ? val + a.in[20][l * 256 + c] : val); } } }
    }
}

__device__ __forceinline__ void mod_phase(const KArgs& a, float* MOD, LAS unsigned char* lds, int bx, int G, int tid, int wid, int lane) {
    LAS float* sc = (LAS float*)lds;
    LAS float* red = (LAS float*)(lds + 9 * 1024 * 4);
    for (int i = tid; i < 9 * 1024; i += 512) { const float x = (i < 8 * 1024) ? a.in[1][i] : a.in[3][i - 8 * 1024]; sc[i] = x / (1.0f + __expf(-x)); }
    __syncthreads();
    for (int u = bx; u < NLAY * (MODW / 64); u += G) {
        const int l = u / (MODW / 64), n0 = (u % (MODW / 64)) * 64;
        const float* W = a.in[4] + (size_t)l * DMODEL * MODW + n0 + lane;
        float acc[9];
#pragma unroll
        for (int j = 0; j < 9; ++j) acc[j] = 0.f;
        for (int k = wid * 128; k < wid * 128 + 128; ++k) { const float wv = W[(size_t)k * MODW];
#pragma unroll
            for (int j = 0; j < 9; ++j) acc[j] += sc[j * 1024 + k] * wv; }
#pragma unroll
        for (int j = 0; j < 9; ++j) red[(wid * 9 + j) * 64 + lane] = acc[j];
        __syncthreads();
        for (int i = tid; i < 9 * 64; i += 512) { const int j = i >> 6, c = i & 63; float s = a.in[5][(size_t)l * MODW + n0 + c];
#pragma unroll
            for (int w = 0; w < 8; ++w) s += red[(w * 9 + j) * 64 + c];
            MOD[((size_t)l * 9 + j) * MODW + n0 + c] = s; }
        __syncthreads();
    }
}

__device__ __forceinline__ void hy_prep_unit(const bf16_t* P, const float* cw, const float* cb, bf16_t* UT, bf16_t* X2T, int b, int s0, int c0, LAS unsigned char* lds, int tid) {
    LAS float* in = (LAS float*)lds;
    for (int idx = tid; idx < 3 * 66 * 8; idx += 512) {
        const int sec = idx / (66 * 8), rem = idx % (66 * 8), rr = rem >> 3, ch = rem & 7, s = s0 - 1 + rr;
        v4u raw = (v4u){0u, 0u, 0u, 0u};
        if (s >= 0 && s < SEQ) raw = *(const v4u*)(P + (size_t)(b * SEQ + s) * INC + sec * 256 + c0 + ch * 8);
        LAS float* d = in + (sec * 66 + rr) * 65 + ch * 8;
        d[0] = __builtin_bit_cast(float, raw.x << 16); d[1] = __builtin_bit_cast(float, raw.x & 0xffff0000u);
        d[2] = __builtin_bit_cast(float, raw.y << 16); d[3] = __builtin_bit_cast(float, raw.y & 0xffff0000u);
        d[4] = __builtin_bit_cast(float, raw.z << 16); d[5] = __builtin_bit_cast(float, raw.z & 0xffff0000u);
        d[6] = __builtin_bit_cast(float, raw.w << 16); d[7] = __builtin_bit_cast(float, raw.w & 0xffff0000u);
    }
    __syncthreads();
    {
        const int c = tid >> 3, k = tid & 7;
        float w[3][3], bb[3];
#pragma unroll
        for (int sec = 0; sec < 3; ++sec) { bb[sec] = cb[sec * 256 + c0 + c];
#pragma unroll
            for (int i = 0; i < 3; ++i) w[sec][i] = cw[i * 768 + sec * 256 + c0 + c]; }
        float vv[8], x2[8];
#pragma unroll
        for (int i = 0; i < 8; ++i) { const int rr = k * 8 + i; float cv[3];
#pragma unroll
            for (int sec = 0; sec < 3; ++sec) { const LAS float* p = in + (sec * 66 + rr) * 65 + c; cv[sec] = w[sec][0] * p[0] + w[sec][1] * p[65] + w[sec][2] * p[130] + bb[sec]; }
            vv[i] = cv[0] * cv[1]; x2[i] = cv[2]; }
        const size_t o = ((size_t)(b * 256 + c0 + c)) * SEQ + s0 + k * 8;
        v4u a; a.x = pk2(vv[0], vv[1]); a.y = pk2(vv[2], vv[3]); a.z = pk2(vv[4], vv[5]); a.w = pk2(vv[6], vv[7]); *(v4u*)(UT + o) = a;
        v4u d; d.x = pk2(x2[0], x2[1]); d.y = pk2(x2[2], x2[3]); d.z = pk2(x2[4], x2[5]); d.w = pk2(x2[6], x2[7]); *(v4u*)(X2T + o) = d;
    }
    __syncthreads();
}

constexpr int HY_PB = 5904;
__device__ __forceinline__ void hy_conv_unit(const bf16_t* UT, const bf16_t* F, bf16_t* YT, int c, LAS unsigned char* lds, int tid, int wid, int lane) {
    LAS bf16_t* U = (LAS bf16_t*)lds;
    { const unsigned z = (unsigned)opq(0);
      for (int i = tid; i < NB * HY_PB / 8; i += 512) ((LAS v4u*)U)[i] = (v4u){z, z, z, z}; }
    __syncthreads();
    for (int i = tid; i < NB * SEQ / 8; i += 512) { const int b = i >> 9, s = (i & 511) * 8, sp = s + 768;
        const v4u raw = *(const v4u*)(UT + ((size_t)(b * 256 + c)) * SEQ + s);
        *(LAS v4u*)(U + b * HY_PB + sp + 8 * (sp >> 8)) = raw; }
    __syncthreads();
    const int rp = wid & 3, gh = wid >> 2, mp = lane & 31, g = lane >> 5, bq = lane & 7, isub = (lane >> 3) & 3;
    const bf16x8v* F0 = (const bf16x8v*)F + ((size_t)(c * 8 + 2 * rp)) * 1024; const bf16x8v* F1 = F0 + 1024;
    f32x16 acc[2][2];
#pragma unroll
    for (int i = 0; i < 2; ++i)
#pragma unroll
        for (int j = 0; j < 2; ++j)
#pragma unroll
            for (int r = 0; r < 16; ++r) acc[i][j][r] = 0.f;
    const int G0 = 2 * gh, jlo = 64 * G0 - 255, jhi = 64 * (G0 + 1) + 48;
    const LAS bf16_t* Ub = U + bq * HY_PB;
    constexpr int PF = 4;
    bf16x8v a0b[PF], a1b[PF];
    const int qbase = mp - g + 512;
#pragma unroll
    for (int p = 0; p < PF; ++p) { a0b[p] = F0[2 * (jlo + p) + qbase]; a1b[p] = F1[2 * (jlo + p) + qbase]; }
#define HY_STEP(D0, D1) do { const int j = j0 + p; const bf16x8v a0 = a0b[p], a1 = a1b[p]; \
        { int jn = j + PF; jn = jn > jhi ? jhi : jn; a0b[p] = F0[2 * jn + qbase]; a1b[p] = F1[2 * jn + qbase]; } \
        if (D0) { const int sp = 256 * (4 * G0 + isub) + 8 * g + 768 - 16 * j; const bf16x8v bf = *(const LAS bf16x8v*)(Ub + sp + 8 * (sp >> 8)); \
            acc[0][0] = __builtin_amdgcn_mfma_f32_32x32x16_bf16(a0, bf, acc[0][0], 0, 0, 0); acc[1][0] = __builtin_amdgcn_mfma_f32_32x32x16_bf16(a1, bf, acc[1][0], 0, 0, 0); } \
        if (D1) { const int sp = 256 * (4 * (G0 + 1) + isub) + 8 * g + 768 - 16 * j; const bf16x8v bf = *(const LAS bf16x8v*)(Ub + sp + 8 * (sp >> 8)); \
            acc[0][1] = __builtin_amdgcn_mfma_f32_32x32x16_bf16(a0, bf, acc[0][1], 0, 0, 0); acc[1][1] = __builtin_amdgcn_mfma_f32_32x32x16_bf16(a1, bf, acc[1][1], 0, 0, 0); } } while (0)
    for (int j0 = jlo; j0 < jlo + 64; j0 += PF) {
#pragma unroll
        for (int p = 0; p < PF; ++p) HY_STEP(true, false); }
    for (int j0 = jlo + 64; j0 <= jhi - 64; j0 += PF) {
#pragma unroll
        for (int p = 0; p < PF; ++p) HY_STEP(true, true); }
    for (int j0 = jhi - 63; j0 <= jhi; j0 += PF) {
#pragma unroll
        for (int p = 0; p < PF; ++p) HY_STEP(false, true); }
#undef HY_STEP
    __syncthreads();
    LAS bf16_t* Y = (LAS bf16_t*)lds;
    for (int re_ = 0; re_ < PR_HYEPI; ++re_) {
#pragma unroll
    for (int ri = 0; ri < 2; ++ri)
#pragma unroll
        for (int gi = 0; gi < 2; ++gi) { const int r = 2 * rp + ri, I = 4 * (G0 + gi) + isub;
#pragma unroll
            for (int reg = 0; reg < 16; ++reg) { const int m = (reg & 3) + 8 * (reg >> 2) + 4 * g, t = 256 * I + 8 * m + r;
                Y[bq * (SEQ + 136) + t + 8 * I] = (bf16_t)f2bf(acc[ri][gi][reg]); } }
    __syncthreads();
    for (int i = tid; i < NB * SEQ / 8; i += 512) { const int b = i >> 9, t = (i & 511) * 8;
        *(v4u*)(YT + ((size_t)(b * 256 + c)) * SEQ + t) = *(const LAS v4u*)(Y + b * (SEQ + 136) + t + 8 * (t >> 8)); }
    }
    __syncthreads();
}

__device__ __forceinline__ void hy_post_unit(const bf16_t* YT, const bf16_t* X2T, bf16_t* MIX, int b, int t0, LAS unsigned char* lds, int tid) {
    LAS bf16_t* T = (LAS bf16_t*)lds;
#pragma unroll
    for (int k = 0; k < 4; ++k) { const int idx = tid + 512 * k, c = idx >> 3, ch = idx & 7;
        const size_t o = ((size_t)(b * 256 + c)) * SEQ + t0 + ch * 8;
        const v4u y = *(const v4u*)(YT + o), x = *(const v4u*)(X2T + o);
        const unsigned yy[4] = {y.x, y.y, y.z, y.w}, xx[4] = {x.x, x.y, x.z, x.w};
#pragma unroll
        for (int e = 0; e < 4; ++e) { const float lo = __builtin_bit_cast(float, yy[e] << 16) * __builtin_bit_cast(float, xx[e] << 16), hi = __builtin_bit_cast(float, yy[e] & 0xffff0000u) * __builtin_bit_cast(float, xx[e] & 0xffff0000u);
            T[(ch * 8 + 2 * e) * 260 + c] = (bf16_t)f2bf(lo); T[(ch * 8 + 2 * e + 1) * 260 + c] = (bf16_t)f2bf(hi); } }
    __syncthreads();
#pragma unroll
    for (int k = 0; k < 4; ++k) { const int idx = tid + 512 * k, t = idx >> 5, ch = idx & 31;
        const LAS v2u* p = (const LAS v2u*)(T + t * 260 + ch * 8); const v2u a = p[0], d = p[1];
        *(v4u*)(MIX + (size_t)(b * SEQ + t0 + t) * DMODEL + ch * 8) = (v4u){a.x, a.y, d.x, d.y}; }
    __syncthreads();
}

__device__ __forceinline__ void hy_ctx_unit(const bf16_t* P, const float* cw, const float* cb, const float* Hc, const float* skip, bf16_t* MIX, int b, int c0, LAS unsigned char* lds, int tid) {
    LAS float* vv = (LAS float*)lds;
    LAS float* fc = vv + 256 * 17;
    const int c = tid & 15, tq = tid >> 4;
    const bf16_t* Pb = P + (size_t)(ML + b * CTX) * INC;
    float w[3][3], bb[3];
#pragma unroll
    for (int sec = 0; sec < 3; ++sec) { bb[sec] = cb[sec * 256 + c0 + c];
#pragma unroll
        for (int i = 0; i < 3; ++i) w[sec][i] = cw[i * 768 + sec * 256 + c0 + c]; }
#pragma unroll 2
    for (int i = 0; i < 8; ++i) { const int s = tq + 32 * i; float cv[2];
#pragma unroll
        for (int sec = 0; sec < 2; ++sec) { float x = bb[sec];
#pragma unroll
            for (int k = 0; k < 3; ++k) { const int ss = s - 1 + k; if (ss >= 0 && ss < CTX) x += w[sec][k] * bf2f(Pb[(size_t)ss * INC + sec * 256 + c0 + c]); }
            cv[sec] = x; }
        vv[s * 17 + c] = cv[0] * cv[1]; }
    for (int i = tid; i < 16 * 512; i += 512) { const int cc = i >> 9, id = i & 511; float x = (id >= 1) ? Hc[(size_t)(c0 + cc) * 512 + id] : 0.f; if (id == 256) x += skip[c0 + cc]; fc[cc * 513 + id] = x; }
    __syncthreads();
    float acc[8];
#pragma unroll
    for (int i = 0; i < 8; ++i) acc[i] = 0.f;
    const LAS float* fcc = fc + c * 513 + 256 + tq;
    for (int s = 0; s < CTX; ++s) { const float v = vv[s * 17 + c];
#pragma unroll
        for (int i = 0; i < 8; ++i) acc[i] += v * fcc[32 * i - s]; }
#pragma unroll 2
    for (int i = 0; i < 8; ++i) { const int t = tq + 32 * i; float x = bb[2];
#pragma unroll
        for (int k = 0; k < 3; ++k) { const int ss = t - 1 + k; if (ss >= 0 && ss < CTX) x += w[2][k] * bf2f(Pb[(size_t)ss * INC + 512 + c0 + c]); }
        MIX[(size_t)(ML + b * CTX + t) * DMODEL + c0 + c] = (bf16_t)f2bf(x * acc[i]); }
    __syncthreads();
}

__global__ void __launch_bounds__(512, 2) hybrid_fwd(KArgs a) {
    extern __shared__ __attribute__((aligned(16))) unsigned char lds_raw[];
    LAS unsigned char* lds = (LAS unsigned char*)lds_raw;
    cg::grid_group grid = cg::this_grid();
    const int tid = threadIdx.x, lane = tid & 63, wid = __builtin_amdgcn_readfirstlane(tid >> 6);
    const int G = gridDim.x, bx = blockIdx.x, gw = bx * 8 + wid, NGW = G * 8, gtid = bx * 512 + tid, gthreads = G * 512;
    unsigned char* ws = a.ws;
    bf16_t* Win_t = (bf16_t*)(ws + WS_WIN); bf16_t* Wout_t = (bf16_t*)(ws + WS_WOUT); bf16_t* Wfi_t = (bf16_t*)(ws + WS_WFI); bf16_t* Wfo_t = (bf16_t*)(ws + WS_WFO);
    float* MOD = (float*)(ws + WS_MOD); float* ROPE = (float*)(ws + WS_ROPE); bf16_t* Hf = (bf16_t*)(ws + WS_HF); float* Hc = (float*)(ws + WS_HC);
    bf16_t* F = (bf16_t*)(ws + WS_F); bf16_t* XN = (bf16_t*)(ws + WS_XN); bf16_t* P = (bf16_t*)(ws + WS_P); bf16_t* MIX = (bf16_t*)(ws + WS_MIX); bf16_t* ACT = (bf16_t*)(ws + WS_P);
    float* XC = (float*)(ws + WS_XC); bf16_t* UT = (bf16_t*)(ws + WS_UT); bf16_t* X2T = (bf16_t*)(ws + WS_X2T); bf16_t* YT = (bf16_t*)(ws + WS_YT);
    float* XL = a.out;
    float* RSS = (float*)(ws + WS_RSS); float* CVI = (float*)(ws + WS_CVI); float* CVF = (float*)(ws + WS_CVF);
    volatile LAS unsigned* xst = (volatile LAS unsigned*)(lds + LDS_BYTES - 64);
    if (tid < 16) xst[tid] = 0u;
    __syncthreads();
    XcdBarrier xbar = xcd_barrier_post((unsigned*)(ws + WS_CTL), xst);

    for (int rp0_ = 0; rp0_ < PR_P0; ++rp0_) {
        LAS float* scr = (LAS float*)(lds + 65536 + wid * 8704);
        constexpr int I_IN = (DMODEL / 64) * (INC / 32), I_OUT = (DMODEL / 64) * (DMODEL / 32), I_FI = (DMODEL / 64) * (2 * FFH / 32), I_FO = (FFH / 64) * (DMODEL / 32);
        constexpr int I_L = I_IN + I_OUT + I_FI + I_FO;
        for (int it = gw; it < NLAY * I_L; it += NGW) {
            const int l = it / I_L; int r = it % I_L;
            if (r < I_IN) { const int nblk = INC / 32, kb = r / nblk, n0 = (r % nblk) * 32; const int pn = n0 >> 8, wc = (n0 & 255) >> 6, bj = (n0 & 63) >> 5;
                transpose_item(a.in[8] + (size_t)l * DMODEL * INC, INC, DMODEL, Win_t + (size_t)l * INC * DMODEL, kb * 64, n0, pn * 256 + bj * 128 + wc * 32, scr, lane); continue; }
            r -= I_IN;
            if (r < I_OUT) { const int nblk = DMODEL / 32, kb = r / nblk, n0 = (r % nblk) * 32;
                transpose_item(a.in[9] + (size_t)l * DMODEL * DMODEL, DMODEL, DMODEL, Wout_t + (size_t)l * DMODEL * DMODEL, kb * 64, n0, n0, scr, lane); continue; }
            r -= I_OUT;
            if (r < I_FI) { const int nblk = 2 * FFH / 32, kb = r / nblk, n0 = (r % nblk) * 32; const int half = n0 / FFH, idx = n0 % FFH, pn = idx >> 7, jj = idx & 127;
                transpose_item(a.in[24] + (size_t)l * DMODEL * 2 * FFH, 2 * FFH, DMODEL, Wfi_t + (size_t)l * 2 * FFH * DMODEL, kb * 64, n0, pn * 256 + half * 128 + jj, scr, lane); continue; }
            r -= I_FI;
            { const int nblk = DMODEL / 32, kb = r / nblk, n0 = (r % nblk) * 32;
                transpose_item(a.in[25] + (size_t)l * FFH * DMODEL, DMODEL, FFH, Wfo_t + (size_t)l * DMODEL * FFH, kb * 64, n0, n0, scr, lane); }
        }
        __syncthreads();
        mod_phase(a, MOD, lds, bx, G, opq(tid), wid, opq(lane));
        filter_rows(a, Hf, Hc, gw, NGW, opq(lane));
        for (int i = gtid; i < 64 * 16; i += gthreads) { const int pos = i >> 4, f = i & 15; const float inv = powf(10000.0f, -(float)f / 16.0f), ang = (float)pos * inv; ROPE[2 * i] = cosf(ang); ROPE[2 * i + 1] = sinf(ang); }
    }
    grid.sync();
    prep0_phase(a.in[0], a.in[2], a.in[6], MOD, XN, RSS, gw, NGW, opq(lane));
    fbuild_phase(Hf, F, opq(gtid), gthreads);
    cvec_phase(Win_t, Wfi_t, MOD, CVI, CVF, lds, bx, G, opq(tid), wid, opq(lane));
    GSYNC();

#pragma nounroll
    for (int l = 0; l < NLAY; ++l) {
        const bool last = (l == NLAY - 1);
        const float* modl = MOD + (size_t)l * 9 * MODW;
        const float* xl_in = (l == 0) ? a.in[0] : XL; const float* xc_in = (l == 0) ? a.in[2] : XC;
        { pg8::Gemm g{XN, Win_t + (size_t)l * INC * DMODEL, MT, INC, DMODEL}; pg8::StaticOrder S; S.init(MT, INC, G, bx);
          pg8::EpiInProj E{P, a.in[21] + l * 64, a.in[22] + l * 64, ROPE, RSS, CVI + (size_t)l * 9 * INC};
          pg8::gemm_phase<pg8::EpiInProj, pg8::StaticOrder, true, true>(lds, g, S, E); }
        GSYNC();
        {
            const attn_body::bf16* Pb = (const attn_body::bf16*)P; attn_body::bf16* Mb = (attn_body::bf16*)MIX;
            unsigned* cbase = (unsigned*)(ws + WS_CTL) + 4096 + 2048 * l;
            unsigned* ctrA = cbase; unsigned* ctrB = cbase + 64; unsigned* ctrC = cbase + 128; unsigned* cnt4c = cbase + 192; unsigned* cnt6c = cbase + 192 + 8 * 64; unsigned* tmo = (unsigned*)(ws + WS_CTL) + XB_TMO;
            float fixm;
            { const int ln_ = opq(lane); float mq = fabsf(a.in[21][l * 64 + ln_]), mk = fabsf(a.in[22][l * 64 + ln_]);
#pragma unroll
              for (int o_ = 1; o_ < 64; o_ <<= 1) { mq = fmaxf(mq, __shfl_xor(mq, o_)); mk = fmaxf(mk, __shfl_xor(mk, o_)); }
              fixm = fminf(64.0f * QSCALE * 1.015f * mq * mk, 60.0f); }
            const bf16_t* ACTCv = (const bf16_t*)(ws + WS_ACTC) - (size_t)ML * FFH;
            for (int u = bx; u < NB * 64 * 4; u += G) { const int b = u & 7, cgp = (u >> 3) & 3, sc = u >> 5;
                hy_prep_unit(P, a.in[10] + (size_t)l * 3 * 768, a.in[11] + (size_t)l * 768, UT, X2T, b, sc * 64, cgp * 64, lds, opq(tid)); }
            sb_arrive(ctrA, opq(tid));
            if (!last) { for (int vv_ = bx; vv_ < 256; vv_ += G) { const int v = (G == 256) ? (vv_ >= 240 ? vv_ - 240 : (vv_ < 208 ? vv_ + 16 : 1000)) : vv_; if (v >= 224) continue;
                if (v < 64) { const int b = v & 7, h = v >> 3, kvh = h >> 2;
                    attn_body::attn_unit<8, 2>(Pb + (size_t)(ML + b * CTX) * INC + 768 + h * 64, Pb + 1280 + kvh * 64, Pb + 1408 + kvh * 64,
                        Mb + (size_t)(ML + b * CTX) * DMODEL + 256 + h * 64, ML + b * CTX, 0, 0, 4, 0, 0, nullptr, (char*)lds_raw, fixm);
                } else if (v < 96) { const int w = v - 64, b = w & 7, h = w >> 3;
                    attn_body::attn_unit<8, 0>(Pb + (size_t)(ML + b * CTX) * INC + 1536 + h * 64, Pb + 1792 + h * 64, Pb + 2048 + h * 64,
                        Mb + (size_t)(ML + b * CTX) * DMODEL + 768 + h * 64, ML + b * CTX, 0, 0, 4, 0, 0, nullptr, (char*)lds_raw);
                } else { const int w = v - 96, b = w & 7, cgp = w >> 3;
                    hy_ctx_unit(P, a.in[10] + (size_t)l * 3 * 768, a.in[11] + (size_t)l * 768, Hc + (size_t)l * 256 * 512, a.in[20] + l * 256, MIX, b, cgp * 16, lds, opq(tid)); }
            }
              sb_arrive(ctrC, opq(tid)); }
#define GQA_UNIT(u) do { const int b = (u) & 7, idx = (u) >> 3, h = idx >> 4, qb = idx & 15, kvh = h >> 2; \
                attn_body::attn_unit<8, 2>(Pb + (size_t)(b * SEQ + qb * 256) * INC + 768 + h * 64, Pb + 1280 + kvh * 64, Pb + 1408 + kvh * 64, \
                    Mb + (size_t)(b * SEQ + qb * 256) * DMODEL + 256 + h * 64, ML + b * CTX, b * SEQ, 1 << 20, 68, 0, 0, nullptr, (char*)lds_raw, fixm); } while (0)
            for (int u = bx; u < 512; u += G) GQA_UNIT(u);
            if (!last) for (int v = bx; v < 32; v += G) { const int pb = v >> 2;
                sb_wait(ctrC, (unsigned)G, tmo, opq(tid));
                pg8::Gemm g{MIX, Wout_t + (size_t)l * DMODEL * DMODEL, MT, DMODEL, DMODEL}; pg8::OneUnit S{ML / 256 + pb, v & 3};
                pg8::EpiResid E{xl_in, xc_in, XL, XC, modl + 2 * DMODEL, XN, RSS, a.in[7] + l * DMODEL, modl + 4 * DMODEL, 1, (LAS float*)(lds + 131072)};
                pg8::gemm_phase<pg8::EpiResid, pg8::OneUnit, true, true>(lds, g, S, E);
                sb_arrive(cnt4c + 64 * pb, opq(tid)); }
            sb_wait(ctrA, (unsigned)G, tmo, opq(tid));
            for (int c = bx; c < 256; c += G) hy_conv_unit(UT, F, YT, c, lds, opq(tid), wid, opq(lane));
            sb_arrive(ctrB, opq(tid));
            if (!last) for (int v = bx; v < 208; v += G) if (v >= 32) { const int w = v - 32, pb = w / 22, pn = w % 22;
                sb_wait(cnt4c + 64 * pb, 4u, tmo, opq(tid));
                pg8::Gemm g{XN, Wfi_t + (size_t)l * 2 * FFH * DMODEL, MT, 2 * FFH, DMODEL}; pg8::OneUnit S{ML / 256 + pb, pn};
                pg8::EpiSwiglu E{(bf16_t*)ACTCv, RSS, CVF + (size_t)l * 9 * 2 * FFH};
                pg8::gemm_phase<pg8::EpiSwiglu, pg8::OneUnit, true, true>(lds, g, S, E);
                sb_arrive(cnt6c + 64 * pb, opq(tid)); }
            for (int u = 512 + bx; u < 1024; u += G) GQA_UNIT(u);
#undef GQA_UNIT
            const bool bal = (!last && G == 256);
            const int n_na = !bal ? ((512 - bx + G - 1) / G) : (bx >= 240 ? 4 : (bx >= 208 ? 1 : 2));
            for (int ii = 0; ii < n_na; ++ii) {
                const int v = !bal ? (bx + ii * G) : (ii < 2 ? bx + ii * 256 : 256 + 208 + 2 * (bx - 240) + (ii - 2));
                const int b = v & 7, idx = v >> 3, h = idx >> 4, qg = idx & 15;
                int r0 = 4 * qg - 4; r0 = r0 < 0 ? 0 : (r0 > 56 ? 56 : r0);
                LAS float* bias = (LAS float*)(lds + NA_BIAS_OFF);
                for (int i = opq(tid); i < 15 * 31; i += 512) bias[i] = a.in[23][((size_t)l * 4 + h) * 465 + i] * LOG2E;
                __syncthreads();
                attn_body::attn_unit<8, 1>(Pb + (size_t)(b * SEQ + qg * 256) * INC + 1536 + h * 64, Pb + 1792 + h * 64, Pb + 2048 + h * 64,
                    Mb + (size_t)(b * SEQ + qg * 256) * DMODEL + 768 + h * 64, ML + b * CTX, b * SEQ + r0 * 64, 63 - r0, 16, r0, 4 * qg, (const float*)(lds_raw + NA_BIAS_OFF), (char*)lds_raw);
            }
            if (!last) for (int v = bx; v < 240; v += G) if (v >= 208) { const int w = v - 208, pb = w >> 2;
                sb_wait(cnt6c + 64 * pb, 22u, tmo, opq(tid));
                pg8::Gemm g{ACTCv, Wfo_t + (size_t)l * DMODEL * FFH, MT, DMODEL, FFH}; pg8::OneUnit S{ML / 256 + pb, w & 3};
                pg8::EpiResid E{XL, XC, XL, XC, modl + 5 * DMODEL, XN, RSS, a.in[6] + (l + 1) * DMODEL, MOD + (size_t)(l + 1) * 9 * MODW + DMODEL, 1, (LAS float*)(lds + 131072)};
                pg8::gemm_phase<pg8::EpiResid, pg8::OneUnit, true, true>(lds, g, S, E); }
            sb_wait(ctrB, (unsigned)G, tmo, opq(tid));
            for (int u = bx; u < NB * 64; u += G) hy_post_unit(YT, X2T, MIX, u & 7, (u >> 3) * 64, lds, opq(tid));
        }
        GSYNC();
        const int mrows = ML;
        if (!last) fbuild_phase(Hf + (size_t)(l + 1) * 256 * 8192, F, opq(gtid), gthreads);
        { pg8::Gemm g{MIX, Wout_t + (size_t)l * DMODEL * DMODEL, mrows, DMODEL, DMODEL}; pg8::StaticOrder S; S.init(mrows, DMODEL, G, bx);
          pg8::EpiResid E{xl_in, xc_in, XL, XC, modl + 2 * DMODEL, XN, RSS, a.in[7] + l * DMODEL, modl + 4 * DMODEL, 1, (LAS float*)(lds + 131072)};
          pg8::gemm_phase<pg8::EpiResid, pg8::StaticOrder, true, true>(lds, g, S, E); }
        GSYNC();
        { pg8::Gemm g{XN, Wfi_t + (size_t)l * 2 * FFH * DMODEL, mrows, 2 * FFH, DMODEL}; pg8::StaticOrder S; S.init(mrows, 2 * FFH, G, bx);
          pg8::EpiSwiglu E{ACT, RSS, CVF + (size_t)l * 9 * 2 * FFH};
          for (int rf_ = 0; rf_ < PR_FFI; ++rf_) pg8::gemm_phase<pg8::EpiSwiglu, pg8::StaticOrder, true, true>(lds, g, S, E); }
        GSYNC();
        { pg8::Gemm g{ACT, Wfo_t + (size_t)l * DMODEL * FFH, mrows, DMODEL, FFH}; pg8::StaticOrder S; S.init(mrows, DMODEL, G, bx);
          pg8::EpiResid E{XL, XC, XL, XC, modl + 5 * DMODEL, XN, RSS, a.in[6] + (last ? l : l + 1) * DMODEL, MOD + (size_t)(last ? l : l + 1) * 9 * MODW + DMODEL, last ? 0 : 1, (LAS float*)(lds + 131072)};
          pg8::gemm_phase<pg8::EpiResid, pg8::StaticOrder, true, true>(lds, g, S, E); }
        GSYNC();
    }
    for (int m = gw; m < ML; m += NGW) { const int lane_o = opq(lane); f32x4v* xr = (f32x4v*)(XL + (size_t)m * DMODEL) + lane_o; f32x4v v[4]; float s = 0.f;
#pragma unroll
        for (int j = 0; j < 4; ++j) { v[j] = xr[64 * j]; s += (v[j].x * v[j].x + v[j].y * v[j].y) + (v[j].z * v[j].z + v[j].w * v[j].w); }
        const float rstd = rsqrtf(wave_sum(s) * (1.f / DMODEL) + NORM_EPS);
#pragma unroll
        for (int j = 0; j < 4; ++j) xr[64 * j] = v[j] * rstd * ((const f32x4v*)a.in[26])[lane_o + 64 * j]; }
}

extern "C" void kernel_launch(void* const* d_in, const int* in_sizes, int n_in, void* d_out, int out_size, void* d_ws, size_t ws_size, hipStream_t stream) {
    static int grid_blocks = 0;
    if (grid_blocks == 0) {
        if (n_in != 27 || ws_size < WS_END) { fprintf(stderr, "kernel_launch: expected 27 inputs and >= %zu bytes of workspace (got %d, %zu)\n", (size_t)WS_END, n_in, ws_size); grid_blocks = -1; return; }
        int dev = 0, cus = 0, per_cu = 0;
        hipGetDevice(&dev); hipDeviceGetAttribute(&cus, hipDeviceAttributeMultiprocessorCount, dev);
        hipFuncSetAttribute((const void*)hybrid_fwd, hipFuncAttributeMaxDynamicSharedMemorySize, LDS_BYTES);
        hipOccupancyMaxActiveBlocksPerMultiprocessor(&per_cu, (const void*)hybrid_fwd, 512, LDS_BYTES);
        if (per_cu < 1) per_cu = 1;
        grid_blocks = cus * per_cu;
        (void)hipGetLastError();
    }
    if (grid_blocks < 0) return;
    if (hipMemsetAsync((char*)d_ws + WS_CTL, 0, CTL_BYTES, stream) != hipSuccess) { fprintf(stderr, "kernel_launch: memset of the barrier words failed\n"); return; }
    KArgs a{};
    for (int i = 0; i < 27; ++i) a.in[i] = (const float*)d_in[i];
    a.out = (float*)d_out; a.ws = (unsigned char*)d_ws;
    void* args[] = {&a};
    hipError_t e = hipLaunchCooperativeKernel((const void*)hybrid_fwd, dim3(grid_blocks), dim3(512), args, LDS_BYTES, stream);
    if (e != hipSuccess) fprintf(stderr, "cooperative launch failed: %s (grid %d)\n", hipGetErrorString(e), grid_blocks);
}
```

```cpp
#include <hip/hip_runtime.h>
#include <hip/hip_bf16.h>
#include <hip/hip_cooperative_groups.h>
#include <cstdio>
#include <cstdint>
#include <cmath>
namespace cg = cooperative_groups;
#ifndef PR_SYNC
#define PR_SYNC 1
#endif
#ifndef PR_MIX
#define PR_MIX 1
#endif
#ifndef PR_HY
#define PR_HY 1
#endif
#ifndef PR_HYEPI
#define PR_HYEPI 1
#endif
#ifndef PR_P0
#define PR_P0 1
#endif
#ifndef PR_NA
#define PR_NA 1
#endif
#ifndef PR_NORM
#define PR_NORM 1
#endif
#ifndef PR_FFI
#define PR_FFI 1
#endif
#ifndef PR_GQA
#define PR_GQA 1
#endif
#define GSYNC() do { for (int s_ = 0; s_ < PR_SYNC; ++s_) xcd_barrier(xbar); } while (0)

constexpr int DMODEL = 1024, NB = 8, SEQ = 4096, NLAY = 4, CTX = 256;
constexpr int ML = NB * SEQ, MC = NB * CTX, MT = ML + MC;
constexpr int INC = 2304, FFH = 2816, MODW = 6 * DMODEL;
constexpr float NORM_EPS = 1e-6f;
constexpr float QSCALE = 0.125f * 1.4426950408889634f;
constexpr float LOG2E = 1.4426950408889634f;

#define LAS __attribute__((address_space(3)))
#define GAS __attribute__((address_space(1)))
typedef unsigned v4u __attribute__((ext_vector_type(4)));
typedef unsigned v2u __attribute__((ext_vector_type(2)));
typedef float f32x16 __attribute__((ext_vector_type(16)));
typedef float f32x4v __attribute__((ext_vector_type(4)));
typedef short bf16x8v __attribute__((ext_vector_type(8)));

__device__ __forceinline__ unsigned f2bf(float f) { unsigned u = __builtin_bit_cast(unsigned, f); return (u + 0x7fffu + ((u >> 16) & 1u)) >> 16; }
__device__ __forceinline__ unsigned pk2(float lo, float hi) { return f2bf(lo) | (f2bf(hi) << 16); }
__device__ __forceinline__ float bf2f(unsigned short u) { return __builtin_bit_cast(float, (unsigned)u << 16); }
__device__ __forceinline__ int opq(int v) { asm volatile("" : "+v"(v)); return v; }
__device__ __forceinline__ float wave_sum(float v) {
#pragma unroll
    for (int o = 1; o < 64; o <<= 1) v += __shfl_xor(v, o);
    return v;
}

namespace pg8 {
#define PG8_LAS __attribute__((address_space(3)))
typedef unsigned short bf16_t;
typedef short bf16x8 __attribute__((ext_vector_type(8)));
typedef float f32x4 __attribute__((ext_vector_type(4)));
typedef unsigned u32x4 __attribute__((ext_vector_type(4)));
constexpr int BM = 256, BK = 64, HALF = 128, HTB = HALF * BK * 2  , STAGE_BYTES = 8 * HTB, NXCD = 8, WGM = 8;

__host__ __device__ __forceinline__ int lds_byte(int r, int c) { const int st = (r >> 4) * 2 + (c >> 5), rr = r & 15, cc = c & 31, ob = rr * 64 + cc * 2; return st * 1024 + (ob ^ (((ob >> 9) & 1) << 5)); }
__host__ __device__ __forceinline__ void stage_rc(int b, int& R, int& C) { const int st = b / 1024, sb = b % 1024, swz = sb ^ (((sb >> 9) & 1) << 5); R = (st >> 1) * 16 + swz / 64; C = (st & 1) * 32 + (swz % 64) / 2; }
__host__ __device__ __forceinline__ int perm32(int rho) { const int n = rho >> 4, i = rho & 15; return 8 * (i >> 2) + 4 * n + (i & 3); }

struct Unit { int pm, pn; };
struct Gemm { const bf16_t* A; const bf16_t* Bt; int M, N, K; };

struct StaticOrder {
    int nM, nN, nwg, G, c;
    __host__ __device__ void init(int M, int N, int G_, int c_) { nM = M / BM; nN = N / BM; nwg = nM * nN; G = G_; c = c_; }
    __host__ __device__ bool next(int i, Unit& u) const {
        const long L = (long)i * G + c; if (L >= nwg) return false;
        int wgid = (int)L; { const int q = nwg / NXCD, r = nwg % NXCD, xcd = wgid % NXCD, off = wgid / NXCD; wgid = (xcd < r ? xcd * (q + 1) : r * (q + 1) + (xcd - r) * q) + off; }
        const int nig = WGM * nN, gid = wgid / nig, fm = gid * WGM, gsz = (nM - fm) < WGM ? (nM - fm) : WGM;
        u.pm = fm + ((wgid % nig) % gsz); u.pn = (wgid % nig) / gsz; return true;
    }
    __device__ __forceinline__ void a_ready(const Unit&) const {}
    __device__ __forceinline__ void done(const Unit&) const {}
};

struct OneUnit { int pm, pn;
    __host__ __device__ bool next(int i, Unit& u) const { if (i > 0) return false; u.pm = pm; u.pn = pn; return true; }
    __device__ __forceinline__ void a_ready(const Unit&) const {}
    __device__ __forceinline__ void done(const Unit&) const {} };
__device__ __forceinline__ unsigned cvt_pk_bf16(float lo, float hi) { unsigned r; asm volatile("v_cvt_pk_bf16_f32 %0, %1, %2" : "=v"(r) : "v"(lo), "v"(hi)); return r; }

__device__ __forceinline__ void rows_rstd(const float* RSS, int rowbase, int fq, float (&rs)[2][4]) {
    float part[2][4];
#pragma unroll
    for (int ai = 0; ai < 2; ++ai)
#pragma unroll
        for (int m = 0; m < 4; ++m) part[ai][m] = RSS[(size_t)fq * MT + rowbase + ai * HALF + m * 16];
#pragma unroll
    for (int ai = 0; ai < 2; ++ai)
#pragma unroll
        for (int m = 0; m < 4; ++m) { float ss = part[ai][m]; ss += __shfl_xor(ss, 16); ss += __shfl_xor(ss, 32); rs[ai][m] = rsqrtf(ss * (1.0f / DMODEL) + NORM_EPS); }
}

struct EpiInProj {
    static constexpr bool PERM = true, AFTER_DRAIN = false;
    bf16_t* P; const float* gq; const float* gk; const float* rope;
    const float* RSS; const float* cv;
    __device__ __forceinline__ void operator()(const f32x4 (&acc)[2][2][4][2], const Unit& u, int wr, int wc, int fr, int fq) const {
        asm volatile("" : "+v"(fr), "+v"(fq));
        const int pn = u.pn;
        int mode = 0;
        if (pn == 3 || pn == 4) mode = 1; else if (pn == 5) mode = (wc < 2) ? 2 : 0; else if (pn == 6) mode = 3;
        const int colbase = pn * 256 + 64 * wc + 8 * fq;
        const int bidx_ = (u.pm * BM < ML) ? ((u.pm * BM) >> 12) : 8;
        f32x4 cvv[2][2];
#pragma unroll
        for (int bj = 0; bj < 2; ++bj)
#pragma unroll
            for (int n = 0; n < 2; ++n) cvv[bj][n] = *(const f32x4*)(cv + (size_t)bidx_ * INC + pn * 256 + 128 * bj + 32 * wc + 8 * fq + 4 * n);
        float rsv[2][4]; rows_rstd(RSS, u.pm * BM + wr * 64 + fr, fq, rsv);
        float gv[2][2][4];
        if (mode == 1 || mode == 2) { const float* g = (mode == 1) ? gq : gk;
#pragma unroll
            for (int bj = 0; bj < 2; ++bj)
#pragma unroll
                for (int n = 0; n < 2; ++n) { const f32x4 t = *(const f32x4*)(g + 32 * bj + 8 * fq + 4 * n); gv[bj][n][0] = t[0]; gv[bj][n][1] = t[1]; gv[bj][n][2] = t[2]; gv[bj][n][3] = t[3]; } }
#pragma unroll
        for (int ai = 0; ai < 2; ++ai)
#pragma unroll
            for (int m = 0; m < 4; ++m) {
                const int row = u.pm * BM + ai * HALF + wr * 64 + m * 16 + fr;
                const float rs_ = rsv[ai][m];
                float v[2][2][4];
#pragma unroll
                for (int bj = 0; bj < 2; ++bj)
#pragma unroll
                    for (int n = 0; n < 2; ++n)
#pragma unroll
                        for (int j = 0; j < 4; ++j) v[bj][n][j] = acc[ai][bj][m][n][j] * rs_ + cvv[bj][n][j];
                if (mode == 1 || mode == 2) {
                    float ss = 0.f;
#pragma unroll
                    for (int bj = 0; bj < 2; ++bj)
#pragma unroll
                        for (int n = 0; n < 2; ++n)
#pragma unroll
                            for (int j = 0; j < 4; ++j) ss += v[bj][n][j] * v[bj][n][j];
                    ss += __shfl_xor(ss, 16); ss += __shfl_xor(ss, 32);
                    const float rstd = rsqrtf(ss * (1.0f / 64.0f) + NORM_EPS);
#pragma unroll
                    for (int bj = 0; bj < 2; ++bj)
#pragma unroll
                        for (int n = 0; n < 2; ++n)
#pragma unroll
                            for (int j = 0; j < 4; ++j) v[bj][n][j] = v[bj][n][j] * rstd * gv[bj][n][j];
                    if (row < ML) {
                        const int s = row & (SEQ - 1); const int pos = (fq < 2) ? (s >> 6) : (s & 63);
                        const float* rp = rope + (pos * 16 + (fq & 1) * 8) * 2;
#pragma unroll
                        for (int n = 0; n < 2; ++n) { const f32x4 c0 = *(const f32x4*)(rp + 8 * n), c1 = *(const f32x4*)(rp + 8 * n + 4);
                            const float cs[4] = {c0[0], c0[2], c1[0], c1[2]}, sn[4] = {c0[1], c0[3], c1[1], c1[3]};
#pragma unroll
                            for (int j = 0; j < 4; ++j) { const float x1 = v[0][n][j], x2 = v[1][n][j]; v[0][n][j] = x1 * cs[j] - x2 * sn[j]; v[1][n][j] = x1 * sn[j] + x2 * cs[j]; } }
                    }
                }
                if (mode == 1 || mode == 3) {
#pragma unroll
                    for (int bj = 0; bj < 2; ++bj)
#pragma unroll
                        for (int n = 0; n < 2; ++n)
#pragma unroll
                            for (int j = 0; j < 4; ++j) v[bj][n][j] *= QSCALE;
                }
                bf16_t* rowp = P + (size_t)row * INC + colbase;
#pragma unroll
                for (int bj = 0; bj < 2; ++bj) { u32x4 w; w.x = cvt_pk_bf16(v[bj][0][0], v[bj][0][1]); w.y = cvt_pk_bf16(v[bj][0][2], v[bj][0][3]); w.z = cvt_pk_bf16(v[bj][1][0], v[bj][1][1]); w.w = cvt_pk_bf16(v[bj][1][2], v[bj][1][3]);
                    *(u32x4*)(rowp + 32 * bj) = w; }
            }
    }
};

struct EpiResid {
    static constexpr bool PERM = true, AFTER_DRAIN = false;
    const float* rin_l; const float* rin_c; float* rout_l; float* rout_c; const float* gate;
    bf16_t* XNo; float* RSS; const float* gnext; const float* scnext; int wantA;
    PG8_LAS float* xs;
    __device__ __forceinline__ void operator()(const f32x4 (&acc)[2][2][4][2], const Unit& u, int wr, int wc, int fr, int fq) const {
        asm volatile("" : "+v"(fr), "+v"(fq));
        const int row0 = u.pm * BM; const bool lat = row0 < ML;
        const int bidx = lat ? (row0 >> 12) : 8;
        const float* rin = lat ? rin_l : rin_c - (size_t)ML * DMODEL; float* rout = lat ? rout_l : rout_c - (size_t)ML * DMODEL;
        const int col0 = u.pn * BM + wc * 32 + 8 * fq;
        f32x4 gt[2][2], gs[2][2];
#pragma unroll
        for (int bj = 0; bj < 2; ++bj)
#pragma unroll
            for (int n = 0; n < 2; ++n) { gt[bj][n] = *(const f32x4*)(gate + (size_t)bidx * MODW + col0 + bj * HALF + 4 * n);
                if (wantA) gs[bj][n] = *(const f32x4*)(gnext + col0 + bj * HALF + 4 * n) * (*(const f32x4*)(scnext + (size_t)bidx * MODW + col0 + bj * HALF + 4 * n) + 1.0f);
                else gs[bj][n] = (f32x4){0.f, 0.f, 0.f, 0.f}; }
#pragma unroll
        for (int ai = 0; ai < 2; ++ai)
#pragma unroll
            for (int mp2 = 0; mp2 < 2; ++mp2) {
                f32x4 xi[2][2][2];
#pragma unroll
                for (int q = 0; q < 2; ++q) { const size_t ro = (size_t)(row0 + ai * HALF + wr * 64 + (2 * mp2 + q) * 16 + fr) * DMODEL + col0;
#pragma unroll
                    for (int bj = 0; bj < 2; ++bj)
#pragma unroll
                        for (int n = 0; n < 2; ++n) xi[q][bj][n] = *(const f32x4*)(rin + ro + bj * HALF + 4 * n); }
#pragma unroll
                for (int q = 0; q < 2; ++q) { const int m = 2 * mp2 + q; const int row = row0 + ai * HALF + wr * 64 + m * 16 + fr; const size_t ro = (size_t)row * DMODEL + col0;
                    float ss = 0.f;
#pragma unroll
                    for (int bj = 0; bj < 2; ++bj) { f32x4 xn[2];
#pragma unroll
                        for (int n = 0; n < 2; ++n) { xn[n] = xi[q][bj][n] + gt[bj][n] * acc[ai][bj][m][n];
                            *(f32x4*)(rout + ro + bj * HALF + 4 * n) = xn[n];
                            ss += (xn[n][0] * xn[n][0] + xn[n][1] * xn[n][1]) + (xn[n][2] * xn[n][2] + xn[n][3] * xn[n][3]); }
                        if (wantA) { const f32x4 a0 = xn[0] * gs[bj][0], a1 = xn[1] * gs[bj][1];
                            u32x4 w; w.x = cvt_pk_bf16(a0[0], a0[1]); w.y = cvt_pk_bf16(a0[2], a0[3]); w.z = cvt_pk_bf16(a1[0], a1[1]); w.w = cvt_pk_bf16(a1[2], a1[3]);
                            *(u32x4*)(XNo + ro + bj * HALF) = w; } }
                    if (wantA) { ss += __shfl_xor(ss, 16); ss += __shfl_xor(ss, 32);
                        if (fq == 0) xs[(ai * HALF + wr * 64 + m * 16 + fr) * 4 + wc] = ss; } } }
        if (wantA) {
            asm volatile("s_waitcnt lgkmcnt(0)\n\ts_barrier" ::: "memory");
            const int t = (wr * 4 + wc) * 64 + fq * 16 + fr;
            if (t < 256) { const f32x4 p = *(const PG8_LAS f32x4*)(xs + 4 * t); RSS[(size_t)u.pn * MT + row0 + t] = (p[0] + p[1]) + (p[2] + p[3]); }
        }
    }
};

struct EpiSwiglu {
    static constexpr bool PERM = true, AFTER_DRAIN = false;
    bf16_t* ACT; const float* RSS; const float* cv;
    __device__ __forceinline__ void operator()(const f32x4 (&acc)[2][2][4][2], const Unit& u, int wr, int wc, int fr, int fq) const {
        asm volatile("" : "+v"(fr), "+v"(fq));
        const int col0 = u.pn * HALF + wc * 32 + 8 * fq;
        const int bidx_ = (u.pm * BM < ML) ? ((u.pm * BM) >> 12) : 8;
        f32x4 cvv[2][2];
#pragma unroll
        for (int bj = 0; bj < 2; ++bj)
#pragma unroll
            for (int n = 0; n < 2; ++n) cvv[bj][n] = *(const f32x4*)(cv + (size_t)bidx_ * (2 * FFH) + u.pn * 256 + 128 * bj + 32 * wc + 8 * fq + 4 * n);
        float rsv[2][4]; rows_rstd(RSS, u.pm * BM + wr * 64 + fr, fq, rsv);
#pragma unroll
        for (int ai = 0; ai < 2; ++ai)
#pragma unroll
            for (int m = 0; m < 4; ++m) { const int row = u.pm * BM + ai * HALF + wr * 64 + m * 16 + fr;
                const float rs_ = rsv[ai][m];
                float o[2][4];
#pragma unroll
                for (int n = 0; n < 2; ++n)
#pragma unroll
                    for (int j = 0; j < 4; ++j) { const float g = acc[ai][0][m][n][j] * rs_ + cvv[0][n][j], uu = acc[ai][1][m][n][j] * rs_ + cvv[1][n][j];
                        o[n][j] = g * __builtin_amdgcn_rcpf(1.0f + __expf(-g)) * uu; }
                u32x4 w; w.x = cvt_pk_bf16(o[0][0], o[0][1]); w.y = cvt_pk_bf16(o[0][2], o[0][3]); w.z = cvt_pk_bf16(o[1][0], o[1][1]); w.w = cvt_pk_bf16(o[1][2], o[1][3]);
                *(u32x4*)(ACT + (size_t)row * FFH + col0) = w; }
    }
};

template <class Epi, class Sched, bool ALIGN_EPI = false, bool SP2 = false>
__device__ __forceinline__ void gemm_phase(PG8_LAS unsigned char* lds, const Gemm g, const Sched& S, const Epi& E) {
    int tid_o = threadIdx.x; asm volatile("" : "+v"(tid_o));
    const int tid = tid_o, wid = __builtin_amdgcn_readfirstlane(tid >> 6), lane = tid & 63, wr = wid >> 2, wc = wid & 3, fr = lane & 15, fq = lane >> 4;
    const int K = g.K, nt = K / BK;
    unsigned voffA[2], voffB[2];
#pragma unroll
    for (int i = 0; i < 2; ++i) { int R, C; stage_rc(tid * 16 + i * 8192, R, C); const int Rb = Epi::PERM ? ((R & ~31) + perm32(R & 31)) : R;
        voffA[i] = (unsigned)(R * K + C) * 2u; voffB[i] = (unsigned)(Rb * K + C) * 2u; }
    const size_t kstep = (size_t)(BK * 2);
    const size_t hstep = (size_t)HALF * K * 2;
    const size_t tstep = 2 * hstep;
    const unsigned ldsw = (unsigned)wid * 1024u;
    const int aoff = lds_byte(wr * 64 + fr, fq * 8), boff = lds_byte(wc * 32 + fr, fq * 8);
#define PG8_SA(b, h) (((b) * 2 + (h)) * HTB)
#define PG8_SB(b, h) ((4 + (b) * 2 + (h)) * HTB)
#define PG8_STAGE(bufoff, gbase, voff) do { _Pragma("unroll") for (int _i = 0; _i < 2; ++_i) \
        __builtin_amdgcn_global_load_lds((const unsigned*)((const char*)(gbase) + (voff)[_i]), (PG8_LAS unsigned*)(lds + (bufoff) + ldsw + _i * 8192), 16, 0, 0); } while (0)
#define PG8_LDA(dst, b, h) do { _Pragma("unroll") for (int m = 0; m < 4; ++m) _Pragma("unroll") for (int k = 0; k < 2; ++k) dst[m][k] = *(const PG8_LAS bf16x8*)(lds + PG8_SA(b, h) + aoff + m * 2048 + k * 1024); } while (0)
#define PG8_LDB(dst, b, h) do { _Pragma("unroll") for (int n = 0; n < 2; ++n) _Pragma("unroll") for (int k = 0; k < 2; ++k) dst[n][k] = *(const PG8_LAS bf16x8*)(lds + PG8_SB(b, h) + boff + n * 2048 + k * 1024); } while (0)
#define PG8_MMA(ai, bj, At, Bt) do { __builtin_amdgcn_s_setprio(1); _Pragma("unroll") for (int m = 0; m < 4; ++m) _Pragma("unroll") for (int n = 0; n < 2; ++n) _Pragma("unroll") for (int k = 0; k < 2; ++k) \
        acc[ai][bj][m][n] = __builtin_amdgcn_mfma_f32_16x16x32_bf16(Bt[n][k], At[m][k], acc[ai][bj][m][n], 0, 0, 0); __builtin_amdgcn_s_setprio(0); } while (0)
#define PG8_WAIT_V(n) asm volatile("s_waitcnt vmcnt(" #n ")" ::: "memory")
#define PG8_WAIT_L(n) asm volatile("s_waitcnt lgkmcnt(" #n ")" ::: "memory")
#define PG8_BAR __builtin_amdgcn_s_barrier()
#define PG8_SCHED __builtin_amdgcn_sched_barrier(0)
    Unit cur, nxt; int ui = 0;
    if (!S.next(0, cur)) return;
    f32x4 acc[2][2][4][2];
#pragma unroll
    for (int a = 0; a < 2; ++a)
#pragma unroll
        for (int b = 0; b < 2; ++b)
#pragma unroll
            for (int m = 0; m < 4; ++m)
#pragma unroll
                for (int n = 0; n < 2; ++n) acc[a][b][m][n] = (f32x4){0.f, 0.f, 0.f, 0.f};
    bf16x8 At[4][2], B0[2][2], B1[2][2];
    const char* cA = (const char*)g.A + (size_t)cur.pm * tstep; const char* cB = (const char*)g.Bt + (size_t)cur.pn * tstep;
    S.a_ready(cur);
    if constexpr (SP2) {
        PG8_STAGE(PG8_SB(0, 0), cB, voffB); PG8_STAGE(PG8_SB(0, 1), cB + hstep, voffB); PG8_STAGE(PG8_SA(0, 0), cA, voffA); PG8_STAGE(PG8_SA(0, 1), cA + hstep, voffA);
        if (wr == 1) PG8_BAR;
        PG8_WAIT_V(2); PG8_BAR;
        PG8_STAGE(PG8_SB(1, 0), cB + kstep, voffB); PG8_STAGE(PG8_SA(1, 0), cA + kstep, voffA); PG8_STAGE(PG8_SB(1, 1), cB + hstep + kstep, voffB);
        PG8_WAIT_V(6); PG8_BAR;
    } else {
        PG8_STAGE(PG8_SB(0, 0), cB, voffB); PG8_STAGE(PG8_SA(0, 0), cA, voffA); PG8_STAGE(PG8_SB(0, 1), cB + hstep, voffB); PG8_STAGE(PG8_SA(0, 1), cA + hstep, voffA);
        if (wr == 1) PG8_BAR;
        PG8_WAIT_V(4); PG8_BAR;
        PG8_STAGE(PG8_SB(1, 0), cB + kstep, voffB); PG8_STAGE(PG8_SA(1, 0), cA + kstep, voffA); PG8_STAGE(PG8_SB(1, 1), cB + hstep + kstep, voffB);
        PG8_WAIT_V(6); PG8_BAR;
    }
    for (;;) {
        const bool has_next = S.next(ui + 1, nxt);
        const char* nA = has_next ? (const char*)g.A + (size_t)nxt.pm * tstep : cA; const char* nB = has_next ? (const char*)g.Bt + (size_t)nxt.pn * tstep : cB;
        for (int t = 0; t < nt; t += 2) {
            const bool last = (t == nt - 2);
            const char* a1 = cA + (size_t)(t + 1) * kstep;
            const char* a2 = last ? nA : cA + (size_t)(t + 2) * kstep; const char* b2 = last ? nB : cB + (size_t)(t + 2) * kstep;
            const char* a3 = a2 + kstep; const char* b3 = b2 + kstep;
            if (last && has_next) S.a_ready(nxt);
            if constexpr (SP2) {
            PG8_LDB(B0, 0, 0); PG8_LDB(B1, 0, 1); PG8_SCHED; PG8_LDA(At, 0, 0); PG8_STAGE(PG8_SA(1, 1), a1 + hstep, voffA);
            PG8_WAIT_V(8); PG8_WAIT_L(0); PG8_BAR; PG8_MMA(0, 0, At, B0); PG8_MMA(0, 1, At, B1); PG8_BAR; PG8_SCHED;
            PG8_LDA(At, 0, 1); PG8_STAGE(PG8_SB(0, 0), b2, voffB); PG8_STAGE(PG8_SB(0, 1), b2 + hstep, voffB); PG8_STAGE(PG8_SA(0, 0), a2, voffA);
            PG8_WAIT_V(8); PG8_WAIT_L(0); PG8_BAR; PG8_MMA(1, 0, At, B0); PG8_MMA(1, 1, At, B1); PG8_BAR; PG8_SCHED;
            PG8_LDB(B0, 1, 0); PG8_LDB(B1, 1, 1); PG8_SCHED; PG8_LDA(At, 1, 0); PG8_STAGE(PG8_SA(0, 1), a2 + hstep, voffA);
            PG8_WAIT_V(8); PG8_WAIT_L(0); PG8_BAR; PG8_MMA(0, 0, At, B0); PG8_MMA(0, 1, At, B1); PG8_BAR; PG8_SCHED;
            PG8_LDA(At, 1, 1); PG8_STAGE(PG8_SB(1, 0), b3, voffB); PG8_STAGE(PG8_SB(1, 1), b3 + hstep, voffB); PG8_STAGE(PG8_SA(1, 0), a3, voffA);
            PG8_WAIT_V(8); PG8_WAIT_L(0); PG8_BAR; PG8_MMA(1, 0, At, B0); PG8_MMA(1, 1, At, B1); PG8_BAR; PG8_SCHED;
            } else {
            PG8_LDB(B0, 0, 0); PG8_SCHED; PG8_LDA(At, 0, 0); PG8_STAGE(PG8_SA(1, 1), a1 + hstep, voffA);
            PG8_WAIT_L(8); PG8_BAR; PG8_WAIT_L(0); PG8_MMA(0, 0, At, B0); PG8_BAR; PG8_SCHED;
            PG8_LDB(B1, 0, 1); PG8_STAGE(PG8_SB(0, 0), b2, voffB);
            PG8_BAR; PG8_WAIT_L(0); PG8_MMA(0, 1, At, B1); PG8_BAR;
            PG8_LDA(At, 0, 1); PG8_STAGE(PG8_SA(0, 0), a2, voffA);
            PG8_BAR; PG8_WAIT_L(0); PG8_MMA(1, 0, At, B0); PG8_BAR; PG8_SCHED;
            PG8_STAGE(PG8_SB(0, 1), b2 + hstep, voffB);
            PG8_WAIT_V(6); PG8_BAR; PG8_MMA(1, 1, At, B1); PG8_BAR;
            PG8_LDB(B0, 1, 0); PG8_SCHED; PG8_LDA(At, 1, 0); PG8_STAGE(PG8_SA(0, 1), a2 + hstep, voffA);
            PG8_WAIT_L(8); PG8_BAR; PG8_WAIT_L(0); PG8_MMA(0, 0, At, B0); PG8_BAR; PG8_SCHED;
            PG8_LDB(B1, 1, 1); PG8_STAGE(PG8_SB(1, 0), b3, voffB);
            PG8_BAR; PG8_WAIT_L(0); PG8_MMA(0, 1, At, B1); PG8_BAR;
            PG8_LDA(At, 1, 1); PG8_STAGE(PG8_SA(1, 0), a3, voffA);
            PG8_BAR; PG8_WAIT_L(0); PG8_MMA(1, 0, At, B0); PG8_BAR; PG8_SCHED;
            PG8_STAGE(PG8_SB(1, 1), b3 + hstep, voffB);
            PG8_WAIT_V(6); PG8_BAR; PG8_MMA(1, 1, At, B1); PG8_BAR;
            }
        }
        if constexpr (ALIGN_EPI) { if (wr == 0) PG8_BAR; }
        if constexpr (!Epi::AFTER_DRAIN) { E(acc, cur, wr, wc, fr, fq); S.done(cur); }
        if (!has_next) break;
#pragma unroll
        for (int a = 0; a < 2; ++a)
#pragma unroll
            for (int b = 0; b < 2; ++b)
#pragma unroll
                for (int m = 0; m < 4; ++m)
#pragma unroll
                    for (int n = 0; n < 2; ++n) acc[a][b][m][n] = (f32x4){0.f, 0.f, 0.f, 0.f};
        cur = nxt; cA = nA; cB = nB; ++ui;
        if constexpr (ALIGN_EPI) { if (wr == 1) PG8_BAR; }
    }
    PG8_WAIT_V(0);
    if constexpr (!ALIGN_EPI) { if (wr == 0) PG8_BAR; }
    PG8_BAR;
    if constexpr (Epi::AFTER_DRAIN) { E.fused(acc, cur, wr, wc, fr, fq, lds, wid, lane); S.done(cur); }
#undef PG8_SA
#undef PG8_SB
#undef PG8_STAGE
#undef PG8_LDA
#undef PG8_LDB
#undef PG8_MMA
#undef PG8_WAIT_V
#undef PG8_WAIT_L
#undef PG8_BAR
#undef PG8_SCHED
}
}

namespace attn_body {
using bf16=__hip_bfloat16;
using bf16x8=__attribute__((ext_vector_type(8)))short;
using s16x4=__attribute__((ext_vector_type(4)))short;
using f32x16=__attribute__((ext_vector_type(16)))float;
using u32x4=__attribute__((ext_vector_type(4)))unsigned;
constexpr int D=64, PP=2304, OP=1024;
constexpr int NW=8,QBLK=32,QB=QBLK*NW,KVBLK=64;
__device__ __forceinline__ int crow(int r,int hi){return (r&3)+8*(r>>2)+4*hi;}
#define SBAR() __builtin_amdgcn_sched_barrier(0)
__device__ __forceinline__ void cmask(f32x16&p0,f32x16&p1,int jb,int qrel,int hi){
  const float NEG=-INFINITY; int kb=64*jb+4*hi;
  #pragma unroll
  for(int r=0;r<16;++r){int kv=kb+(r&3)+8*(r>>2); if(kv>qrel)p0[r]=NEG; if(kv+32>qrel)p1[r]=NEG;}
}

constexpr int NSLOT=3, SLOTB=8192;
constexpr int LDS_K=0, LDS_V=NSLOT*SLOTB, LDS_WS=2*NSLOT*SLOTB, LDS_OST=LDS_WS+NW*64*4, LDS_BYTES=LDS_OST+NW*4096;
constexpr float C2=0.125f*1.4426950408889634f;

__device__ __forceinline__ void na_hook(f32x16&p0,f32x16&p1,int t,int r0,int qrow,int qcol,int hi,const float*bias){
  if(t<4)return;
  const float NEG=-INFINITY; const int kr=r0+t-4; int rs=qrow-4; rs=rs<0?0:(rs>56?56:rs);
  if(kr<rs||kr>rs+7){
    #pragma unroll
    for(int r=0;r<16;++r){p0[r]=NEG;p1[r]=NEG;}
    return; }
  int cs=qcol-8; cs=cs<0?0:(cs>48?48:cs);
  const float*bt=bias+(kr-qrow+7)*31+15-qcol;
  #pragma unroll
  for(int r=0;r<16;++r){ const int kc=(r&3)+8*(r>>2)+4*hi;
    const bool v0=(unsigned)(kc-cs)<16u, v1=(unsigned)(kc+32-cs)<16u;
    const float b0=v0?bt[kc]:0.f, b1=v1?bt[kc+32]:0.f;
    p0[r]=v0?p0[r]+b0:NEG; p1[r]=v1?p1[r]+b1:NEG; }
}
__device__ __forceinline__ void glds16(const void*gsrc,unsigned lds_dst){unsigned keep;
  asm volatile("s_mov_b32 %0, m0\n\ts_mov_b32 m0, %2\n\ts_nop 0\n\tglobal_load_lds_dwordx4 %1, off\n\ts_mov_b32 m0, %0":"=&s"(keep):"v"(gsrc),"s"(lds_dst):"memory");}
__device__ __forceinline__ float max3f(float a,float b,float c){float r;asm("v_max3_f32 %0, %1, %2, %3":"=v"(r):"v"(a),"v"(b),"v"(c));return r;}
__device__ __forceinline__ float max2f(float a,float b){float r;asm("v_max_f32_e32 %0, %1, %2":"=v"(r):"v"(a),"v"(b));return r;}
__device__ __forceinline__ float fadd_s(float a,float b){float r;asm("v_add_f32_e32 %0, %1, %2":"=v"(r):"v"(a),"v"(b));return r;}
__device__ __forceinline__ float fsub_s(float a,float b){float r;asm("v_sub_f32_e32 %0, %1, %2":"=v"(r):"v"(a),"v"(b));return r;}
typedef float f32x2_t __attribute__((ext_vector_type(2))); typedef __bf16 bf16x2_t __attribute__((ext_vector_type(2)));
__device__ __forceinline__ unsigned cvtpk_s(float lo,float hi){f32x2_t v={lo,hi};bf16x2_t b=__builtin_convertvector(v,bf16x2_t);return __builtin_bit_cast(unsigned,b);}
#define WAIT_BAR(N) asm volatile("s_waitcnt vmcnt(" #N ") lgkmcnt(0)\n\ts_barrier":::"memory")

__device__ __forceinline__ void qkt(f32x16&p0,f32x16&p1,const char*Kslot,const bf16x8*qr,const f32x16&negm,int r32,int hi){
  const char*kb=Kslot+hi*1024+r32*16;
  #pragma unroll
  for(int d0=0;d0<4;++d0){
    const bf16x8 b0=*reinterpret_cast<const bf16x8*>(kb+d0*2048);
    const bf16x8 b1=*reinterpret_cast<const bf16x8*>(kb+d0*2048+512);
    if(d0==0){p0=__builtin_amdgcn_mfma_f32_32x32x16_bf16(b0,qr[0],negm,0,0,0);p1=__builtin_amdgcn_mfma_f32_32x32x16_bf16(b1,qr[0],negm,0,0,0);}
    else{p0=__builtin_amdgcn_mfma_f32_32x32x16_bf16(b0,qr[d0],p0,0,0,0);p1=__builtin_amdgcn_mfma_f32_32x32x16_bf16(b1,qr[d0],p1,0,0,0);}}
}
typedef __attribute__((address_space(3))) const char* lds_cptr;
typedef short v4i16_t __attribute__((ext_vector_type(4)));
__device__ __forceinline__ void kload8(bf16x8*kf,lds_cptr kp){
  kf[0]=*(const __attribute__((address_space(3))) bf16x8*)(kp);      kf[1]=*(const __attribute__((address_space(3))) bf16x8*)(kp+512);
  kf[2]=*(const __attribute__((address_space(3))) bf16x8*)(kp+2048); kf[3]=*(const __attribute__((address_space(3))) bf16x8*)(kp+2560);
  kf[4]=*(const __attribute__((address_space(3))) bf16x8*)(kp+4096); kf[5]=*(const __attribute__((address_space(3))) bf16x8*)(kp+4608);
  kf[6]=*(const __attribute__((address_space(3))) bf16x8*)(kp+6144); kf[7]=*(const __attribute__((address_space(3))) bf16x8*)(kp+6656);
}
__device__ __forceinline__ void kload2(bf16x8*kf,lds_cptr kp,int j){ kf[2*j]=*(const __attribute__((address_space(3))) bf16x8*)(kp+j*2048); kf[2*j+1]=*(const __attribute__((address_space(3))) bf16x8*)(kp+j*2048+512); }
__device__ __forceinline__ s16x4 vtr(lds_cptr p){ return __builtin_bit_cast(s16x4,__builtin_amdgcn_ds_read_tr16_b64_v4i16((__attribute__((address_space(3))) v4i16_t*)p)); }
__device__ __forceinline__ float rowmax(const f32x16&p0,const f32x16&p1){
  float a=max3f(p0[0],p0[1],p1[0]),b=max3f(p0[2],p0[3],p1[1]);a=max3f(a,p1[2],p1[3]);
  #pragma unroll
  for(int r=4;r<16;r+=4){a=max3f(a,p0[r],p0[r+1]);b=max3f(b,p0[r+2],p0[r+3]);a=max3f(a,p1[r],p1[r+1]);b=max3f(b,p1[r+2],p1[r+3]);}
  const float m=max2f(a,b);
  auto rr=__builtin_amdgcn_permlane32_swap(__float_as_uint(m),__float_as_uint(m),false,false);
  return max2f(__uint_as_float(rr[0]),__uint_as_float(rr[1]));
}
__device__ __forceinline__ void pv(f32x16*o,int vb,bf16x8 pa0,bf16x8 pa1,bf16x8 pa2,bf16x8 pa3){
  #pragma unroll
  for(int d0=0;d0<2;++d0){s16x4 lo[4],hi[4];
    #pragma unroll
    for(int ks=0;ks<4;++ks){
      asm volatile("ds_read_b64_tr_b16 %0,%1 offset:%c2":"=&v"(lo[ks]):"v"(vb),"i"(d0*4096+ks*1024):"memory");
      asm volatile("ds_read_b64_tr_b16 %0,%1 offset:%c2":"=&v"(hi[ks]):"v"(vb),"i"(d0*4096+ks*1024+512):"memory");}
    asm volatile("s_waitcnt lgkmcnt(0)":::"memory");SBAR();
    #define PK(k) (bf16x8){lo[k][0],lo[k][1],lo[k][2],lo[k][3],hi[k][0],hi[k][1],hi[k][2],hi[k][3]}
    o[d0]=__builtin_amdgcn_mfma_f32_32x32x16_bf16(pa0,PK(0),o[d0],0,0,0);
    o[d0]=__builtin_amdgcn_mfma_f32_32x32x16_bf16(pa1,PK(1),o[d0],0,0,0);
    o[d0]=__builtin_amdgcn_mfma_f32_32x32x16_bf16(pa2,PK(2),o[d0],0,0,0);
    o[d0]=__builtin_amdgcn_mfma_f32_32x32x16_bf16(pa3,PK(3),o[d0],0,0,0);
    #undef PK
  }
}

#ifndef ATTN_STORE16
#define ATTN_STORE16(p,v) (*(u32x4*)(p)=(v))
#endif
template<int THRL,int MODE> __device__ __forceinline__ void attn_unit(const bf16*Qu,const bf16*__restrict__ Kb,const bf16*__restrict__ Vb,bf16*Ou,int krow_c,int krow_l,int tclamp,int NT,int na_r0,int na_qrow0,const float*na_bias,char*shm,float fixm=0.f){
  int tid_o=threadIdx.x; asm volatile("":"+v"(tid_o)); const int tid=tid_o,lane=tid&63,r32=lane&31,hi=lane>>5; const int wid=__builtin_amdgcn_readfirstlane(tid>>6);
  const bf16*Qw=Qu+(long)(wid*QBLK)*PP;
  const bf16*Kh=Kb,*Vh=Vb;
  #define KROW(t) (((t)<4)?(krow_c+64*(t)):(krow_l+64*(((t)-4)<tclamp?((t)-4):tclamp)))
  const unsigned lds0=(unsigned)(uintptr_t)shm;
  float*wsf=(float*)(shm+LDS_WS)+wid*64;
  const bf16*ksrc=Kh+(long)lane*PP+wid*8;
  const bf16*vsrc=Vh+(long)(16*(wid&3)+(lane>>2))*PP+(wid>>2)*32+(lane&3)*8;
  const unsigned kdst=lds0+LDS_K+wid*1024, vdst=lds0+LDS_V+wid*1024;
  #define DMA_K(t,slot) glds16(ksrc+(long)KROW(t)*PP,(unsigned)__builtin_amdgcn_readfirstlane(kdst+(slot)))
  #define DMA_V(t,slot) glds16(vsrc+(long)KROW(t)*PP,(unsigned)__builtin_amdgcn_readfirstlane(vdst+(slot)))
  const int vb0=(int)(lds0+LDS_V)+((lane>>4)&1)*32+(lane&3)*8+(4*hi+((lane&15)>>2))*64;
  const char*Kbase=shm+LDS_K; bf16x8 kf[8];
  const lds_cptr shm3=(lds_cptr)shm; const lds_cptr kp0=shm3+LDS_K+hi*1024+r32*16; const lds_cptr vp0=shm3+LDS_V+((lane>>4)&1)*32+(lane&3)*8+(4*hi+((lane&15)>>2))*64;
  DMA_K(0,0);DMA_V(0,0);DMA_K(1,SLOTB);
  bf16x8 qr[4];
  #pragma unroll
  for(int d0=0;d0<4;++d0)qr[d0]=*reinterpret_cast<const bf16x8*>(&Qw[(long)r32*PP+d0*16+hi*8]);
  float mhat=0.f,l_reg=0.f;f32x16 o[2];o[0]=f32x16{};o[1]=f32x16{};f32x16 negm=f32x16{};asm volatile("":"+v"(negm));
  const int na_qrow=na_qrow0+(wid>>1), na_qcol=32*(wid&1)+r32;
  #define CMASK(P0,P1,t) do{ if(MODE==1) na_hook(P0,P1,(t),na_r0,na_qrow,na_qcol,hi,na_bias); }while(0)
  bool resc=false;
  #define START(P0,P1) do{ const float rm=(MODE==2)?fixm:rowmax(P0,P1); resc=false; \
    { const float dl=rm; mhat=fadd_s(mhat,dl); \
      _Pragma("unroll") for(int r=0;r<16;++r){P0[r]=fsub_s(P0[r],dl);P1[r]=fsub_s(P1[r],dl);} \
      _Pragma("unroll") for(int r=0;r<16;++r)negm[r]=-mhat; asm volatile("":"+v"(negm)); } \
    _Pragma("unroll") for(int r=0;r<16;++r)P0[r]=__builtin_amdgcn_exp2f(P0[r]); }while(0)
  #define RESC() do{ if(resc){ asm volatile("s_waitcnt lgkmcnt(0)":::"memory"); \
      _Pragma("unroll") for(int d_=0;d_<2;++d_) _Pragma("unroll") for(int r=0;r<16;++r)o[d_][r]*=wsf[crow(r,hi)]; } }while(0)
  f32x16 pA0,pA1,pB0,pB1;
  int sl_prev=0,sl_cur=0,sl_next=SLOTB;
  #define ROT() do{sl_prev=sl_cur;sl_cur=sl_next;sl_next=(sl_next==(NSLOT-1)*SLOTB)?0:sl_next+SLOTB;}while(0)
  DMA_K(2,2*SLOTB);
  WAIT_BAR(3);
  qkt(pA0,pA1,Kbase,qr,negm,r32,hi);asm volatile("s_nop 15\n\ts_nop 7":"+v"(pA0),"+v"(pA1));CMASK(pA0,pA1,0);
  START(pA0,pA1);
  _Pragma("unroll") for(int r=0;r<16;++r)pA1[r]=__builtin_amdgcn_exp2f(pA1[r]);
  WAIT_BAR(0);
  DMA_K(3,0);DMA_V(1,SLOTB);
  ROT();
  kload8(kf,kp0+sl_cur);
  WAIT_BAR(2);
  s16x4 vlo[8],vhi[8]; u32x4 pw0,pw1,pw2,pw3;
  #define PKW(P,B) cvtpk_s(P[B],P[B+1])
  #define PAF(k) __builtin_bit_cast(bf16x8,pw##k)
  #define VFR(i) (bf16x8){vlo[i][0],vlo[i][1],vlo[i][2],vlo[i][3],vhi[i][0],vhi[i][1],vhi[i][2],vhi[i][3]}
  #define PIN(x) asm volatile("":"+v"(x))
  #define MX3(a,b,c) __builtin_fmaxf(__builtin_fmaxf((a),(b)),(c))
  #define GAPA(MF,A0,A1,A2,A3,W0,W1,PW) do{ MF; sacc2+=(f32x2_t){A0,A1}; sacc2+=(f32x2_t){A2,A3}; PIN(sacc2); W0; W1; PIN(PW); SBAR(); }while(0)
  #define EX(v) __builtin_amdgcn_exp2f(v)
  #define GAPB(MF,X,B) do{ MF; X[B]=EX(X[B]); X[B+1]=EX(X[B+1]); X[B+2]=EX(X[B+2]); X[B+3]=EX(X[B+3]); PIN(X); SBAR(); }while(0)
  #define VRD(i) do{ vlo[i]=vtr(vp_+(((i)>>2)*4096+((i)&3)*1024)); vhi[i]=vtr(vp_+(((i)>>2)*4096+((i)&3)*1024+512)); }while(0)
  #define KRD(G,j) do{ if(G){ kload2(kf,kp0+sl_next,j); SBAR(); } }while(0)
  #define STEP(C0,C1,P0,P1,t,GK,GV,GL) do{ SBAR(); \
    const lds_cptr vp_=vp0+sl_prev; \
    VRD(0); SBAR(); f32x2_t sacc2={P0[0],P0[1]}; \
    GAPA(C0=__builtin_amdgcn_mfma_f32_32x32x16_bf16(kf[0],qr[0],negm,0,0,0), P0[2],P0[3],P0[4],P0[5],     pw0[0]=PKW(P0,0), pw0[1]=PKW(P0,2), pw0); \
    VRD(4); SBAR(); GAPA(C1=__builtin_amdgcn_mfma_f32_32x32x16_bf16(kf[1],qr[0],negm,0,0,0), P0[6],P0[7],P0[8],P0[9],     pw0[2]=PKW(P0,4), pw0[3]=PKW(P0,6), pw0); \
    VRD(1); SBAR(); GAPA(C0=__builtin_amdgcn_mfma_f32_32x32x16_bf16(kf[2],qr[1],C0,0,0,0),   P0[10],P0[11],P0[12],P0[13], pw1[0]=PKW(P0,8), pw1[1]=PKW(P0,10), pw1); \
    VRD(5); SBAR(); GAPA(C1=__builtin_amdgcn_mfma_f32_32x32x16_bf16(kf[3],qr[1],C1,0,0,0),   P0[14],P0[15],P1[0],P1[1],   pw1[2]=PKW(P0,12),pw1[3]=PKW(P0,14), pw1); \
    VRD(2); SBAR(); GAPA(C0=__builtin_amdgcn_mfma_f32_32x32x16_bf16(kf[4],qr[2],C0,0,0,0),   P1[2],P1[3],P1[4],P1[5],     pw2[0]=PKW(P1,0), pw2[1]=PKW(P1,2), pw2); \
    VRD(6); SBAR(); GAPA(C1=__builtin_amdgcn_mfma_f32_32x32x16_bf16(kf[5],qr[2],C1,0,0,0),   P1[6],P1[7],P1[8],P1[9],     pw2[2]=PKW(P1,4), pw2[3]=PKW(P1,6), pw2); \
    VRD(3); SBAR(); GAPA(C0=__builtin_amdgcn_mfma_f32_32x32x16_bf16(kf[6],qr[3],C0,0,0,0),   P1[10],P1[11],P1[12],P1[13], pw3[0]=PKW(P1,8), pw3[1]=PKW(P1,10), pw3); \
    VRD(7); SBAR(); GAPA(C1=__builtin_amdgcn_mfma_f32_32x32x16_bf16(kf[7],qr[3],C1,0,0,0),   P1[14],P1[15],0.f,0.f,       pw3[2]=PKW(P1,12),pw3[3]=PKW(P1,14), pw3); \
    l_reg+=(sacc2[0]+sacc2[1]); \
    if(GK){DMA_K((t)+3,sl_cur);} if(GV){DMA_V((t)+1,sl_next);} \
    CMASK(C0,C1,t); \
    resc=false; if(MODE!=2){ float a=MX3(C0[0],C0[1],C1[0]),b=MX3(C0[2],C0[3],C1[1]); a=MX3(a,C1[2],C1[3]); \
      _Pragma("unroll") for(int r=4;r<16;r+=4){a=MX3(a,C0[r],C0[r+1]);b=MX3(b,C0[r+2],C0[r+3]);a=MX3(a,C1[r],C1[r+1]);b=MX3(b,C1[r+2],C1[r+3]);} \
      float rm=__builtin_fmaxf(a,b); { auto rr=__builtin_amdgcn_permlane32_swap(__float_as_uint(rm),__float_as_uint(rm),false,false); rm=__builtin_fmaxf(__uint_as_float(rr[0]),__uint_as_float(rr[1])); } \
      resc=false; \
      if(__builtin_expect(__any(rm>(float)THRL),0)){ const float dl=__builtin_fmaxf(rm,0.f); mhat+=dl; \
        _Pragma("unroll") for(int r=0;r<16;++r){C0[r]-=dl;C1[r]-=dl;} \
        _Pragma("unroll") for(int r=0;r<16;++r)negm[r]=-mhat; asm volatile("":"+v"(negm)); \
        const float f=__builtin_amdgcn_exp2f(-dl); l_reg*=f; if(hi==0)wsf[r32]=f; resc=true; } } \
    SBAR(); \
    GAPB(o[0]=__builtin_amdgcn_mfma_f32_32x32x16_bf16(PAF(0),VFR(0),o[0],0,0,0), C0,0); \
    GAPB(o[1]=__builtin_amdgcn_mfma_f32_32x32x16_bf16(PAF(0),VFR(4),o[1],0,0,0), C0,4); \
    KRD(GL,0); GAPB(o[0]=__builtin_amdgcn_mfma_f32_32x32x16_bf16(PAF(1),VFR(1),o[0],0,0,0), C0,8); \
    KRD(GL,1); GAPB(o[1]=__builtin_amdgcn_mfma_f32_32x32x16_bf16(PAF(1),VFR(5),o[1],0,0,0), C0,12); \
    KRD(GL,2); GAPB(o[0]=__builtin_amdgcn_mfma_f32_32x32x16_bf16(PAF(2),VFR(2),o[0],0,0,0), C1,0); \
    KRD(GL,3); GAPB(o[1]=__builtin_amdgcn_mfma_f32_32x32x16_bf16(PAF(2),VFR(6),o[1],0,0,0), C1,4); \
    GAPB(o[0]=__builtin_amdgcn_mfma_f32_32x32x16_bf16(PAF(3),VFR(3),o[0],0,0,0), C1,8); \
    GAPB(o[1]=__builtin_amdgcn_mfma_f32_32x32x16_bf16(PAF(3),VFR(7),o[1],0,0,0), C1,12); \
    }while(0)
  int t=1;
  for(;t+5<NT;t+=2){
    STEP(pB0,pB1,pA0,pA1,t,true,true,true);     WAIT_BAR(2); RESC(); ROT();
    STEP(pA0,pA1,pB0,pB1,t+1,true,true,true);   WAIT_BAR(2); RESC(); ROT();
  }
  #define ENDW(tt) do{ if((tt)+3<NT){WAIT_BAR(2);} else if((tt)+2<NT){WAIT_BAR(1);} else {WAIT_BAR(0);} }while(0)
  for(;t+1<NT;t+=2){
    STEP(pB0,pB1,pA0,pA1,t,(t+3<NT),(t+1<NT),(t+1<NT));       ENDW(t);   RESC(); ROT();
    STEP(pA0,pA1,pB0,pB1,t+1,(t+4<NT),(t+2<NT),(t+2<NT));     ENDW(t+1); RESC(); ROT();
  }
  STEP(pB0,pB1,pA0,pA1,NT-1,false,false,false); RESC();
  { float sacc=pB0[0]+pB0[1]; _Pragma("unroll") for(int r=2;r<16;++r)sacc+=pB0[r]; _Pragma("unroll") for(int r=0;r<16;++r)sacc+=pB1[r]; l_reg+=sacc;
    pw0=(u32x4){PKW(pB0,0),PKW(pB0,2),PKW(pB0,4),PKW(pB0,6)};pw1=(u32x4){PKW(pB0,8),PKW(pB0,10),PKW(pB0,12),PKW(pB0,14)};pw2=(u32x4){PKW(pB1,0),PKW(pB1,2),PKW(pB1,4),PKW(pB1,6)};pw3=(u32x4){PKW(pB1,8),PKW(pB1,10),PKW(pB1,12),PKW(pB1,14)};
    SBAR(); pv(o,vb0+sl_cur,PAF(0),PAF(1),PAF(2),PAF(3)); }
  #undef PKW
  #undef PAF
  #undef VFR
  #undef PIN
  #undef MX3
  #undef GAPA
  #undef GAPB
  #undef EX
  #undef VRD
  #undef KRD
  #undef STEP
  #undef ENDW
  {auto rr=__builtin_amdgcn_permlane32_swap(__float_as_uint(l_reg),__float_as_uint(l_reg),false,false);l_reg=__uint_as_float(rr[0])+__uint_as_float(rr[1]);}
  if(hi==0)wsf[32+r32]=l_reg;asm volatile("s_waitcnt lgkmcnt(0)":::"memory");
  float rli[16];
  #pragma unroll
  for(int r=0;r<16;++r)rli[r]=__builtin_amdgcn_rcpf(wsf[32+crow(r,hi)]);
  bf16*Ow=Ou+(long)(wid*QBLK)*OP;
  { bf16*stg=(bf16*)(shm+LDS_OST)+wid*2048;
    #pragma unroll
    for(int r=0;r<16;++r){const int orow=crow(r,hi);
      #pragma unroll
      for(int d0=0;d0<2;++d0)stg[orow*64+d0*32+r32]=__float2bfloat16(o[d0][r]*rli[r]);}
    asm volatile("s_waitcnt lgkmcnt(0)":::"memory");
    #pragma unroll
    for(int i=0;i<4;++i){const int row=i*8+(lane>>3),ch=lane&7; const u32x4 v=*(const u32x4*)(stg+row*64+ch*8); ATTN_STORE16(Ow+(long)row*OP+ch*8,v);} }
  asm volatile("s_waitcnt lgkmcnt(0)\n\ts_barrier":::"memory");
  #undef DMA_K
  #undef KROW
  #undef DMA_V
  #undef CMASK
  #undef START
  #undef RESC
  #undef ROT
}
#undef SBAR
#undef WAIT_BAR
}

#define XB_TMO      128
#define XB_XCNT(j)  (256  + 64 * (j))
#define XB_XSUB(j)  (1280 + 64 * (j))
#define XB_XGEN(j)  (2304 + 64 * (j))
#define XB_TOP      3328
#define XB_TOPGEN   3392
#define XCD_BAR_WORDS 3456
#define XB_SPIN_CAP (1u << 18)

__device__ __forceinline__ unsigned xb_ld(unsigned* p)              { return __hip_atomic_load(p, __ATOMIC_RELAXED, __HIP_MEMORY_SCOPE_AGENT); }
__device__ __forceinline__ unsigned xb_add(unsigned* p, unsigned v) { return __hip_atomic_fetch_add(p, v, __ATOMIC_RELAXED, __HIP_MEMORY_SCOPE_AGENT); }
__device__ __forceinline__ unsigned xb_xcc_id() { return (unsigned)__builtin_amdgcn_s_getreg((3 << 11) | 20) & 0xFu; }
#define XB_SPIN(cond, bar) do { unsigned _sp = 0; while (cond) { __builtin_amdgcn_s_sleep(1); \
    if ((++_sp & 255u) == 0u) { if (xb_ld(&(bar)[XB_TMO])) break; if (_sp > XB_SPIN_CAP) { atomicAdd(&(bar)[XB_TMO], 1u); break; } } } } while (0)

struct XcdBarrier {
    unsigned* bar; unsigned x;
    volatile LAS unsigned* st;
};

__device__ __forceinline__ XcdBarrier xcd_barrier_post(unsigned* bar, volatile LAS unsigned* st) {
    XcdBarrier b; b.bar = bar; b.x = xb_xcc_id(); b.st = st;
    if (threadIdx.x == 0) (void)xb_add(&bar[XB_XCNT(b.x)], 1u);
    return b;
}
__device__ __forceinline__ void xcd_barrier_complete(unsigned* bar, unsigned x, unsigned& nloc, unsigned& nx) {
    const unsigned G = gridDim.x * gridDim.y * gridDim.z;
    unsigned sum, cnt, mine, sp = 0u;
    for (;;) {
        sum = 0u; cnt = 0u; mine = 0u;
#pragma unroll
        for (unsigned j = 0; j < 16; ++j) { const unsigned c = xb_ld(&bar[XB_XCNT(j)]); sum += c; cnt += (c > 0u) ? 1u : 0u; mine = (j == x) ? c : mine; }
        if (sum == G) break;
        __builtin_amdgcn_s_sleep(1);
        if ((++sp & 255u) == 0u) { if (xb_ld(&bar[XB_TMO])) break; if (sp > XB_SPIN_CAP) { atomicAdd(&bar[XB_TMO], 1u); break; } }
    }
    nloc = mine > 0u ? mine : 1u; nx = cnt > 0u ? cnt : 1u;
}

__device__ __forceinline__ void xcd_barrier(const XcdBarrier& b) {
    asm volatile("s_waitcnt vmcnt(0)" ::: "memory");
    __syncthreads();
    if (threadIdx.x == 0) {
        unsigned* bar = b.bar;
        __builtin_amdgcn_s_waitcnt(0);
        unsigned nloc = b.st[0], nx = b.st[1];
        if (nloc == 0u) { xcd_barrier_complete(bar, b.x, nloc, nx); b.st[0] = nloc; b.st[1] = nx; }
        const unsigned old = xb_add(&bar[XB_XSUB(b.x)], 1u);
        const unsigned gen = old / nloc;
        if (old + 1u == (gen + 1u) * nloc) {
            __builtin_amdgcn_fence(__ATOMIC_RELEASE, "agent");
            asm volatile("s_waitcnt vmcnt(0)" ::: "memory");
            const unsigned og = xb_add(&bar[XB_TOP], 1u);
            const unsigned tg = og / nx;
            if (og + 1u == (tg + 1u) * nx) xb_add(&bar[XB_TOPGEN], 1u);
            else XB_SPIN(xb_ld(&bar[XB_TOPGEN]) == tg, bar);
            __builtin_amdgcn_fence(__ATOMIC_ACQUIRE, "agent");
            xb_add(&bar[XB_XGEN(b.x)], 1u);
            asm volatile("s_waitcnt vmcnt(0)" ::: "memory");
        } else {
            XB_SPIN(xb_ld(&bar[XB_XGEN(b.x)]) == gen, bar);
            __builtin_amdgcn_fence(__ATOMIC_ACQUIRE, "agent");
            asm volatile("s_waitcnt vmcnt(0)" ::: "memory");
        }
    }
    __syncthreads();
}

__device__ __forceinline__ void sb_arrive(unsigned* ctr, int tid) {
    asm volatile("s_waitcnt vmcnt(0)" ::: "memory");
    __syncthreads();
    if (tid == 0) { __builtin_amdgcn_fence(__ATOMIC_RELEASE, "agent"); asm volatile("s_waitcnt vmcnt(0)" ::: "memory"); (void)xb_add(ctr, 1u); }
}
__device__ __forceinline__ void sb_wait(unsigned* ctr, unsigned need, unsigned* tmo, int tid) {
    if (tid == 0) { unsigned sp = 0u;
        while (xb_ld(ctr) < need) { __builtin_amdgcn_s_sleep(2); if (((++sp) & 1023u) == 0u) { if (xb_ld(tmo)) break; if (sp > (1u << 22)) { atomicAdd(tmo, 1u); break; } } }
        __builtin_amdgcn_fence(__ATOMIC_ACQUIRE, "agent"); asm volatile("s_waitcnt vmcnt(0)" ::: "memory"); }
    __syncthreads();
}

typedef unsigned short bf16_t;
constexpr size_t SZ_WIN = (size_t)INC * DMODEL * 2, SZ_WOUT = (size_t)DMODEL * DMODEL * 2, SZ_WFI = (size_t)2 * FFH * DMODEL * 2, SZ_WFO = (size_t)DMODEL * FFH * 2;
constexpr size_t WS_WIN = 0;
constexpr size_t WS_WOUT = WS_WIN + NLAY * SZ_WIN;
constexpr size_t WS_WFI = WS_WOUT + NLAY * SZ_WOUT;
constexpr size_t WS_WFO = WS_WFI + NLAY * SZ_WFI;
constexpr size_t WS_MOD = WS_WFO + NLAY * SZ_WFO;
constexpr size_t WS_ROPE = WS_MOD + (size_t)NLAY * 9 * MODW * 4;
constexpr size_t WS_HF = WS_ROPE + 64 * 16 * 2 * 4;
constexpr size_t WS_HC = WS_HF + (size_t)NLAY * 256 * 8192 * 2;
constexpr size_t WS_F = WS_HC + (size_t)NLAY * 256 * 512 * 4;
constexpr size_t WS_XN = WS_F + (size_t)256 * 8 * 1024 * 16;
constexpr size_t WS_P = WS_XN + (size_t)MT * DMODEL * 2;
constexpr size_t WS_MIX = WS_P + (size_t)MT * INC * 2;
constexpr size_t WS_XC = WS_MIX + (size_t)MT * DMODEL * 2;
constexpr size_t WS_UT = WS_XC + (size_t)MC * DMODEL * 4;
constexpr size_t WS_X2T = WS_UT + (size_t)NB * 256 * SEQ * 2;
constexpr size_t WS_CTL = WS_X2T + (size_t)NB * 256 * SEQ * 2;
constexpr size_t CTL_BYTES = 65536;
constexpr size_t WS_RSS = WS_CTL + CTL_BYTES;
constexpr size_t WS_CVI = WS_RSS + (size_t)4 * MT * 4;
constexpr size_t WS_CVF = WS_CVI + (size_t)NLAY * 9 * INC * 4;
constexpr size_t WS_YT = WS_CVF + (size_t)NLAY * 9 * 2 * FFH * 4;
constexpr size_t WS_ACTC = WS_YT + (size_t)NB * 256 * SEQ * 2;
constexpr size_t WS_END = WS_ACTC + (size_t)MC * FFH * 2;
static_assert(WS_END <= (size_t)4 * NB * SEQ * DMODEL * 4, "workspace must fit 4x the largest tensor");
static_assert((size_t)MT * FFH * 2 <= (size_t)MT * INC * 2 + (size_t)MT * DMODEL * 2, "ACT overlay");
static_assert(WS_ROPE % 256 == 0 && WS_HF % 256 == 0 && WS_F % 256 == 0 && WS_XN % 256 == 0 && WS_P % 256 == 0 && WS_MIX % 256 == 0 && WS_UT % 256 == 0, "alignment");

constexpr int LDS_BYTES = 147456;
constexpr int NA_BIAS_OFF = 98304;

struct KArgs { const float* in[27]; float* out; unsigned char* ws; };

__device__ __forceinline__ void transpose_item(const float* W, int N, int K, bf16_t* WT, int k0, int n0, int drow0, LAS float* scr, int lane) {
#pragma unroll 8
    for (int i = 0; i < 32; ++i) { const int kk = 2 * i + (lane >> 5); scr[kk * 33 + (lane & 31)] = W[(size_t)(k0 + kk) * N + n0 + (lane & 31)]; }
    asm volatile("s_waitcnt lgkmcnt(0)" ::: "memory");
    const int c = lane & 7;
#pragma unroll
    for (int j = 0; j < 4; ++j) { const int n = (lane >> 3) + 8 * j; const LAS float* s = scr + (8 * c) * 33 + n;
        v4u o; o.x = pk2(s[0 * 33], s[1 * 33]); o.y = pk2(s[2 * 33], s[3 * 33]); o.z = pk2(s[4 * 33], s[5 * 33]); o.w = pk2(s[6 * 33], s[7 * 33]);
        *(v4u*)(WT + (size_t)(drow0 + n) * K + k0 + 8 * c) = o; }
    asm volatile("s_waitcnt lgkmcnt(0)" ::: "memory");
}

__device__ __forceinline__ void norm_row(const float* xrow, const float* g, const float* shift, const float* scale, bf16_t* orow, int lane) {
    const f32x4v* xr = (const f32x4v*)xrow + lane;
    f32x4v v[4]; float s = 0.f;
#pragma unroll
    for (int j = 0; j < 4; ++j) { v[j] = xr[64 * j]; s += (v[j].x * v[j].x + v[j].y * v[j].y) + (v[j].z * v[j].z + v[j].w * v[j].w); }
    const float rstd = rsqrtf(wave_sum(s) * (1.f / DMODEL) + NORM_EPS);
    unsigned long long* o8 = (unsigned long long*)orow + lane;
#pragma unroll
    for (int j = 0; j < 4; ++j) { const f32x4v gg = ((const f32x4v*)g)[lane + 64 * j], sh = ((const f32x4v*)shift)[lane + 64 * j], sc = ((const f32x4v*)scale)[lane + 64 * j];
        const f32x4v y = v[j] * rstd * gg * (sc + 1.0f) + sh;
        o8[64 * j] = (unsigned long long)pk2(y.x, y.y) | ((unsigned long long)pk2(y.z, y.w) << 32); }
}

__device__ __forceinline__ void norm_phase(const float* xl, const float* xc, const float* g, const float* mod, int shoff, int scoff, bf16_t* XN, int mrows, int gw, int NGW, int lane) {
    for (int m = gw; m < mrows; m += NGW) {
        const bool lat = m < ML; const int bidx = lat ? (m >> 12) : 8;
        const float* xrow = lat ? xl + (size_t)m * DMODEL : xc + (size_t)(m - ML) * DMODEL;
        norm_row(xrow, g, mod + (size_t)bidx * MODW + shoff, mod + (size_t)bidx * MODW + scoff, XN + (size_t)m * DMODEL, lane);
    }
}

__device__ __forceinline__ void prep0_phase(const float* xl, const float* xc, const float* g, const float* mod, bf16_t* XN, float* RSS, int gw, int NGW, int lane) {
    for (int m = gw; m < MT; m += NGW) {
        const bool lat = m < ML; const int bidx = lat ? (m >> 12) : 8;
        const float* xrow = lat ? xl + (size_t)m * DMODEL : xc + (size_t)(m - ML) * DMODEL;
        const f32x4v* xr = (const f32x4v*)xrow + lane; const f32x4v* sc = (const f32x4v*)(mod + (size_t)bidx * MODW + DMODEL);
        unsigned long long* o8 = (unsigned long long*)(XN + (size_t)m * DMODEL) + lane;
        float s = 0.f;
#pragma unroll
        for (int j = 0; j < 4; ++j) { const f32x4v v = xr[64 * j]; s += (v.x * v.x + v.y * v.y) + (v.z * v.z + v.w * v.w);
            const f32x4v y = v * ((const f32x4v*)g)[lane + 64 * j] * (sc[lane + 64 * j] + 1.0f);
            o8[64 * j] = (unsigned long long)pk2(y.x, y.y) | ((unsigned long long)pk2(y.z, y.w) << 32); }
        const float tot = wave_sum(s);
        if (lane < 4) RSS[(size_t)lane * MT + m] = (lane == 0) ? tot : 0.f;
    }
}

__device__ __forceinline__ void cvec_phase(const bf16_t* Win_t, const bf16_t* Wfi_t, const float* MOD, float* CVI, float* CVF, LAS unsigned char* lds, int bx, int G, int tid, int wid, int lane) {
    LAS float* sh = (LAS float*)lds;
    for (int l = 0; l < NLAY; ++l) {
        __syncthreads();
        for (int i = tid; i < 2 * 9 * 1024; i += 512) { const int which = i / 9216, rem = i % 9216, b = rem >> 10, k = rem & 1023; sh[i] = MOD[((size_t)l * 9 + b) * MODW + (which ? 3 * DMODEL : 0) + k]; }
        __syncthreads();
        for (int row = bx * 8 + wid; row < INC + 2 * FFH; row += G * 8) {
            const int which = row >= INC, n = which ? row - INC : row;
            const bf16_t* wrow = which ? Wfi_t + ((size_t)l * 2 * FFH + n) * DMODEL : Win_t + ((size_t)l * INC + n) * DMODEL;
            const v4u w0 = *(const v4u*)(wrow + lane * 8), w1 = *(const v4u*)(wrow + 512 + lane * 8);
            float wf[16];
            wf[0] = __builtin_bit_cast(float, w0.x << 16); wf[1] = __builtin_bit_cast(float, w0.x & 0xffff0000u); wf[2] = __builtin_bit_cast(float, w0.y << 16); wf[3] = __builtin_bit_cast(float, w0.y & 0xffff0000u);
            wf[4] = __builtin_bit_cast(float, w0.z << 16); wf[5] = __builtin_bit_cast(float, w0.z & 0xffff0000u); wf[6] = __builtin_bit_cast(float, w0.w << 16); wf[7] = __builtin_bit_cast(float, w0.w & 0xffff0000u);
            wf[8] = __builtin_bit_cast(float, w1.x << 16); wf[9] = __builtin_bit_cast(float, w1.x & 0xffff0000u); wf[10] = __builtin_bit_cast(float, w1.y << 16); wf[11] = __builtin_bit_cast(float, w1.y & 0xffff0000u);
            wf[12] = __builtin_bit_cast(float, w1.z << 16); wf[13] = __builtin_bit_cast(float, w1.z & 0xffff0000u); wf[14] = __builtin_bit_cast(float, w1.w << 16); wf[15] = __builtin_bit_cast(float, w1.w & 0xffff0000u);
            float mine = 0.f;
            for (int b = 0; b < 9; ++b) { const LAS float* p = sh + (which * 9 + b) * 1024 + lane * 8; float sacc = 0.f;
#pragma unroll
                for (int i = 0; i < 8; ++i) sacc += wf[i] * p[i] + wf[8 + i] * p[512 + i];
                sacc = wave_sum(sacc); if (lane == b) mine = sacc; }
            if (lane < 9) { if (which) CVF[((size_t)l * 9 + lane) * (2 * FFH) + n] = mine; else CVI[((size_t)l * 9 + lane) * INC + n] = mine; }
        }
    }
    __syncthreads();
}

__device__ __forceinline__ void fbuild_phase(const bf16_t* Hf, bf16_t* F, int gtid, int gthreads) {
    for (int idx = gtid; idx < 256 * 1024; idx += gthreads) {
        const int c = idx >> 10, qi = idx & 1023, B = 8 * (qi - 512) + 4088;
        const bf16_t* h = Hf + (size_t)c * 8192;
        v4u lo = (v4u){0u, 0u, 0u, 0u}, hi;
        if (B >= 0) lo = *(const v4u*)(h + B);
        hi = *(const v4u*)(h + B + 8);
        if (B == 0) lo.x &= 0xffff0000u;
        if (B == -8) hi.x &= 0xffff0000u;
        const unsigned d[8] = {lo.x, lo.y, lo.z, lo.w, hi.x, hi.y, hi.z, hi.w};
#pragma unroll
        for (int r = 0; r < 8; ++r) { unsigned o[4];
#pragma unroll
            for (int j = 0; j < 4; ++j) { const int e0 = r + 8 - 2 * j, e1 = e0 - 1;
                const unsigned a = (d[e0 >> 1] >> (16 * (e0 & 1))) & 0xffffu, b = (d[e1 >> 1] >> (16 * (e1 & 1))) & 0xffffu; o[j] = a | (b << 16); }
            *(v4u*)(F + (((size_t)(c * 8 + r)) * 1024 + qi) * 8) = (v4u){o[0], o[1], o[2], o[3]}; }
    }
}

__device__ __forceinline__ void filter_rows(const KArgs& a, bf16_t* Hf, float* Hc, int gw, int NGW, int lane) {
    constexpr int R = 8;
    for (int it = gw; it < NLAY * (SEQ + CTX) / R; it += NGW) {
        const int l = it / ((SEQ + CTX) / R), rr = (it % ((SEQ + CTX) / R)) * R; const bool isc = rr >= SEQ; const int t0 = isc ? rr - SEQ : rr, L = isc ? CTX : SEQ;
        float tn[R], z[R], h[R], s[R];
#pragma unroll
        for (int r = 0; r < R; ++r) { const int t = t0 + r; tn[r] = (float)t / (float)(L - 1); const float w = 6.283185307179586f * (float)t / (float)L;
            z[r] = 0.f;
            if (lane == 0) z[r] = tn[r];
            else if (lane <= 16) { const float fr = 1e-4f + (float)(lane - 1) * ((15.0f - 1e-4f) / 15.0f); z[r] = cosf(fr * w); }
            else if (lane <= 32) { const float fr = 1e-4f + (float)(lane - 17) * ((15.0f - 1e-4f) / 15.0f); z[r] = -sinf(fr * w); } }
        const float* w1 = a.in[12] + (size_t)l * 33 * 64; const float* w2 = a.in[14] + (size_t)l * 64 * 64; const float* w3 = a.in[16] + (size_t)l * 64 * 64; const float* wo = a.in[18] + (size_t)l * 64 * 512;
        const float om = a.in[19][l * 64 + lane];
#pragma unroll
        for (int r = 0; r < R; ++r) s[r] = a.in[13][l * 64 + lane];
#pragma unroll 3
        for (int k = 0; k < 33; ++k) { const float wv = w1[k * 64 + lane];
#pragma unroll
            for (int r = 0; r < R; ++r) s[r] += __shfl(z[r], k) * wv; }
#pragma unroll
        for (int r = 0; r < R; ++r) { h[r] = sinf(om * s[r]); s[r] = a.in[15][l * 64 + lane]; }
#pragma unroll 4
        for (int k = 0; k < 64; ++k) { const float wv = w2[k * 64 + lane];
#pragma unroll
            for (int r = 0; r < R; ++r) s[r] += __shfl(h[r], k) * wv; }
#pragma unroll
        for (int r = 0; r < R; ++r) { h[r] = sinf(om * s[r]); s[r] = a.in[17][l * 64 + lane]; }
#pragma unroll 4
        for (int k = 0; k < 64; ++k) { const float wv = w3[k * 64 + lane];
#pragma unroll
            for (int r = 0; r < R; ++r) s[r] += __shfl(h[r], k) * wv; }
#pragma unroll
        for (int r = 0; r < R; ++r) h[r] = sinf(om * s[r]);
        float o[R][8];
#pragma unroll
        for (int r = 0; r < R; ++r)
#pragma unroll
            for (int i = 0; i < 8; ++i) o[r][i] = 0.f;
#pragma unroll 2
        for (int k = 0; k < 64; ++k) { float hk[R];
#pragma unroll
            for (int r = 0; r < R; ++r) hk[r] = __shfl(h[r], k);
#pragma unroll
            for (int i = 0; i < 8; ++i) { const float wv = wo[k * 512 + lane + 64 * i];
#pragma unroll
                for (int r = 0; r < R; ++r) o[r][i] += hk[r] * wv; } }
        const float d0 = -4.605170185988091f / 1.5f, d1 = -4.605170185988091f / 0.3f;
#pragma unroll
        for (int i = 0; i < 8; ++i) { const int n = lane + 64 * i, c = n & 255; const bool bwd = n >= 256;
            const float delta = d0 + (float)c * ((d1 - d0) / 255.0f);
#pragma unroll
            for (int r = 0; r < R; ++r) { const int t = t0 + r; const float val = o[r][i] * expf(-tn[r] * fabsf(delta));
                if (!bwd || t > 0) { if (isc) Hc[((size_t)l * 256 + c) * 512 + 256 + (bwd ? -t : t)] = val; else Hf[((size_t)l * 256 + c) * 8192 + 4096 + (bwd ? -t : t)] = (bf16_t)f2bf((t == 0) ? val + a.in[20][l * 256 + c] : val); } } }
    }
}

__device__ __forceinline__ void mod_phase(const KArgs& a, float* MOD, LAS unsigned char* lds, int bx, int G, int tid, int wid, int lane) {
    LAS float* sc = (LAS float*)lds;
    LAS float* red = (LAS float*)(lds + 9 * 1024 * 4);
    for (int i = tid; i < 9 * 1024; i += 512) { const float x = (i < 8 * 1024) ? a.in[1][i] : a.in[3][i - 8 * 1024]; sc[i] = x / (1.0f + __expf(-x)); }
    __syncthreads();
    for (int u = bx; u < NLAY * (MODW / 64); u += G) {
        const int l = u / (MODW / 64), n0 = (u % (MODW / 64)) * 64;
        const float* W = a.in[4] + (size_t)l * DMODEL * MODW + n0 + lane;
        float acc[9];
#pragma unroll
        for (int j = 0; j < 9; ++j) acc[j] = 0.f;
        for (int k = wid * 128; k < wid * 128 + 128; ++k) { const float wv = W[(size_t)k * MODW];
#pragma unroll
            for (int j = 0; j < 9; ++j) acc[j] += sc[j * 1024 + k] * wv; }
#pragma unroll
        for (int j = 0; j < 9; ++j) red[(wid * 9 + j) * 64 + lane] = acc[j];
        __syncthreads();
        for (int i = tid; i < 9 * 64; i += 512) { const int j = i >> 6, c = i & 63; float s = a.in[5][(size_t)l * MODW + n0 + c];
#pragma unroll
            for (int w = 0; w < 8; ++w) s += red[(w * 9 + j) * 64 + c];
            MOD[((size_t)l * 9 + j) * MODW + n0 + c] = s; }
        __syncthreads();
    }
}

__device__ __forceinline__ void hy_prep_unit(const bf16_t* P, const float* cw, const float* cb, bf16_t* UT, bf16_t* X2T, int b, int s0, int c0, LAS unsigned char* lds, int tid) {
    LAS float* in = (LAS float*)lds;
    for (int idx = tid; idx < 3 * 66 * 8; idx += 512) {
        const int sec = idx / (66 * 8), rem = idx % (66 * 8), rr = rem >> 3, ch = rem & 7, s = s0 - 1 + rr;
        v4u raw = (v4u){0u, 0u, 0u, 0u};
        if (s >= 0 && s < SEQ) raw = *(const v4u*)(P + (size_t)(b * SEQ + s) * INC + sec * 256 + c0 + ch * 8);
        LAS float* d = in + (sec * 66 + rr) * 65 + ch * 8;
        d[0] = __builtin_bit_cast(float, raw.x << 16); d[1] = __builtin_bit_cast(float, raw.x & 0xffff0000u);
        d[2] = __builtin_bit_cast(float, raw.y << 16); d[3] = __builtin_bit_cast(float, raw.y & 0xffff0000u);
        d[4] = __builtin_bit_cast(float, raw.z << 16); d[5] = __builtin_bit_cast(float, raw.z & 0xffff0000u);
        d[6] = __builtin_bit_cast(float, raw.w << 16); d[7] = __builtin_bit_cast(float, raw.w & 0xffff0000u);
    }
    __syncthreads();
    {
        const int c = tid >> 3, k = tid & 7;
        float w[3][3], bb[3];
#pragma unroll
        for (int sec = 0; sec < 3; ++sec) { bb[sec] = cb[sec * 256 + c0 + c];
#pragma unroll
            for (int i = 0; i < 3; ++i) w[sec][i] = cw[i * 768 + sec * 256 + c0 + c]; }
        float vv[8], x2[8];
#pragma unroll
        for (int i = 0; i < 8; ++i) { const int rr = k * 8 + i; float cv[3];
#pragma unroll
            for (int sec = 0; sec < 3; ++sec) { const LAS float* p = in + (sec * 66 + rr) * 65 + c; cv[sec] = w[sec][0] * p[0] + w[sec][1] * p[65] + w[sec][2] * p[130] + bb[sec]; }
            vv[i] = cv[0] * cv[1]; x2[i] = cv[2]; }
        const size_t o = ((size_t)(b * 256 + c0 + c)) * SEQ + s0 + k * 8;
        v4u a; a.x = pk2(vv[0], vv[1]); a.y = pk2(vv[2], vv[3]); a.z = pk2(vv[4], vv[5]); a.w = pk2(vv[6], vv[7]); *(v4u*)(UT + o) = a;
        v4u d; d.x = pk2(x2[0], x2[1]); d.y = pk2(x2[2], x2[3]); d.z = pk2(x2[4], x2[5]); d.w = pk2(x2[6], x2[7]); *(v4u*)(X2T + o) = d;
    }
    __syncthreads();
}

constexpr int HY_PB = 5904;
__device__ __forceinline__ void hy_conv_unit(const bf16_t* UT, const bf16_t* F, bf16_t* YT, int c, LAS unsigned char* lds, int tid, int wid, int lane) {
    LAS bf16_t* U = (LAS bf16_t*)lds;
    { const unsigned z = (unsigned)opq(0);
      for (int i = tid; i < NB * HY_PB / 8; i += 512) ((LAS v4u*)U)[i] = (v4u){z, z, z, z}; }
    __syncthreads();
    for (int i = tid; i < NB * SEQ / 8; i += 512) { const int b = i >> 9, s = (i & 511) * 8, sp = s + 768;
        const v4u raw = *(const v4u*)(UT + ((size_t)(b * 256 + c)) * SEQ + s);
        *(LAS v4u*)(U + b * HY_PB + sp + 8 * (sp >> 8)) = raw; }
    __syncthreads();
    const int rp = wid & 3, gh = wid >> 2, mp = lane & 31, g = lane >> 5, bq = lane & 7, isub = (lane >> 3) & 3;
    const bf16x8v* F0 = (const bf16x8v*)F + ((size_t)(c * 8 + 2 * rp)) * 1024; const bf16x8v* F1 = F0 + 1024;
    f32x16 acc[2][2];
#pragma unroll
    for (int i = 0; i < 2; ++i)
#pragma unroll
        for (int j = 0; j < 2; ++j)
#pragma unroll
            for (int r = 0; r < 16; ++r) acc[i][j][r] = 0.f;
    const int G0 = 2 * gh, jlo = 64 * G0 - 255, jhi = 64 * (G0 + 1) + 48;
    const LAS bf16_t* Ub = U + bq * HY_PB;
    constexpr int PF = 4;
    bf16x8v a0b[PF], a1b[PF];
    const int qbase = mp - g + 512;
#pragma unroll
    for (int p = 0; p < PF; ++p) { a0b[p] = F0[2 * (jlo + p) + qbase]; a1b[p] = F1[2 * (jlo + p) + qbase]; }
#define HY_STEP(D0, D1) do { const int j = j0 + p; const bf16x8v a0 = a0b[p], a1 = a1b[p]; \
        { int jn = j + PF; jn = jn > jhi ? jhi : jn; a0b[p] = F0[2 * jn + qbase]; a1b[p] = F1[2 * jn + qbase]; } \
        if (D0) { const int sp = 256 * (4 * G0 + isub) + 8 * g + 768 - 16 * j; const bf16x8v bf = *(const LAS bf16x8v*)(Ub + sp + 8 * (sp >> 8)); \
            acc[0][0] = __builtin_amdgcn_mfma_f32_32x32x16_bf16(a0, bf, acc[0][0], 0, 0, 0); acc[1][0] = __builtin_amdgcn_mfma_f32_32x32x16_bf16(a1, bf, acc[1][0], 0, 0, 0); } \
        if (D1) { const int sp = 256 * (4 * (G0 + 1) + isub) + 8 * g + 768 - 16 * j; const bf16x8v bf = *(const LAS bf16x8v*)(Ub + sp + 8 * (sp >> 8)); \
            acc[0][1] = __builtin_amdgcn_mfma_f32_32x32x16_bf16(a0, bf, acc[0][1], 0, 0, 0); acc[1][1] = __builtin_amdgcn_mfma_f32_32x32x16_bf16(a1, bf, acc[1][1], 0, 0, 0); } } while (0)
    for (int j0 = jlo; j0 < jlo + 64; j0 += PF) {
#pragma unroll
        for (int p = 0; p < PF; ++p) HY_STEP(true, false); }
    for (int j0 = jlo + 64; j0 <= jhi - 64; j0 += PF) {
#pragma unroll
        for (int p = 0; p < PF; ++p) HY_STEP(true, true); }
    for (int j0 = jhi - 63; j0 <= jhi; j0 += PF) {
#pragma unroll
        for (int p = 0; p < PF; ++p) HY_STEP(false, true); }
#undef HY_STEP
    __syncthreads();
    LAS bf16_t* Y = (LAS bf16_t*)lds;
    for (int re_ = 0; re_ < PR_HYEPI; ++re_) {
#pragma unroll
    for (int ri = 0; ri < 2; ++ri)
#pragma unroll
        for (int gi = 0; gi < 2; ++gi) { const int r = 2 * rp + ri, I = 4 * (G0 + gi) + isub;
#pragma unroll
            for (int reg = 0; reg < 16; ++reg) { const int m = (reg & 3) + 8 * (reg >> 2) + 4 * g, t = 256 * I + 8 * m + r;
                Y[bq * (SEQ + 136) + t + 8 * I] = (bf16_t)f2bf(acc[ri][gi][reg]); } }
    __syncthreads();
    for (int i = tid; i < NB * SEQ / 8; i += 512) { const int b = i >> 9, t = (i & 511) * 8;
        *(v4u*)(YT + ((size_t)(b * 256 + c)) * SEQ + t) = *(const LAS v4u*)(Y + b * (SEQ + 136) + t + 8 * (t >> 8)); }
    }
    __syncthreads();
}

__device__ __forceinline__ void hy_post_unit(const bf16_t* YT, const bf16_t* X2T, bf16_t* MIX, int b, int t0, LAS unsigned char* lds, int tid) {
    LAS bf16_t* T = (LAS bf16_t*)lds;
#pragma unroll
    for (int k = 0; k < 4; ++k) { const int idx = tid + 512 * k, c = idx >> 3, ch = idx & 7;
        const size_t o = ((size_t)(b * 256 + c)) * SEQ + t0 + ch * 8;
        const v4u y = *(const v4u*)(YT + o), x = *(const v4u*)(X2T + o);
        const unsigned yy[4] = {y.x, y.y, y.z, y.w}, xx[4] = {x.x, x.y, x.z, x.w};
#pragma unroll
        for (int e = 0; e < 4; ++e) { const float lo = __builtin_bit_cast(float, yy[e] << 16) * __builtin_bit_cast(float, xx[e] << 16), hi = __builtin_bit_cast(float, yy[e] & 0xffff0000u) * __builtin_bit_cast(float, xx[e] & 0xffff0000u);
            T[(ch * 8 + 2 * e) * 260 + c] = (bf16_t)f2bf(lo); T[(ch * 8 + 2 * e + 1) * 260 + c] = (bf16_t)f2bf(hi); } }
    __syncthreads();
#pragma unroll
    for (int k = 0; k < 4; ++k) { const int idx = tid + 512 * k, t = idx >> 5, ch = idx & 31;
        const LAS v2u* p = (const LAS v2u*)(T + t * 260 + ch * 8); const v2u a = p[0], d = p[1];
        *(v4u*)(MIX + (size_t)(b * SEQ + t0 + t) * DMODEL + ch * 8) = (v4u){a.x, a.y, d.x, d.y}; }
    __syncthreads();
}

__device__ __forceinline__ void hy_ctx_unit(const bf16_t* P, const float* cw, const float* cb, const float* Hc, const float* skip, bf16_t* MIX, int b, int c0, LAS unsigned char* lds, int tid) {
    LAS float* vv = (LAS float*)lds;
    LAS float* fc = vv + 256 * 17;
    const int c = tid & 15, tq = tid >> 4;
    const bf16_t* Pb = P + (size_t)(ML + b * CTX) * INC;
    float w[3][3], bb[3];
#pragma unroll
    for (int sec = 0; sec < 3; ++sec) { bb[sec] = cb[sec * 256 + c0 + c];
#pragma unroll
        for (int i = 0; i < 3; ++i) w[sec][i] = cw[i * 768 + sec * 256 + c0 + c]; }
#pragma unroll 2
    for (int i = 0; i < 8; ++i) { const int s = tq + 32 * i; float cv[2];
#pragma unroll
        for (int sec = 0; sec < 2; ++sec) { float x = bb[sec];
#pragma unroll
            for (int k = 0; k < 3; ++k) { const int ss = s - 1 + k; if (ss >= 0 && ss < CTX) x += w[sec][k] * bf2f(Pb[(size_t)ss * INC + sec * 256 + c0 + c]); }
            cv[sec] = x; }
        vv[s * 17 + c] = cv[0] * cv[1]; }
    for (int i = tid; i < 16 * 512; i += 512) { const int cc = i >> 9, id = i & 511; float x = (id >= 1) ? Hc[(size_t)(c0 + cc) * 512 + id] : 0.f; if (id == 256) x += skip[c0 + cc]; fc[cc * 513 + id] = x; }
    __syncthreads();
    float acc[8];
#pragma unroll
    for (int i = 0; i < 8; ++i) acc[i] = 0.f;
    const LAS float* fcc = fc + c * 513 + 256 + tq;
    for (int s = 0; s < CTX; ++s) { const float v = vv[s * 17 + c];
#pragma unroll
        for (int i = 0; i < 8; ++i) acc[i] += v * fcc[32 * i - s]; }
#pragma unroll 2
    for (int i = 0; i < 8; ++i) { const int t = tq + 32 * i; float x = bb[2];
#pragma unroll
        for (int k = 0; k < 3; ++k) { const int ss = t - 1 + k; if (ss >= 0 && ss < CTX) x += w[2][k] * bf2f(Pb[(size_t)ss * INC + 512 + c0 + c]); }
        MIX[(size_t)(ML + b * CTX + t) * DMODEL + c0 + c] = (bf16_t)f2bf(x * acc[i]); }
    __syncthreads();
}

__global__ void __launch_bounds__(512, 2) hybrid_fwd(KArgs a) {
    extern __shared__ __attribute__((aligned(16))) unsigned char lds_raw[];
    LAS unsigned char* lds = (LAS unsigned char*)lds_raw;
    cg::grid_group grid = cg::this_grid();
    const int tid = threadIdx.x, lane = tid & 63, wid = __builtin_amdgcn_readfirstlane(tid >> 6);
    const int G = gridDim.x, bx = blockIdx.x, gw = bx * 8 + wid, NGW = G * 8, gtid = bx * 512 + tid, gthreads = G * 512;
    unsigned char* ws = a.ws;
    bf16_t* Win_t = (bf16_t*)(ws + WS_WIN); bf16_t* Wout_t = (bf16_t*)(ws + WS_WOUT); bf16_t* Wfi_t = (bf16_t*)(ws + WS_WFI); bf16_t* Wfo_t = (bf16_t*)(ws + WS_WFO);
    float* MOD = (float*)(ws + WS_MOD); float* ROPE = (float*)(ws + WS_ROPE); bf16_t* Hf = (bf16_t*)(ws + WS_HF); float* Hc = (float*)(ws + WS_HC);
    bf16_t* F = (bf16_t*)(ws + WS_F); bf16_t* XN = (bf16_t*)(ws + WS_XN); bf16_t* P = (bf16_t*)(ws + WS_P); bf16_t* MIX = (bf16_t*)(ws + WS_MIX); bf16_t* ACT = (bf16_t*)(ws + WS_P);
    float* XC = (float*)(ws + WS_XC); bf16_t* UT = (bf16_t*)(ws + WS_UT); bf16_t* X2T = (bf16_t*)(ws + WS_X2T); bf16_t* YT = (bf16_t*)(ws + WS_YT);
    float* XL = a.out;
    float* RSS = (float*)(ws + WS_RSS); float* CVI = (float*)(ws + WS_CVI); float* CVF = (float*)(ws + WS_CVF);
    volatile LAS unsigned* xst = (volatile LAS unsigned*)(lds + LDS_BYTES - 64);
    if (tid < 16) xst[tid] = 0u;
    __syncthreads();
    XcdBarrier xbar = xcd_barrier_post((unsigned*)(ws + WS_CTL), xst);

    for (int rp0_ = 0; rp0_ < PR_P0; ++rp0_) {
        LAS float* scr = (LAS float*)(lds + 65536 + wid * 8704);
        constexpr int I_IN = (DMODEL / 64) * (INC / 32), I_OUT = (DMODEL / 64) * (DMODEL / 32), I_FI = (DMODEL / 64) * (2 * FFH / 32), I_FO = (FFH / 64) * (DMODEL / 32);
        constexpr int I_L = I_IN + I_OUT + I_FI + I_FO;
        for (int it = gw; it < NLAY * I_L; it += NGW) {
            const int l = it / I_L; int r = it % I_L;
            if (r < I_IN) { const int nblk = INC / 32, kb = r / nblk, n0 = (r % nblk) * 32; const int pn = n0 >> 8, wc = (n0 & 255) >> 6, bj = (n0 & 63) >> 5;
                transpose_item(a.in[8] + (size_t)l * DMODEL * INC, INC, DMODEL, Win_t + (size_t)l * INC * DMODEL, kb * 64, n0, pn * 256 + bj * 128 + wc * 32, scr, lane); continue; }
            r -= I_IN;
            if (r < I_OUT) { const int nblk = DMODEL / 32, kb = r / nblk, n0 = (r % nblk) * 32;
                transpose_item(a.in[9] + (size_t)l * DMODEL * DMODEL, DMODEL, DMODEL, Wout_t + (size_t)l * DMODEL * DMODEL, kb * 64, n0, n0, scr, lane); continue; }
            r -= I_OUT;
            if (r < I_FI) { const int nblk = 2 * FFH / 32, kb = r / nblk, n0 = (r % nblk) * 32; const int half = n0 / FFH, idx = n0 % FFH, pn = idx >> 7, jj = idx & 127;
                transpose_item(a.in[24] + (size_t)l * DMODEL * 2 * FFH, 2 * FFH, DMODEL, Wfi_t + (size_t)l * 2 * FFH * DMODEL, kb * 64, n0, pn * 256 + half * 128 + jj, scr, lane); continue; }
            r -= I_FI;
            { const int nblk = DMODEL / 32, kb = r / nblk, n0 = (r % nblk) * 32;
                transpose_item(a.in[25] + (size_t)l * FFH * DMODEL, DMODEL, FFH, Wfo_t + (size_t)l * DMODEL * FFH, kb * 64, n0, n0, scr, lane); }
        }
        __syncthreads();
        mod_phase(a, MOD, lds, bx, G, opq(tid), wid, opq(lane));
        filter_rows(a, Hf, Hc, gw, NGW, opq(lane));
        for (int i = gtid; i < 64 * 16; i += gthreads) { const int pos = i >> 4, f = i & 15; const float inv = powf(10000.0f, -(float)f / 16.0f), ang = (float)pos * inv; ROPE[2 * i] = cosf(ang); ROPE[2 * i + 1] = sinf(ang); }
    }
    grid.sync();
    prep0_phase(a.in[0], a.in[2], a.in[6], MOD, XN, RSS, gw, NGW, opq(lane));
    fbuild_phase(Hf, F, opq(gtid), gthreads);
    cvec_phase(Win_t, Wfi_t, MOD, CVI, CVF, lds, bx, G, opq(tid), wid, opq(lane));
    GSYNC();

#pragma nounroll
    for (int l = 0; l < NLAY; ++l) {
        const bool last = (l == NLAY - 1);
        const float* modl = MOD + (size_t)l * 9 * MODW;
        const float* xl_in = (l == 0) ? a.in[0] : XL; const float* xc_in = (l == 0) ? a.in[2] : XC;
        { pg8::Gemm g{XN, Win_t + (size_t)l * INC * DMODEL, MT, INC, DMODEL}; pg8::StaticOrder S; S.init(MT, INC, G, bx);
          pg8::EpiInProj E{P, a.in[21] + l * 64, a.in[22] + l * 64, ROPE, RSS, CVI + (size_t)l * 9 * INC};
          pg8::gemm_phase<pg8::EpiInProj, pg8::StaticOrder, true, true>(lds, g, S, E); }
        GSYNC();
        {
            const attn_body::bf16* Pb = (const attn_body::bf16*)P; attn_body::bf16* Mb = (attn_body::bf16*)MIX;
            unsigned* cbase = (unsigned*)(ws + WS_CTL) + 4096 + 2048 * l;
            unsigned* ctrA = cbase; unsigned* ctrB = cbase + 64; unsigned* ctrC = cbase + 128; unsigned* cnt4c = cbase + 192; unsigned* cnt6c = cbase + 192 + 8 * 64; unsigned* tmo = (unsigned*)(ws + WS_CTL) + XB_TMO;
            float fixm;
            { const int ln_ = opq(lane); float mq = fabsf(a.in[21][l * 64 + ln_]), mk = fabsf(a.in[22][l * 64 + ln_]);
#pragma unroll
              for (int o_ = 1; o_ < 64; o_ <<= 1) { mq = fmaxf(mq, __shfl_xor(mq, o_)); mk = fmaxf(mk, __shfl_xor(mk, o_)); }
              fixm = fminf(64.0f * QSCALE * 1.015f * mq * mk, 60.0f); }
            const bf16_t* ACTCv = (const bf16_t*)(ws + WS_ACTC) - (size_t)ML * FFH;
            for (int u = bx; u < NB * 64 * 4; u += G) { const int b = u & 7, cgp = (u >> 3) & 3, sc = u >> 5;
                hy_prep_unit(P, a.in[10] + (size_t)l * 3 * 768, a.in[11] + (size_t)l * 768, UT, X2T, b, sc * 64, cgp * 64, lds, opq(tid)); }
            sb_arrive(ctrA, opq(tid));
            if (!last) { for (int vv_ = bx; vv_ < 256; vv_ += G) { const int v = (G == 256) ? (vv_ >= 240 ? vv_ - 240 : (vv_ < 208 ? vv_ + 16 : 1000)) : vv_; if (v >= 224) continue;
                if (v < 64) { const int b = v & 7, h = v >> 3, kvh = h >> 2;
                    attn_body::attn_unit<8, 2>(Pb + (size_t)(ML + b * CTX) * INC + 768 + h * 64, Pb + 1280 + kvh * 64, Pb + 1408 + kvh * 64,
                        Mb + (size_t)(ML + b * CTX) * DMODEL + 256 + h * 64, ML + b * CTX, 0, 0, 4, 0, 0, nullptr, (char*)lds_raw, fixm);
                } else if (v < 96) { const int w = v - 64, b = w & 7, h = w >> 3;
                    attn_body::attn_unit<8, 0>(Pb + (size_t)(ML + b * CTX) * INC + 1536 + h * 64, Pb + 1792 + h * 64, Pb + 2048 + h * 64,
                        Mb + (size_t)(ML + b * CTX) * DMODEL + 768 + h * 64, ML + b * CTX, 0, 0, 4, 0, 0, nullptr, (char*)lds_raw);
                } else { const int w = v - 96, b = w & 7, cgp = w >> 3;
                    hy_ctx_unit(P, a.in[10] + (size_t)l * 3 * 768, a.in[11] + (size_t)l * 768, Hc + (size_t)l * 256 * 512, a.in[20] + l * 256, MIX, b, cgp * 16, lds, opq(tid)); }
            }
              sb_arrive(ctrC, opq(tid)); }
#define GQA_UNIT(u) do { const int b = (u) & 7, idx = (u) >> 3, h = idx >> 4, qb = idx & 15, kvh = h >> 2; \
                attn_body::attn_unit<8, 2>(Pb + (size_t)(b * SEQ + qb * 256) * INC + 768 + h * 64, Pb + 1280 + kvh * 64, Pb + 1408 + kvh * 64, \
                    Mb + (size_t)(b * SEQ + qb * 256) * DMODEL + 256 + h * 64, ML + b * CTX, b * SEQ, 1 << 20, 68, 0, 0, nullptr, (char*)lds_raw, fixm); } while (0)
            for (int u = bx; u < 512; u += G) GQA_UNIT(u);
            if (!last) for (int v = bx; v < 32; v += G) { const int pb = v >> 2;
                sb_wait(ctrC, (unsigned)G, tmo, opq(tid));
                pg8::Gemm g{MIX, Wout_t + (size_t)l * DMODEL * DMODEL, MT, DMODEL, DMODEL}; pg8::OneUnit S{ML / 256 + pb, v & 3};
                pg8::EpiResid E{xl_in, xc_in, XL, XC, modl + 2 * DMODEL, XN, RSS, a.in[7] + l * DMODEL, modl + 4 * DMODEL, 1, (LAS float*)(lds + 131072)};
                pg8::gemm_phase<pg8::EpiResid, pg8::OneUnit, true, true>(lds, g, S, E);
                sb_arrive(cnt4c + 64 * pb, opq(tid)); }
            sb_wait(ctrA, (unsigned)G, tmo, opq(tid));
            for (int c = bx; c < 256; c += G) hy_conv_unit(UT, F, YT, c, lds, opq(tid), wid, opq(lane));
            sb_arrive(ctrB, opq(tid));
            if (!last) for (int v = bx; v < 208; v += G) if (v >= 32) { const int w = v - 32, pb = w / 22, pn = w % 22;
                sb_wait(cnt4c + 64 * pb, 4u, tmo, opq(tid));
                pg8::Gemm g{XN, Wfi_t + (size_t)l * 2 * FFH * DMODEL, MT, 2 * FFH, DMODEL}; pg8::OneUnit S{ML / 256 + pb, pn};
                pg8::EpiSwiglu E{(bf16_t*)ACTCv, RSS, CVF + (size_t)l * 9 * 2 * FFH};
                pg8::gemm_phase<pg8::EpiSwiglu, pg8::OneUnit, true, true>(lds, g, S, E);
                sb_arrive(cnt6c + 64 * pb, opq(tid)); }
            for (int u = 512 + bx; u < 1024; u += G) GQA_UNIT(u);
#undef GQA_UNIT
            const bool bal = (!last && G == 256);
            const int n_na = !bal ? ((512 - bx + G - 1) / G) : (bx >= 240 ? 4 : (bx >= 208 ? 1 : 2));
            for (int ii = 0; ii < n_na; ++ii) {
                const int v = !bal ? (bx + ii * G) : (ii < 2 ? bx + ii * 256 : 256 + 208 + 2 * (bx - 240) + (ii - 2));
                const int b = v & 7, idx = v >> 3, h = idx >> 4, qg = idx & 15;
                int r0 = 4 * qg - 4; r0 = r0 < 0 ? 0 : (r0 > 56 ? 56 : r0);
                LAS float* bias = (LAS float*)(lds + NA_BIAS_OFF);
                for (int i = opq(tid); i < 15 * 31; i += 512) bias[i] = a.in[23][((size_t)l * 4 + h) * 465 + i] * LOG2E;
                __syncthreads();
                attn_body::attn_unit<8, 1>(Pb + (size_t)(b * SEQ + qg * 256) * INC + 1536 + h * 64, Pb + 1792 + h * 64, Pb + 2048 + h * 64,
                    Mb + (size_t)(b * SEQ + qg * 256) * DMODEL + 768 + h * 64, ML + b * CTX, b * SEQ + r0 * 64, 63 - r0, 16, r0, 4 * qg, (const float*)(lds_raw + NA_BIAS_OFF), (char*)lds_raw);
            }
            if (!last) for (int v = bx; v < 240; v += G) if (v >= 208) { const int w = v - 208, pb = w >> 2;
                sb_wait(cnt6c + 64 * pb, 22u, tmo, opq(tid));
                pg8::Gemm g{ACTCv, Wfo_t + (size_t)l * DMODEL * FFH, MT, DMODEL, FFH}; pg8::OneUnit S{ML / 256 + pb, w & 3};
                pg8::EpiResid E{XL, XC, XL, XC, modl + 5 * DMODEL, XN, RSS, a.in[6] + (l + 1) * DMODEL, MOD + (size_t)(l + 1) * 9 * MODW + DMODEL, 1, (LAS float*)(lds + 131072)};
                pg8::gemm_phase<pg8::EpiResid, pg8::OneUnit, true, true>(lds, g, S, E); }
            sb_wait(ctrB, (unsigned)G, tmo, opq(tid));
            for (int u = bx; u < NB * 64; u += G) hy_post_unit(YT, X2T, MIX, u & 7, (u >> 3) * 64, lds, opq(tid));
        }
        GSYNC();
        const int mrows = ML;
        if (!last) fbuild_phase(Hf + (size_t)(l + 1) * 256 * 8192, F, opq(gtid), gthreads);
        { pg8::Gemm g{MIX, Wout_t + (size_t)l * DMODEL * DMODEL, mrows, DMODEL, DMODEL}; pg8::StaticOrder S; S.init(mrows, DMODEL, G, bx);
          pg8::EpiResid E{xl_in, xc_in, XL, XC, modl + 2 * DMODEL, XN, RSS, a.in[7] + l * DMODEL, modl + 4 * DMODEL, 1, (LAS float*)(lds + 131072)};
          pg8::gemm_phase<pg8::EpiResid, pg8::StaticOrder, true, true>(lds, g, S, E); }
        GSYNC();
        { pg8::Gemm g{XN, Wfi_t + (size_t)l * 2 * FFH * DMODEL, mrows, 2 * FFH, DMODEL}; pg8::StaticOrder S; S.init(mrows, 2 * FFH, G, bx);
          pg8::EpiSwiglu E{ACT, RSS, CVF + (size_t)l * 9 * 2 * FFH};
          for (int rf_ = 0; rf_ < PR_FFI; ++rf_) pg8::gemm_phase<pg8::EpiSwiglu, pg8::StaticOrder, true, true>(lds, g, S, E); }
        GSYNC();
        { pg8::Gemm g{ACT, Wfo_t + (size_t)l * DMODEL * FFH, mrows, DMODEL, FFH}; pg8::StaticOrder S; S.init(mrows, DMODEL, G, bx);
          pg8::EpiResid E{XL, XC, XL, XC, modl + 5 * DMODEL, XN, RSS, a.in[6] + (last ? l : l + 1) * DMODEL, MOD + (size_t)(last ? l : l + 1) * 9 * MODW + DMODEL, last ? 0 : 1, (LAS float*)(lds + 131072)};
          pg8::gemm_phase<pg8::EpiResid, pg8::StaticOrder, true, true>(lds, g, S, E); }
        GSYNC();
    }
    for (int m = gw; m < ML; m += NGW) { const int lane_o = opq(lane); f32x4v* xr = (f32x4v*)(XL + (size_t)m * DMODEL) + lane_o; f32x4v v[4]; float s = 0.f;
#pragma unroll
        for (int j = 0; j < 4; ++j) { v[j] = xr[64 * j]; s += (v[j].x * v[j].x + v[j].y * v[j].y) + (v[j].z * v[j].z + v[j].w * v[j].w); }
        const float rstd = rsqrtf(wave_sum(s) * (1.f / DMODEL) + NORM_EPS);
#pragma unroll
        for (int j = 0; j < 4; ++j) xr[64 * j] = v[j] * rstd * ((const f32x4v*)a.in[26])[lane_o + 64 * j]; }
}

extern "C" void kernel_launch(void* const* d_in, const int* in_sizes, int n_in, void* d_out, int out_size, void* d_ws, size_t ws_size, hipStream_t stream) {
    static int grid_blocks = 0;
    if (grid_blocks == 0) {
        if (n_in != 27 || ws_size < WS_END) { fprintf(stderr, "kernel_launch: expected 27 inputs and >= %zu bytes of workspace (got %d, %zu)\n", (size_t)WS_END, n_in, ws_size); grid_blocks = -1; return; }
        int dev = 0, cus = 0, per_cu = 0;
        hipGetDevice(&dev); hipDeviceGetAttribute(&cus, hipDeviceAttributeMultiprocessorCount, dev);
        hipFuncSetAttribute((const void*)hybrid_fwd, hipFuncAttributeMaxDynamicSharedMemorySize, LDS_BYTES);
        hipOccupancyMaxActiveBlocksPerMultiprocessor(&per_cu, (const void*)hybrid_fwd, 512, LDS_BYTES);
        if (per_cu < 1) per_cu = 1;
        grid_blocks = cus * per_cu;
        (void)hipGetLastError();
    }
    if (grid_blocks < 0) return;
    if (hipMemsetAsync((char*)d_ws + WS_CTL, 0, CTL_BYTES, stream) != hipSuccess) { fprintf(stderr, "kernel_launch: memset of the barrier words failed\n"); return; }
    KArgs a{};
    for (int i = 0; i < 27; ++i) a.in[i] = (const float*)d_in[i];
    a.out = (float*)d_out; a.ws = (unsigned char*)d_ws;
    void* args[] = {&a};
    hipError_t e = hipLaunchCooperativeKernel((const void*)hybrid_fwd, dim3(grid_blocks), dim3(512), args, LDS_BYTES, stream);
    if (e != hipSuccess) fprintf(stderr, "cooperative launch failed: %s (grid %d)\n", hipGetErrorString(e), grid_blocks);
}
```

```cpp
#include <hip/hip_runtime.h>
#include <hip/hip_bf16.h>
#include <hip/hip_cooperative_groups.h>
#include <cstdio>
#include <cstdint>
#include <cmath>
namespace cg = cooperative_groups;
#ifndef PR_SYNC
#define PR_SYNC 1
#endif
#ifndef PR_MIX
#define PR_MIX 1
#endif
#ifndef PR_HY
#define PR_HY 1
#endif
#ifndef PR_HYEPI
#define PR_HYEPI 1
#endif
#ifndef PR_P0
#define PR_P0 1
#endif
#ifndef PR_NA
#define PR_NA 1
#endif
#ifndef PR_NORM
#define PR_NORM 1
#endif
#ifndef PR_FFI
#define PR_FFI 1
#endif
#ifndef PR_GQA
#define PR_GQA 1
#endif
#define GSYNC() do { for (int s_ = 0; s_ < PR_SYNC; ++s_) xcd_barrier(xbar); } while (0)

constexpr int DMODEL = 1024, NB = 8, SEQ = 4096, NLAY = 4, CTX = 256;
constexpr int ML = NB * SEQ, MC = NB * CTX, MT = ML + MC;
constexpr int INC = 2304, FFH = 2816, MODW = 6 * DMODEL;
constexpr float NORM_EPS = 1e-6f;
constexpr float QSCALE = 0.125f * 1.4426950408889634f;
constexpr float LOG2E = 1.4426950408889634f;

#define LAS __attribute__((address_space(3)))
#define GAS __attribute__((address_space(1)))
typedef unsigned v4u __attribute__((ext_vector_type(4)));
typedef unsigned v2u __attribute__((ext_vector_type(2)));
typedef float f32x16 __attribute__((ext_vector_type(16)));
typedef float f32x4v __attribute__((ext_vector_type(4)));
typedef short bf16x8v __attribute__((ext_vector_type(8)));

__device__ __forceinline__ unsigned f2bf(float f) { unsigned u = __builtin_bit_cast(unsigned, f); return (u + 0x7fffu + ((u >> 16) & 1u)) >> 16; }
__device__ __forceinline__ unsigned pk2(float lo, float hi) { return f2bf(lo) | (f2bf(hi) << 16); }
__device__ __forceinline__ float bf2f(unsigned short u) { return __builtin_bit_cast(float, (unsigned)u << 16); }
__device__ __forceinline__ int opq(int v) { asm volatile("" : "+v"(v)); return v; }
__device__ __forceinline__ float wave_sum(float v) {
#pragma unroll
    for (int o = 1; o < 64; o <<= 1) v += __shfl_xor(v, o);
    return v;
}

namespace pg8 {
#define PG8_LAS __attribute__((address_space(3)))
typedef unsigned short bf16_t;
typedef short bf16x8 __attribute__((ext_vector_type(8)));
typedef float f32x4 __attribute__((ext_vector_type(4)));
typedef unsigned u32x4 __attribute__((ext_vector_type(4)));
constexpr int BM = 256, BK = 64, HALF = 128, HTB = HALF * BK * 2  , STAGE_BYTES = 8 * HTB, NXCD = 8, WGM = 8;

__host__ __device__ __forceinline__ int lds_byte(int r, int c) { const int st = (r >> 4) * 2 + (c >> 5), rr = r & 15, cc = c & 31, ob = rr * 64 + cc * 2; return st * 1024 + (ob ^ (((ob >> 9) & 1) << 5)); }
__host__ __device__ __forceinline__ void stage_rc(int b, int& R, int& C) { const int st = b / 1024, sb = b % 1024, swz = sb ^ (((sb >> 9) & 1) << 5); R = (st >> 1) * 16 + swz / 64; C = (st & 1) * 32 + (swz % 64) / 2; }
__host__ __device__ __forceinline__ int perm32(int rho) { const int n = rho >> 4, i = rho & 15; return 8 * (i >> 2) + 4 * n + (i & 3); }

struct Unit { int pm, pn; };
struct Gemm { const bf16_t* A; const bf16_t* Bt; int M, N, K; };

struct StaticOrder {
    int nM, nN, nwg, G, c;
    __host__ __device__ void init(int M, int N, int G_, int c_) { nM = M / BM; nN = N / BM; nwg = nM * nN; G = G_; c = c_; }
    __host__ __device__ bool next(int i, Unit& u) const {
        const long L = (long)i * G + c; if (L >= nwg) return false;
        int wgid = (int)L; { const int q = nwg / NXCD, r = nwg % NXCD, xcd = wgid % NXCD, off = wgid / NXCD; wgid = (xcd < r ? xcd * (q + 1) : r * (q + 1) + (xcd - r) * q) + off; }
        const int nig = WGM * nN, gid = wgid / nig, fm = gid * WGM, gsz = (nM - fm) < WGM ? (nM - fm) : WGM;
        u.pm = fm + ((wgid % nig) % gsz); u.pn = (wgid % nig) / gsz; return true;
    }
    __device__ __forceinline__ void a_ready(const Unit&) const {}
    __device__ __forceinline__ void done(const Unit&) const {}
};

struct OneUnit { int pm, pn;
    __host__ __device__ bool next(int i, Unit& u) const { if (i > 0) return false; u.pm = pm; u.pn = pn; return true; }
    __device__ __forceinline__ void a_ready(const Unit&) const {}
    __device__ __forceinline__ void done(const Unit&) const {} };
__device__ __forceinline__ unsigned cvt_pk_bf16(float lo, float hi) { unsigned r; asm volatile("v_cvt_pk_bf16_f32 %0, %1, %2" : "=v"(r) : "v"(lo), "v"(hi)); return r; }

__device__ __forceinline__ void rows_rstd(const float* RSS, int rowbase, int fq, float (&rs)[2][4]) {
    float part[2][4];
#pragma unroll
    for (int ai = 0; ai < 2; ++ai)
#pragma unroll
        for (int m = 0; m < 4; ++m) part[ai][m] = RSS[(size_t)fq * MT + rowbase + ai * HALF + m * 16];
#pragma unroll
    for (int ai = 0; ai < 2; ++ai)
#pragma unroll
        for (int m = 0; m < 4; ++m) { float ss = part[ai][m]; ss += __shfl_xor(ss, 16); ss += __shfl_xor(ss, 32); rs[ai][m] = rsqrtf(ss * (1.0f / DMODEL) + NORM_EPS); }
}

struct EpiInProj {
    static constexpr bool PERM = true, AFTER_DRAIN = false;
    bf16_t* P; const float* gq; const float* gk; const float* rope;
    const float* RSS; const float* cv;
    __device__ __forceinline__ void operator()(const f32x4 (&acc)[2][2][4][2], const Unit& u, int wr, int wc, int fr, int fq) const {
        asm volatile("" : "+v"(fr), "+v"(fq));
        const int pn = u.pn;
        int mode = 0;
        if (pn == 3 || pn == 4) mode = 1; else if (pn == 5) mode = (wc < 2) ? 2 : 0; else if (pn == 6) mode = 3;
        const int colbase = pn * 256 + 64 * wc + 8 * fq;
        const int bidx_ = (u.pm * BM < ML) ? ((u.pm * BM) >> 12) : 8;
        f32x4 cvv[2][2];
#pragma unroll
        for (int bj = 0; bj < 2; ++bj)
#pragma unroll
            for (int n = 0; n < 2; ++n) cvv[bj][n] = *(const f32x4*)(cv + (size_t)bidx_ * INC + pn * 256 + 128 * bj + 32 * wc + 8 * fq + 4 * n);
        float rsv[2][4]; rows_rstd(RSS, u.pm * BM + wr * 64 + fr, fq, rsv);
        float gv[2][2][4];
        if (mode == 1 || mode == 2) { const float* g = (mode == 1) ? gq : gk;
#pragma unroll
            for (int bj = 0; bj < 2; ++bj)
#pragma unroll
                for (int n = 0; n < 2; ++n) { const f32x4 t = *(const f32x4*)(g + 32 * bj + 8 * fq + 4 * n); gv[bj][n][0] = t[0]; gv[bj][n][1] = t[1]; gv[bj][n][2] = t[2]; gv[bj][n][3] = t[3]; } }
#pragma unroll
        for (int ai = 0; ai < 2; ++ai)
#pragma unroll
            for (int m = 0; m < 4; ++m) {
                const int row = u.pm * BM + ai * HALF + wr * 64 + m * 16 + fr;
                const float rs_ = rsv[ai][m];
                float v[2][2][4];
#pragma unroll
                for (int bj = 0; bj < 2; ++bj)
#pragma unroll
                    for (int n = 0; n < 2; ++n)
#pragma unroll
                        for (int j = 0; j < 4; ++j) v[bj][n][j] = acc[ai][bj][m][n][j] * rs_ + cvv[bj][n][j];
                if (mode == 1 || mode == 2) {
                    float ss = 0.f;
#pragma unroll
                    for (int bj = 0; bj < 2; ++bj)
#pragma unroll
                        for (int n = 0; n < 2; ++n)
#pragma unroll
                            for (int j = 0; j < 4; ++j) ss += v[bj][n][j] * v[bj][n][j];
                    ss += __shfl_xor(ss, 16); ss += __shfl_xor(ss, 32);
                    const float rstd = rsqrtf(ss * (1.0f / 64.0f) + NORM_EPS);
#pragma unroll
                    for (int bj = 0; bj < 2; ++bj)
#pragma unroll
                        for (int n = 0; n < 2; ++n)
#pragma unroll
                            for (int j = 0; j < 4; ++j) v[bj][n][j] = v[bj][n][j] * rstd * gv[bj][n][j];
                    if (row < ML) {
                        const int s = row & (SEQ - 1); const int pos = (fq < 2) ? (s >> 6) : (s & 63);
                        const float* rp = rope + (pos * 16 + (fq & 1) * 8) * 2;
#pragma unroll
                        for (int n = 0; n < 2; ++n) { const f32x4 c0 = *(const f32x4*)(rp + 8 * n), c1 = *(const f32x4*)(rp + 8 * n + 4);
                            const float cs[4] = {c0[0], c0[2], c1[0], c1[2]}, sn[4] = {c0[1], c0[3], c1[1], c1[3]};
#pragma unroll
                            for (int j = 0; j < 4; ++j) { const float x1 = v[0][n][j], x2 = v[1][n][j]; v[0][n][j] = x1 * cs[j] - x2 * sn[j]; v[1][n][j] = x1 * sn[j] + x2 * cs[j]; } }
                    }
                }
                if (mode == 1 || mode == 3) {
#pragma unroll
                    for (int bj = 0; bj < 2; ++bj)
#pragma unroll
                        for (int n = 0; n < 2; ++n)
#pragma unroll
                            for (int j = 0; j < 4; ++j) v[bj][n][j] *= QSCALE;
                }
                bf16_t* rowp = P + (size_t)row * INC + colbase;
#pragma unroll
                for (int bj = 0; bj < 2; ++bj) { u32x4 w; w.x = cvt_pk_bf16(v[bj][0][0], v[bj][0][1]); w.y = cvt_pk_bf16(v[bj][0][2], v[bj][0][3]); w.z = cvt_pk_bf16(v[bj][1][0], v[bj][1][1]); w.w = cvt_pk_bf16(v[bj][1][2], v[bj][1][3]);
                    *(u32x4*)(rowp + 32 * bj) = w; }
            }
    }
};

struct EpiResid {
    static constexpr bool PERM = true, AFTER_DRAIN = false;
    const float* rin_l; const float* rin_c; float* rout_l; float* rout_c; const float* gate;
    bf16_t* XNo; float* RSS; const float* gnext; const float* scnext; int wantA;
    PG8_LAS float* xs;
    __device__ __forceinline__ void operator()(const f32x4 (&acc)[2][2][4][2], const Unit& u, int wr, int wc, int fr, int fq) const {
        asm volatile("" : "+v"(fr), "+v"(fq));
        const int row0 = u.pm * BM; const bool lat = row0 < ML;
        const int bidx = lat ? (row0 >> 12) : 8;
        const float* rin = lat ? rin_l : rin_c - (size_t)ML * DMODEL; float* rout = lat ? rout_l : rout_c - (size_t)ML * DMODEL;
        const int col0 = u.pn * BM + wc * 32 + 8 * fq;
        f32x4 gt[2][2], gs[2][2];
#pragma unroll
        for (int bj = 0; bj < 2; ++bj)
#pragma unroll
            for (int n = 0; n < 2; ++n) { gt[bj][n] = *(const f32x4*)(gate + (size_t)bidx * MODW + col0 + bj * HALF + 4 * n);
                if (wantA) gs[bj][n] = *(const f32x4*)(gnext + col0 + bj * HALF + 4 * n) * (*(const f32x4*)(scnext + (size_t)bidx * MODW + col0 + bj * HALF + 4 * n) + 1.0f);
                else gs[bj][n] = (f32x4){0.f, 0.f, 0.f, 0.f}; }
#pragma unroll
        for (int ai = 0; ai < 2; ++ai)
#pragma unroll
            for (int mp2 = 0; mp2 < 2; ++mp2) {
                f32x4 xi[2][2][2];
#pragma unroll
                for (int q = 0; q < 2; ++q) { const size_t ro = (size_t)(row0 + ai * HALF + wr * 64 + (2 * mp2 + q) * 16 + fr) * DMODEL + col0;
#pragma unroll
                    for (int bj = 0; bj < 2; ++bj)
#pragma unroll
                        for (int n = 0; n < 2; ++n) xi[q][bj][n] = *(const f32x4*)(rin + ro + bj * HALF + 4 * n); }
#pragma unroll
                for (int q = 0; q < 2; ++q) { const int m = 2 * mp2 + q; const int row = row0 + ai * HALF + wr * 64 + m * 16 + fr; const size_t ro = (size_t)row * DMODEL + col0;
                    float ss = 0.f;
#pragma unroll
                    for (int bj = 0; bj < 2; ++bj) { f32x4 xn[2];
#pragma unroll
                        for (int n = 0; n < 2; ++n) { xn[n] = xi[q][bj][n] + gt[bj][n] * acc[ai][bj][m][n];
                            *(f32x4*)(rout + ro + bj * HALF + 4 * n) = xn[n];
                            ss += (xn[n][0] * xn[n][0] + xn[n][1] * xn[n][1]) + (xn[n][2] * xn[n][2] + xn[n][3] * xn[n][3]); }
                        if (wantA) { const f32x4 a0 = xn[0] * gs[bj][0], a1 = xn[1] * gs[bj][1];
                            u32x4 w; w.x = cvt_pk_bf16(a0[0], a0[1]); w.y = cvt_pk_bf16(a0[2], a0[3]); w.z = cvt_pk_bf16(a1[0], a1[1]); w.w = cvt_pk_bf16(a1[2], a1[3]);
                            *(u32x4*)(XNo + ro + bj * HALF) = w; } }
                    if (wantA) { ss += __shfl_xor(ss, 16); ss += __shfl_xor(ss, 32);
                        if (fq == 0) xs[(ai * HALF + wr * 64 + m * 16 + fr) * 4 + wc] = ss; } } }
        if (wantA) {
            asm volatile("s_waitcnt lgkmcnt(0)\n\ts_barrier" ::: "memory");
            const int t = (wr * 4 + wc) * 64 + fq * 16 + fr;
            if (t < 256) { const f32x4 p = *(const PG8_LAS f32x4*)(xs + 4 * t); RSS[(size_t)u.pn * MT + row0 + t] = (p[0] + p[1]) + (p[2] + p[3]); }
        }
    }
};

struct EpiSwiglu {
    static constexpr bool PERM = true, AFTER_DRAIN = false;
    bf16_t* ACT; const float* RSS; const float* cv;
    __device__ __forceinline__ void operator()(const f32x4 (&acc)[2][2][4][2], const Unit& u, int wr, int wc, int fr, int fq) const {
        asm volatile("" : "+v"(fr), "+v"(fq));
        const int col0 = u.pn * HALF + wc * 32 + 8 * fq;
        const int bidx_ = (u.pm * BM < ML) ? ((u.pm * BM) >> 12) : 8;
        f32x4 cvv[2][2];
#pragma unroll
        for (int bj = 0; bj < 2; ++bj)
#pragma unroll
            for (int n = 0; n < 2; ++n) cvv[bj][n] = *(const f32x4*)(cv + (size_t)bidx_ * (2 * FFH) + u.pn * 256 + 128 * bj + 32 * wc + 8 * fq + 4 * n);
        float rsv[2][4]; rows_rstd(RSS, u.pm * BM + wr * 64 + fr, fq, rsv);
#pragma unroll
        for (int ai = 0; ai < 2; ++ai)
#pragma unroll
            for (int m = 0; m < 4; ++m) { const int row = u.pm * BM + ai * HALF + wr * 64 + m * 16 + fr;
                const float rs_ = rsv[ai][m];
                float o[2][4];
#pragma unroll
                for (int n = 0; n < 2; ++n)
#pragma unroll
                    for (int j = 0; j < 4; ++j) { const float g = acc[ai][0][m][n][j] * rs_ + cvv[0][n][j], uu = acc[ai][1][m][n][j] * rs_ + cvv[1][n][j];
                        o[n][j] = g * __builtin_amdgcn_rcpf(1.0f + __expf(-g)) * uu; }
                u32x4 w; w.x = cvt_pk_bf16(o[0][0], o[0][1]); w.y = cvt_pk_bf16(o[0][2], o[0][3]); w.z = cvt_pk_bf16(o[1][0], o[1][1]); w.w = cvt_pk_bf16(o[1][2], o[1][3]);
                *(u32x4*)(ACT + (size_t)row * FFH + col0) = w; }
    }
};

template <class Epi, class Sched, bool ALIGN_EPI = false, bool SP2 = false>
__device__ __forceinline__ void gemm_phase(PG8_LAS unsigned char* lds, const Gemm g, const Sched& S, const Epi& E) {
    int tid_o = threadIdx.x; asm volatile("" : "+v"(tid_o));
    const int tid = tid_o, wid = __builtin_amdgcn_readfirstlane(tid >> 6), lane = tid & 63, wr = wid >> 2, wc = wid & 3, fr = lane & 15, fq = lane >> 4;
    const int K = g.K, nt = K / BK;
    unsigned voffA[2], voffB[2];
#pragma unroll
    for (int i = 0; i < 2; ++i) { int R, C; stage_rc(tid * 16 + i * 8192, R, C); const int Rb = Epi::PERM ? ((R & ~31) + perm32(R & 31)) : R;
        voffA[i] = (unsigned)(R * K + C) * 2u; voffB[i] = (unsigned)(Rb * K + C) * 2u; }
    const size_t kstep = (size_t)(BK * 2);
    const size_t hstep = (size_t)HALF * K * 2;
    const size_t tstep = 2 * hstep;
    const unsigned ldsw = (unsigned)wid * 1024u;
    const int aoff = lds_byte(wr * 64 + fr, fq * 8), boff = lds_byte(wc * 32 + fr, fq * 8);
#define PG8_SA(b, h) (((b) * 2 + (h)) * HTB)
#define PG8_SB(b, h) ((4 + (b) * 2 + (h)) * HTB)
#define PG8_STAGE(bufoff, gbase, voff) do { _Pragma("unroll") for (int _i = 0; _i < 2; ++_i) \
        __builtin_amdgcn_global_load_lds((const unsigned*)((const char*)(gbase) + (voff)[_i]), (PG8_LAS unsigned*)(lds + (bufoff) + ldsw + _i * 8192), 16, 0, 0); } while (0)
#define PG8_LDA(dst, b, h) do { _Pragma("unroll") for (int m = 0; m < 4; ++m) _Pragma("unroll") for (int k = 0; k < 2; ++k) dst[m][k] = *(const PG8_LAS bf16x8*)(lds + PG8_SA(b, h) + aoff + m * 2048 + k * 1024); } while (0)
#define PG8_LDB(dst, b, h) do { _Pragma("unroll") for (int n = 0; n < 2; ++n) _Pragma("unroll") for (int k = 0; k < 2; ++k) dst[n][k] = *(const PG8_LAS bf16x8*)(lds + PG8_SB(b, h) + boff + n * 2048 + k * 1024); } while (0)
#define PG8_MMA(ai, bj, At, Bt) do { __builtin_amdgcn_s_setprio(1); _Pragma("unroll") for (int m = 0; m < 4; ++m) _Pragma("unroll") for (int n = 0; n < 2; ++n) _Pragma("unroll") for (int k = 0; k < 2; ++k) \
        acc[ai][bj][m][n] = __builtin_amdgcn_mfma_f32_16x16x32_bf16(Bt[n][k], At[m][k], acc[ai][bj][m][n], 0, 0, 0); __builtin_amdgcn_s_setprio(0); } while (0)
#define PG8_WAIT_V(n) asm volatile("s_waitcnt vmcnt(" #n ")" ::: "memory")
#define PG8_WAIT_L(n) asm volatile("s_waitcnt lgkmcnt(" #n ")" ::: "memory")
#define PG8_BAR __builtin_amdgcn_s_barrier()
#define PG8_SCHED __builtin_amdgcn_sched_barrier(0)
    Unit cur, nxt; int ui = 0;
    if (!S.next(0, cur)) return;
    f32x4 acc[2][2][4][2];
#pragma unroll
    for (int a = 0; a < 2; ++a)
#pragma unroll
        for (int b = 0; b < 2; ++b)
#pragma unroll
            for (int m = 0; m < 4; ++m)
#pragma unroll
                for (int n = 0; n < 2; ++n) acc[a][b][m][n] = (f32x4){0.f, 0.f, 0.f, 0.f};
    bf16x8 At[4][2], B0[2][2], B1[2][2];
    const char* cA = (const char*)g.A + (size_t)cur.pm * tstep; const char* cB = (const char*)g.Bt + (size_t)cur.pn * tstep;
    S.a_ready(cur);
    if constexpr (SP2) {
        PG8_STAGE(PG8_SB(0, 0), cB, voffB); PG8_STAGE(PG8_SB(0, 1), cB + hstep, voffB); PG8_STAGE(PG8_SA(0, 0), cA, voffA); PG8_STAGE(PG8_SA(0, 1), cA + hstep, voffA);
        if (wr == 1) PG8_BAR;
        PG8_WAIT_V(2); PG8_BAR;
        PG8_STAGE(PG8_SB(1, 0), cB + kstep, voffB); PG8_STAGE(PG8_SA(1, 0), cA + kstep, voffA); PG8_STAGE(PG8_SB(1, 1), cB + hstep + kstep, voffB);
        PG8_WAIT_V(6); PG8_BAR;
    } else {
        PG8_STAGE(PG8_SB(0, 0), cB, voffB); PG8_STAGE(PG8_SA(0, 0), cA, voffA); PG8_STAGE(PG8_SB(0, 1), cB + hstep, voffB); PG8_STAGE(PG8_SA(0, 1), cA + hstep, voffA);
        if (wr == 1) PG8_BAR;
        PG8_WAIT_V(4); PG8_BAR;
        PG8_STAGE(PG8_SB(1, 0), cB + kstep, voffB); PG8_STAGE(PG8_SA(1, 0), cA + kstep, voffA); PG8_STAGE(PG8_SB(1, 1), cB + hstep + kstep, voffB);
        PG8_WAIT_V(6); PG8_BAR;
    }
    for (;;) {
        const bool has_next = S.next(ui + 1, nxt);
        const char* nA = has_next ? (const char*)g.A + (size_t)nxt.pm * tstep : cA; const char* nB = has_next ? (const char*)g.Bt + (size_t)nxt.pn * tstep : cB;
        for (int t = 0; t < nt; t += 2) {
            const bool last = (t == nt - 2);
            const char* a1 = cA + (size_t)(t + 1) * kstep;
            const char* a2 = last ? nA : cA + (size_t)(t + 2) * kstep; const char* b2 = last ? nB : cB + (size_t)(t + 2) * kstep;
            const char* a3 = a2 + kstep; const char* b3 = b2 + kstep;
            if (last && has_next) S.a_ready(nxt);
            if constexpr (SP2) {
            PG8_LDB(B0, 0, 0); PG8_LDB(B1, 0, 1); PG8_SCHED; PG8_LDA(At, 0, 0); PG8_STAGE(PG8_SA(1, 1), a1 + hstep, voffA);
            PG8_WAIT_V(8); PG8_WAIT_L(0); PG8_BAR; PG8_MMA(0, 0, At, B0); PG8_MMA(0, 1, At, B1); PG8_BAR; PG8_SCHED;
            PG8_LDA(At, 0, 1); PG8_STAGE(PG8_SB(0, 0), b2, voffB); PG8_STAGE(PG8_SB(0, 1), b2 + hstep, voffB); PG8_STAGE(PG8_SA(0, 0), a2, voffA);
            PG8_WAIT_V(8); PG8_WAIT_L(0); PG8_BAR; PG8_MMA(1, 0, At, B0); PG8_MMA(1, 1, At, B1); PG8_BAR; PG8_SCHED;
            PG8_LDB(B0, 1, 0); PG8_LDB(B1, 1, 1); PG8_SCHED; PG8_LDA(At, 1, 0); PG8_STAGE(PG8_SA(0, 1), a2 + hstep, voffA);
            PG8_WAIT_V(8); PG8_WAIT_L(0); PG8_BAR; PG8_MMA(0, 0, At, B0); PG8_MMA(0, 1, At, B1); PG8_BAR; PG8_SCHED;
            PG8_LDA(At, 1, 1); PG8_STAGE(PG8_SB(1, 0), b3, voffB); PG8_STAGE(PG8_SB(1, 1), b3 + hstep, voffB); PG8_STAGE(PG8_SA(1, 0), a3, voffA);
            PG8_WAIT_V(8); PG8_WAIT_L(0); PG8_BAR; PG8_MMA(1, 0, At, B0); PG8_MMA(1, 1, At, B1); PG8_BAR; PG8_SCHED;
            } else {
            PG8_LDB(B0, 0, 0); PG8_SCHED; PG8_LDA(At, 0, 0); PG8_STAGE(PG8_SA(1, 1), a1 + hstep, voffA);
            PG8_WAIT_L(8); PG8_BAR; PG8_WAIT_L(0); PG8_MMA(0, 0, At, B0); PG8_BAR; PG8_SCHED;
            PG8_LDB(B1, 0, 1); PG8_STAGE(PG8_SB(0, 0), b2, voffB);
            PG8_BAR; PG8_WAIT_L(0); PG8_MMA(0, 1, At, B1); PG8_BAR;
            PG8_LDA(At, 0, 1); PG8_STAGE(PG8_SA(0, 0), a2, voffA);
            PG8_BAR; PG8_WAIT_L(0); PG8_MMA(1, 0, At, B0); PG8_BAR; PG8_SCHED;
            PG8_STAGE(PG8_SB(0, 1), b2 + hstep, voffB);
            PG8_WAIT_V(6); PG8_BAR; PG8_MMA(1, 1, At, B1); PG8_BAR;
            PG8_LDB(B0, 1, 0); PG8_SCHED; PG8_LDA(At, 1, 0); PG8_STAGE(PG8_SA(0, 1), a2 + hstep, voffA);
            PG8_WAIT_L(8); PG8_BAR; PG8_WAIT_L(0); PG8_MMA(0, 0, At, B0); PG8_BAR; PG8_SCHED;
            PG8_LDB(B1, 1, 1); PG8_STAGE(PG8_SB(1, 0), b3, voffB);
            PG8_BAR; PG8_WAIT_L(0); PG8_MMA(0, 1, At, B1); PG8_BAR;
            PG8_LDA(At, 1, 1); PG8_STAGE(PG8_SA(1, 0), a3, voffA);
            PG8_BAR; PG8_WAIT_L(0); PG8_MMA(1, 0, At, B0); PG8_BAR; PG8_SCHED;
            PG8_STAGE(PG8_SB(1, 1), b3 + hstep, voffB);
            PG8_WAIT_V(6); PG8_BAR; PG8_MMA(1, 1, At, B1); PG8_BAR;
            }
        }
        if constexpr (ALIGN_EPI) { if (wr == 0) PG8_BAR; }
        if constexpr (!Epi::AFTER_DRAIN) { E(acc, cur, wr, wc, fr, fq); S.done(cur); }
        if (!has_next) break;
#pragma unroll
        for (int a = 0; a < 2; ++a)
#pragma unroll
            for (int b = 0; b < 2; ++b)
#pragma unroll
                for (int m = 0; m < 4; ++m)
#pragma unroll
                    for (int n = 0; n < 2; ++n) acc[a][b][m][n] = (f32x4){0.f, 0.f, 0.f, 0.f};
        cur = nxt; cA = nA; cB = nB; ++ui;
        if constexpr (ALIGN_EPI) { if (wr == 1) PG8_BAR; }
    }
    PG8_WAIT_V(0);
    if constexpr (!ALIGN_EPI) { if (wr == 0) PG8_BAR; }
    PG8_BAR;
    if constexpr (Epi::AFTER_DRAIN) { E.fused(acc, cur, wr, wc, fr, fq, lds, wid, lane); S.done(cur); }
#undef PG8_SA
#undef PG8_SB
#undef PG8_STAGE
#undef PG8_LDA
#undef PG8_LDB
#undef PG8_MMA
#undef PG8_WAIT_V
#undef PG8_WAIT_L
#undef PG8_BAR
#undef PG8_SCHED
}
}

namespace attn_body {
using bf16=__hip_bfloat16;
using bf16x8=__attribute__((ext_vector_type(8)))short;
using s16x4=__attribute__((ext_vector_type(4)))short;
using f32x16=__attribute__((ext_vector_type(16)))float;
using u32x4=__attribute__((ext_vector_type(4)))unsigned;
constexpr int D=64, PP=2304, OP=1024;
constexpr int NW=8,QBLK=32,QB=QBLK*NW,KVBLK=64;
__device__ __forceinline__ int crow(int r,int hi){return (r&3)+8*(r>>2)+4*hi;}
#define SBAR() __builtin_amdgcn_sched_barrier(0)
__device__ __forceinline__ void cmask(f32x16&p0,f32x16&p1,int jb,int qrel,int hi){
  const float NEG=-INFINITY; int kb=64*jb+4*hi;
  #pragma unroll
  for(int r=0;r<16;++r){int kv=kb+(r&3)+8*(r>>2); if(kv>qrel)p0[r]=NEG; if(kv+32>qrel)p1[r]=NEG;}
}

constexpr int NSLOT=3, SLOTB=8192;
constexpr int LDS_K=0, LDS_V=NSLOT*SLOTB, LDS_WS=2*NSLOT*SLOTB, LDS_OST=LDS_WS+NW*64*4, LDS_BYTES=LDS_OST+NW*4096;
constexpr float C2=0.125f*1.4426950408889634f;

__device__ __forceinline__ void na_hook(f32x16&p0,f32x16&p1,int t,int r0,int qrow,int qcol,int hi,const float*bias){
  if(t<4)return;
  const float NEG=-INFINITY; const int kr=r0+t-4; int rs=qrow-4; rs=rs<0?0:(rs>56?56:rs);
  if(kr<rs||kr>rs+7){
    #pragma unroll
    for(int r=0;r<16;++r){p0[r]=NEG;p1[r]=NEG;}
    return; }
  int cs=qcol-8; cs=cs<0?0:(cs>48?48:cs);
  const float*bt=bias+(kr-qrow+7)*31+15-qcol;
  #pragma unroll
  for(int r=0;r<16;++r){ const int kc=(r&3)+8*(r>>2)+4*hi;
    const bool v0=(unsigned)(kc-cs)<16u, v1=(unsigned)(kc+32-cs)<16u;
    const float b0=v0?bt[kc]:0.f, b1=v1?bt[kc+32]:0.f;
    p0[r]=v0?p0[r]+b0:NEG; p1[r]=v1?p1[r]+b1:NEG; }
}
__device__ __forceinline__ void glds16(const void*gsrc,unsigned lds_dst){unsigned keep;
  asm volatile("s_mov_b32 %0, m0\n\ts_mov_b32 m0, %2\n\ts_nop 0\n\tglobal_load_lds_dwordx4 %1, off\n\ts_mov_b32 m0, %0":"=&s"(keep):"v"(gsrc),"s"(lds_dst):"memory");}
__device__ __forceinline__ float max3f(float a,float b,float c){float r;asm("v_max3_f32 %0, %1, %2, %3":"=v"(r):"v"(a),"v"(b),"v"(c));return r;}
__device__ __forceinline__ float max2f(float a,float b){float r;asm("v_max_f32_e32 %0, %1, %2":"=v"(r):"v"(a),"v"(b));return r;}
__device__ __forceinline__ float fadd_s(float a,float b){float r;asm("v_add_f32_e32 %0, %1, %2":"=v"(r):"v"(a),"v"(b));return r;}
__device__ __forceinline__ float fsub_s(float a,float b){float r;asm("v_sub_f32_e32 %0, %1, %2":"=v"(r):"v"(a),"v"(b));return r;}
typedef float f32x2_t __attribute__((ext_vector_type(2))); typedef __bf16 bf16x2_t __attribute__((ext_vector_type(2)));
__device__ __forceinline__ unsigned cvtpk_s(float lo,float hi){f32x2_t v={lo,hi};bf16x2_t b=__builtin_convertvector(v,bf16x2_t);return __builtin_bit_cast(unsigned,b);}
#define WAIT_BAR(N) asm volatile("s_waitcnt vmcnt(" #N ") lgkmcnt(0)\n\ts_barrier":::"memory")

__device__ __forceinline__ void qkt(f32x16&p0,f32x16&p1,const char*Kslot,const bf16x8*qr,const f32x16&negm,int r32,int hi){
  const char*kb=Kslot+hi*1024+r32*16;
  #pragma unroll
  for(int d0=0;d0<4;++d0){
    const bf16x8 b0=*reinterpret_cast<const bf16x8*>(kb+d0*2048);
    const bf16x8 b1=*reinterpret_cast<const bf16x8*>(kb+d0*2048+512);
    if(d0==0){p0=__builtin_amdgcn_mfma_f32_32x32x16_bf16(b0,qr[0],negm,0,0,0);p1=__builtin_amdgcn_mfma_f32_32x32x16_bf16(b1,qr[0],negm,0,0,0);}
    else{p0=__builtin_amdgcn_mfma_f32_32x32x16_bf16(b0,qr[d0],p0,0,0,0);p1=__builtin_amdgcn_mfma_f32_32x32x16_bf16(b1,qr[d0],p1,0,0,0);}}
}
typedef __attribute__((address_space(3))) const char* lds_cptr;
typedef short v4i16_t __attribute__((ext_vector_type(4)));
__device__ __forceinline__ void kload8(bf16x8*kf,lds_cptr kp){
  kf[0]=*(const __attribute__((address_space(3))) bf16x8*)(kp);      kf[1]=*(const __attribute__((address_space(3))) bf16x8*)(kp+512);
  kf[2]=*(const __attribute__((address_space(3))) bf16x8*)(kp+2048); kf[3]=*(const __attribute__((address_space(3))) bf16x8*)(kp+2560);
  kf[4]=*(const __attribute__((address_space(3))) bf16x8*)(kp+4096); kf[5]=*(const __attribute__((address_space(3))) bf16x8*)(kp+4608);
  kf[6]=*(const __attribute__((address_space(3))) bf16x8*)(kp+6144); kf[7]=*(const __attribute__((address_space(3))) bf16x8*)(kp+6656);
}
__device__ __forceinline__ void kload2(bf16x8*kf,lds_cptr kp,int j){ kf[2*j]=*(const __attribute__((address_space(3))) bf16x8*)(kp+j*2048); kf[2*j+1]=*(const __attribute__((address_space(3))) bf16x8*)(kp+j*2048+512); }
__device__ __forceinline__ s16x4 vtr(lds_cptr p){ return __builtin_bit_cast(s16x4,__builtin_amdgcn_ds_read_tr16_b64_v4i16((__attribute__((address_space(3))) v4i16_t*)p)); }
__device__ __forceinline__ float rowmax(const f32x16&p0,const f32x16&p1){
  float a=max3f(p0[0],p0[1],p1[0]),b=max3f(p0[2],p0[3],p1[1]);a=max3f(a,p1[2],p1[3]);
  #pragma unroll
  for(int r=4;r<16;r+=4){a=max3f(a,p0[r],p0[r+1]);b=max3f(b,p0[r+2],p0[r+3]);a=max3f(a,p1[r],p1[r+1]);b=max3f(b,p1[r+2],p1[r+3]);}
  const float m=max2f(a,b);
  auto rr=__builtin_amdgcn_permlane32_swap(__float_as_uint(m),__float_as_uint(m),false,false);
  return max2f(__uint_as_float(rr[0]),__uint_as_float(rr[1]));
}
__device__ __forceinline__ void pv(f32x16*o,int vb,bf16x8 pa0,bf16x8 pa1,bf16x8 pa2,bf16x8 pa3){
  #pragma unroll
  for(int d0=0;d0<2;++d0){s16x4 lo[4],hi[4];
    #pragma unroll
    for(int ks=0;ks<4;++ks){
      asm volatile("ds_read_b64_tr_b16 %0,%1 offset:%c2":"=&v"(lo[ks]):"v"(vb),"i"(d0*4096+ks*1024):"memory");
      asm volatile("ds_read_b64_tr_b16 %0,%1 offset:%c2":"=&v"(hi[ks]):"v"(vb),"i"(d0*4096+ks*1024+512):"memory");}
    asm volatile("s_waitcnt lgkmcnt(0)":::"memory");SBAR();
    #define PK(k) (bf16x8){lo[k][0],lo[k][1],lo[k][2],lo[k][3],hi[k][0],hi[k][1],hi[k][2],hi[k][3]}
    o[d0]=__builtin_amdgcn_mfma_f32_32x32x16_bf16(pa0,PK(0),o[d0],0,0,0);
    o[d0]=__builtin_amdgcn_mfma_f32_32x32x16_bf16(pa1,PK(1),o[d0],0,0,0);
    o[d0]=__builtin_amdgcn_mfma_f32_32x32x16_bf16(pa2,PK(2),o[d0],0,0,0);
    o[d0]=__builtin_amdgcn_mfma_f32_32x32x16_bf16(pa3,PK(3),o[d0],0,0,0);
    #undef PK
  }
}

#ifndef ATTN_STORE16
#define ATTN_STORE16(p,v) (*(u32x4*)(p)=(v))
#endif
template<int THRL,int MODE> __device__ __forceinline__ void attn_unit(const bf16*Qu,const bf16*__restrict__ Kb,const bf16*__restrict__ Vb,bf16*Ou,int krow_c,int krow_l,int tclamp,int NT,int na_r0,int na_qrow0,const float*na_bias,char*shm,float fixm=0.f){
  int tid_o=threadIdx.x; asm volatile("":"+v"(tid_o)); const int tid=tid_o,lane=tid&63,r32=lane&31,hi=lane>>5; const int wid=__builtin_amdgcn_readfirstlane(tid>>6);
  const bf16*Qw=Qu+(long)(wid*QBLK)*PP;
  const bf16*Kh=Kb,*Vh=Vb;
  #define KROW(t) (((t)<4)?(krow_c+64*(t)):(krow_l+64*(((t)-4)<tclamp?((t)-4):tclamp)))
  const unsigned lds0=(unsigned)(uintptr_t)shm;
  float*wsf=(float*)(shm+LDS_WS)+wid*64;
  const bf16*ksrc=Kh+(long)lane*PP+wid*8;
  const bf16*vsrc=Vh+(long)(16*(wid&3)+(lane>>2))*PP+(wid>>2)*32+(lane&3)*8;
  const unsigned kdst=lds0+LDS_K+wid*1024, vdst=lds0+LDS_V+wid*1024;
  #define DMA_K(t,slot) glds16(ksrc+(long)KROW(t)*PP,(unsigned)__builtin_amdgcn_readfirstlane(kdst+(slot)))
  #define DMA_V(t,slot) glds16(vsrc+(long)KROW(t)*PP,(unsigned)__builtin_amdgcn_readfirstlane(vdst+(slot)))
  const int vb0=(int)(lds0+LDS_V)+((lane>>4)&1)*32+(lane&3)*8+(4*hi+((lane&15)>>2))*64;
  const char*Kbase=shm+LDS_K; bf16x8 kf[8];
  const lds_cptr shm3=(lds_cptr)shm; const lds_cptr kp0=shm3+LDS_K+hi*1024+r32*16; const lds_cptr vp0=shm3+LDS_V+((lane>>4)&1)*32+(lane&3)*8+(4*hi+((lane&15)>>2))*64;
  DMA_K(0,0);DMA_V(0,0);DMA_K(1,SLOTB);
  bf16x8 qr[4];
  #pragma unroll
  for(int d0=0;d0<4;++d0)qr[d0]=*reinterpret_cast<const bf16x8*>(&Qw[(long)r32*PP+d0*16+hi*8]);
  float mhat=0.f,l_reg=0.f;f32x16 o[2];o[0]=f32x16{};o[1]=f32x16{};f32x16 negm=f32x16{};asm volatile("":"+v"(negm));
  const int na_qrow=na_qrow0+(wid>>1), na_qcol=32*(wid&1)+r32;
  #define CMASK(P0,P1,t) do{ if(MODE==1) na_hook(P0,P1,(t),na_r0,na_qrow,na_qcol,hi,na_bias); }while(0)
  bool resc=false;
  #define START(P0,P1) do{ const float rm=(MODE==2)?fixm:rowmax(P0,P1); resc=false; \
    { const float dl=rm; mhat=fadd_s(mhat,dl); \
      _Pragma("unroll") for(int r=0;r<16;++r){P0[r]=fsub_s(P0[r],dl);P1[r]=fsub_s(P1[r],dl);} \
      _Pragma("unroll") for(int r=0;r<16;++r)negm[r]=-mhat; asm volatile("":"+v"(negm)); } \
    _Pragma("unroll") for(int r=0;r<16;++r)P0[r]=__builtin_amdgcn_exp2f(P0[r]); }while(0)
  #define RESC() do{ if(resc){ asm volatile("s_waitcnt lgkmcnt(0)":::"memory"); \
      _Pragma("unroll") for(int d_=0;d_<2;++d_) _Pragma("unroll") for(int r=0;r<16;++r)o[d_][r]*=wsf[crow(r,hi)]; } }while(0)
  f32x16 pA0,pA1,pB0,pB1;
  int sl_prev=0,sl_cur=0,sl_next=SLOTB;
  #define ROT() do{sl_prev=sl_cur;sl_cur=sl_next;sl_next=(sl_next==(NSLOT-1)*SLOTB)?0:sl_next+SLOTB;}while(0)
  DMA_K(2,2*SLOTB);
  WAIT_BAR(3);
  qkt(pA0,pA1,Kbase,qr,negm,r32,hi);asm volatile("s_nop 15\n\ts_nop 7":"+v"(pA0),"+v"(pA1));CMASK(pA0,pA1,0);
  START(pA0,pA1);
  _Pragma("unroll") for(int r=0;r<16;++r)pA1[r]=__builtin_amdgcn_exp2f(pA1[r]);
  WAIT_BAR(0);
  DMA_K(3,0);DMA_V(1,SLOTB);
  ROT();
  kload8(kf,kp0+sl_cur);
  WAIT_BAR(2);
  s16x4 vlo[8],vhi[8]; u32x4 pw0,pw1,pw2,pw3;
  #define PKW(P,B) cvtpk_s(P[B],P[B+1])
  #define PAF(k) __builtin_bit_cast(bf16x8,pw##k)
  #define VFR(i) (bf16x8){vlo[i][0],vlo[i][1],vlo[i][2],vlo[i][3],vhi[i][0],vhi[i][1],vhi[i][2],vhi[i][3]}
  #define PIN(x) asm volatile("":"+v"(x))
  #define MX3(a,b,c) __builtin_fmaxf(__builtin_fmaxf((a),(b)),(c))
  #define GAPA(MF,A0,A1,A2,A3,W0,W1,PW) do{ MF; sacc2+=(f32x2_t){A0,A1}; sacc2+=(f32x2_t){A2,A3}; PIN(sacc2); W0; W1; PIN(PW); SBAR(); }while(0)
  #define EX(v) __builtin_amdgcn_exp2f(v)
  #define GAPB(MF,X,B) do{ MF; X[B]=EX(X[B]); X[B+1]=EX(X[B+1]); X[B+2]=EX(X[B+2]); X[B+3]=EX(X[B+3]); PIN(X); SBAR(); }while(0)
  #define VRD(i) do{ vlo[i]=vtr(vp_+(((i)>>2)*4096+((i)&3)*1024)); vhi[i]=vtr(vp_+(((i)>>2)*4096+((i)&3)*1024+512)); }while(0)
  #define KRD(G,j) do{ if(G){ kload2(kf,kp0+sl_next,j); SBAR(); } }while(0)
  #define STEP(C0,C1,P0,P1,t,GK,GV,GL) do{ SBAR(); \
    const lds_cptr vp_=vp0+sl_prev; \
    VRD(0); SBAR(); f32x2_t sacc2={P0[0],P0[1]}; \
    GAPA(C0=__builtin_amdgcn_mfma_f32_32x32x16_bf16(kf[0],qr[0],negm,0,0,0), P0[2],P0[3],P0[4],P0[5],     pw0[0]=PKW(P0,0), pw0[1]=PKW(P0,2), pw0); \
    VRD(4); SBAR(); GAPA(C1=__builtin_amdgcn_mfma_f32_32x32x16_bf16(kf[1],qr[0],negm,0,0,0), P0[6],P0[7],P0[8],P0[9],     pw0[2]=PKW(P0,4), pw0[3]=PKW(P0,6), pw0); \
    VRD(1); SBAR(); GAPA(C0=__builtin_amdgcn_mfma_f32_32x32x16_bf16(kf[2],qr[1],C0,0,0,0),   P0[10],P0[11],P0[12],P0[13], pw1[0]=PKW(P0,8), pw1[1]=PKW(P0,10), pw1); \
    VRD(5); SBAR(); GAPA(C1=__builtin_amdgcn_mfma_f32_32x32x16_bf16(kf[3],qr[1],C1,0,0,0),   P0[14],P0[15],P1[0],P1[1],   pw1[2]=PKW(P0,12),pw1[3]=PKW(P0,14), pw1); \
    VRD(2); SBAR(); GAPA(C0=__builtin_amdgcn_mfma_f32_32x32x16_bf16(kf[4],qr[2],C0,0,0,0),   P1[2],P1[3],P1[4],P1[5],     pw2[0]=PKW(P1,0), pw2[1]=PKW(P1,2), pw2); \
    VRD(6); SBAR(); GAPA(C1=__builtin_amdgcn_mfma_f32_32x32x16_bf16(kf[5],qr[2],C1,0,0,0),   P1[6],P1[7],P1[8],P1[9],     pw2[2]=PKW(P1,4), pw2[3]=PKW(P1,6), pw2); \
    VRD(3); SBAR(); GAPA(C0=__builtin_amdgcn_mfma_f32_32x32x16_bf16(kf[6],qr[3],C0,0,0,0),   P1[10],P1[11],P1[12],P1[13], pw3[0]=PKW(P1,8), pw3[1]=PKW(P1,10), pw3); \
    VRD(7); SBAR(); GAPA(C1=__builtin_amdgcn_mfma_f32_32x32x16_bf16(kf[7],qr[3],C1,0,0,0),   P1[14],P1[15],0.f,0.f,       pw3[2]=PKW(P1,12),pw3[3]=PKW(P1,14), pw3); \
    l_reg+=(sacc2[0]+sacc2[1]); \
    if(GK){DMA_K((t)+3,sl_cur);} if(GV){DMA_V((t)+1,sl_next);} \
    CMASK(C0,C1,t); \
    resc=false; if(MODE!=2){ float a=MX3(C0[0],C0[1],C1[0]),b=MX3(C0[2],C0[3],C1[1]); a=MX3(a,C1[2],C1[3]); \
      _Pragma("unroll") for(int r=4;r<16;r+=4){a=MX3(a,C0[r],C0[r+1]);b=MX3(b,C0[r+2],C0[r+3]);a=MX3(a,C1[r],C1[r+1]);b=MX3(b,C1[r+2],C1[r+3]);} \
      float rm=__builtin_fmaxf(a,b); { auto rr=__builtin_amdgcn_permlane32_swap(__float_as_uint(rm),__float_as_uint(rm),false,false); rm=__builtin_fmaxf(__uint_as_float(rr[0]),__uint_as_float(rr[1])); } \
      resc=false; \
      if(__builtin_expect(__any(rm>(float)THRL),0)){ const float dl=__builtin_fmaxf(rm,0.f); mhat+=dl; \
        _Pragma("unroll") for(int r=0;r<16;++r){C0[r]-=dl;C1[r]-=dl;} \
        _Pragma("unroll") for(int r=0;r<16;++r)negm[r]=-mhat; asm volatile("":"+v"(negm)); \
        const float f=__builtin_amdgcn_exp2f(-dl); l_reg*=f; if(hi==0)wsf[r32]=f; resc=true; } } \
    SBAR(); \
    GAPB(o[0]=__builtin_amdgcn_mfma_f32_32x32x16_bf16(PAF(0),VFR(0),o[0],0,0,0), C0,0); \
    GAPB(o[1]=__builtin_amdgcn_mfma_f32_32x32x16_bf16(PAF(0),VFR(4),o[1],0,0,0), C0,4); \
    KRD(GL,0); GAPB(o[0]=__builtin_amdgcn_mfma_f32_32x32x16_bf16(PAF(1),VFR(1),o[0],0,0,0), C0,8); \
    KRD(GL,1); GAPB(o[1]=__builtin_amdgcn_mfma_f32_32x32x16_bf16(PAF(1),VFR(5),o[1],0,0,0), C0,12); \
    KRD(GL,2); GAPB(o[0]=__builtin_amdgcn_mfma_f32_32x32x16_bf16(PAF(2),VFR(2),o[0],0,0,0), C1,0); \
    KRD(GL,3); GAPB(o[1]=__builtin_amdgcn_mfma_f32_32x32x16_bf16(PAF(2),VFR(6),o[1],0,0,0), C1,4); \
    GAPB(o[0]=__builtin_amdgcn_mfma_f32_32x32x16_bf16(PAF(3),VFR(3),o[0],0,0,0), C1,8); \
    GAPB(o[1]=__builtin_amdgcn_mfma_f32_32x32x16_bf16(PAF(3),VFR(7),o[1],0,0,0), C1,12); \
    }while(0)
  int t=1;
  for(;t+5<NT;t+=2){
    STEP(pB0,pB1,pA0,pA1,t,true,true,true);     WAIT_BAR(2); RESC(); ROT();
    STEP(pA0,pA1,pB0,pB1,t+1,true,true,true);   WAIT_BAR(2); RESC(); ROT();
  }
  #define ENDW(tt) do{ if((tt)+3<NT){WAIT_BAR(2);} else if((tt)+2<NT){WAIT_BAR(1);} else {WAIT_BAR(0);} }while(0)
  for(;t+1<NT;t+=2){
    STEP(pB0,pB1,pA0,pA1,t,(t+3<NT),(t+1<NT),(t+1<NT));       ENDW(t);   RESC(); ROT();
    STEP(pA0,pA1,pB0,pB1,t+1,(t+4<NT),(t+2<NT),(t+2<NT));     ENDW(t+1); RESC(); ROT();
  }
  STEP(pB0,pB1,pA0,pA1,NT-1,false,false,false); RESC();
  { float sacc=pB0[0]+pB0[1]; _Pragma("unroll") for(int r=2;r<16;++r)sacc+=pB0[r]; _Pragma("unroll") for(int r=0;r<16;++r)sacc+=pB1[r]; l_reg+=sacc;
    pw0=(u32x4){PKW(pB0,0),PKW(pB0,2),PKW(pB0,4),PKW(pB0,6)};pw1=(u32x4){PKW(pB0,8),PKW(pB0,10),PKW(pB0,12),PKW(pB0,14)};pw2=(u32x4){PKW(pB1,0),PKW(pB1,2),PKW(pB1,4),PKW(pB1,6)};pw3=(u32x4){PKW(pB1,8),PKW(pB1,10),PKW(pB1,12),PKW(pB1,14)};
    SBAR(); pv(o,vb0+sl_cur,PAF(0),PAF(1),PAF(2),PAF(3)); }
  #undef PKW
  #undef PAF
  #undef VFR
  #undef PIN
  #undef MX3
  #undef GAPA
  #undef GAPB
  #undef EX
  #undef VRD
  #undef KRD
  #undef STEP
  #undef ENDW
  {auto rr=__builtin_amdgcn_permlane32_swap(__float_as_uint(l_reg),__float_as_uint(l_reg),false,false);l_reg=__uint_as_float(rr[0])+__uint_as_float(rr[1]);}
  if(hi==0)wsf[32+r32]=l_reg;asm volatile("s_waitcnt lgkmcnt(0)":::"memory");
  float rli[16];
  #pragma unroll
  for(int r=0;r<16;++r)rli[r]=__builtin_amdgcn_rcpf(wsf[32+crow(r,hi)]);
  bf16*Ow=Ou+(long)(wid*QBLK)*OP;
  { bf16*stg=(bf16*)(shm+LDS_OST)+wid*2048;
    #pragma unroll
    for(int r=0;r<16;++r){const int orow=crow(r,hi);
      #pragma unroll
      for(int d0=0;d0<2;++d0)stg[orow*64+d0*32+r32]=__float2bfloat16(o[d0][r]*rli[r]);}
    asm volatile("s_waitcnt lgkmcnt(0)":::"memory");
    #pragma unroll
    for(int i=0;i<4;++i){const int row=i*8+(lane>>3),ch=lane&7; const u32x4 v=*(const u32x4*)(stg+row*64+ch*8); ATTN_STORE16(Ow+(long)row*OP+ch*8,v);} }
  asm volatile("s_waitcnt lgkmcnt(0)\n\ts_barrier":::"memory");
  #undef DMA_K
  #undef KROW
  #undef DMA_V
  #undef CMASK
  #undef START
  #undef RESC
  #undef ROT
}
#undef SBAR
#undef WAIT_BAR
}

#define XB_TMO      128
#define XB_XCNT(j)  (256  + 64 * (j))
#define XB_XSUB(j)  (1280 + 64 * (j))
#define XB_XGEN(j)  (2304 + 64 * (j))
#define XB_TOP      3328
#define XB_TOPGEN   3392
#define XCD_BAR_WORDS 3456
#define XB_SPIN_CAP (1u << 18)

__device__ __forceinline__ unsigned xb_ld(unsigned* p)              { return __hip_atomic_load(p, __ATOMIC_RELAXED, __HIP_MEMORY_SCOPE_AGENT); }
__device__ __forceinline__ unsigned xb_add(unsigned* p, unsigned v) { return __hip_atomic_fetch_add(p, v, __ATOMIC_RELAXED, __HIP_MEMORY_SCOPE_AGENT); }
__device__ __forceinline__ unsigned xb_xcc_id() { return (unsigned)__builtin_amdgcn_s_getreg((3 << 11) | 20) & 0xFu; }
#define XB_SPIN(cond, bar) do { unsigned _sp = 0; while (cond) { __builtin_amdgcn_s_sleep(1); \
    if ((++_sp & 255u) == 0u) { if (xb_ld(&(bar)[XB_TMO])) break; if (_sp > XB_SPIN_CAP) { atomicAdd(&(bar)[XB_TMO], 1u); break; } } } } while (0)

struct XcdBarrier {
    unsigned* bar; unsigned x;
    volatile LAS unsigned* st;
};

__device__ __forceinline__ XcdBarrier xcd_barrier_post(unsigned* bar, volatile LAS unsigned* st) {
    XcdBarrier b; b.bar = bar; b.x = xb_xcc_id(); b.st = st;
    if (threadIdx.x == 0) (void)xb_add(&bar[XB_XCNT(b.x)], 1u);
    return b;
}
__device__ __forceinline__ void xcd_barrier_complete(unsigned* bar, unsigned x, unsigned& nloc, unsigned& nx) {
    const unsigned G = gridDim.x * gridDim.y * gridDim.z;
    unsigned sum, cnt, mine, sp = 0u;
    for (;;) {
        sum = 0u; cnt = 0u; mine = 0u;
#pragma unroll
        for (unsigned j = 0; j < 16; ++j) { const unsigned c = xb_ld(&bar[XB_XCNT(j)]); sum += c; cnt += (c > 0u) ? 1u : 0u; mine = (j == x) ? c : mine; }
        if (sum == G) break;
        __builtin_amdgcn_s_sleep(1);
        if ((++sp & 255u) == 0u) { if (xb_ld(&bar[XB_TMO])) break; if (sp > XB_SPIN_CAP) { atomicAdd(&bar[XB_TMO], 1u); break; } }
    }
    nloc = mine > 0u ? mine : 1u; nx = cnt > 0u ? cnt : 1u;
}

__device__ __forceinline__ void xcd_barrier(const XcdBarrier& b) {
    asm volatile("s_waitcnt vmcnt(0)" ::: "memory");
    __syncthreads();
    if (threadIdx.x == 0) {
        unsigned* bar = b.bar;
        __builtin_amdgcn_s_waitcnt(0);
        unsigned nloc = b.st[0], nx = b.st[1];
        if (nloc == 0u) { xcd_barrier_complete(bar, b.x, nloc, nx); b.st[0] = nloc; b.st[1] = nx; }
        const unsigned old = xb_add(&bar[XB_XSUB(b.x)], 1u);
        const unsigned gen = old / nloc;
        if (old + 1u == (gen + 1u) * nloc) {
            __builtin_amdgcn_fence(__ATOMIC_RELEASE, "agent");
            asm volatile("s_waitcnt vmcnt(0)" ::: "memory");
            const unsigned og = xb_add(&bar[XB_TOP], 1u);
            const unsigned tg = og / nx;
            if (og + 1u == (tg + 1u) * nx) xb_add(&bar[XB_TOPGEN], 1u);
            else XB_SPIN(xb_ld(&bar[XB_TOPGEN]) == tg, bar);
            __builtin_amdgcn_fence(__ATOMIC_ACQUIRE, "agent");
            xb_add(&bar[XB_XGEN(b.x)], 1u);
            asm volatile("s_waitcnt vmcnt(0)" ::: "memory");
        } else {
            XB_SPIN(xb_ld(&bar[XB_XGEN(b.x)]) == gen, bar);
            __builtin_amdgcn_fence(__ATOMIC_ACQUIRE, "agent");
            asm volatile("s_waitcnt vmcnt(0)" ::: "memory");
        }
    }
    __syncthreads();
}

__device__ __forceinline__ void sb_arrive(unsigned* ctr, int tid) {
    asm volatile("s_waitcnt vmcnt(0)" ::: "memory");
    __syncthreads();
    if (tid == 0) { __builtin_amdgcn_fence(__ATOMIC_RELEASE, "agent"); asm volatile("s_waitcnt vmcnt(0)" ::: "memory"); (void)xb_add(ctr, 1u); }
}
__device__ __forceinline__ void sb_wait(unsigned* ctr, unsigned need, unsigned* tmo, int tid) {
    if (tid == 0) { unsigned sp = 0u;
        while (xb_ld(ctr) < need) { __builtin_amdgcn_s_sleep(2); if (((++sp) & 1023u) == 0u) { if (xb_ld(tmo)) break; if (sp > (1u << 22)) { atomicAdd(tmo, 1u); break; } } }
        __builtin_amdgcn_fence(__ATOMIC_ACQUIRE, "agent"); asm volatile("s_waitcnt vmcnt(0)" ::: "memory"); }
    __syncthreads();
}

typedef unsigned short bf16_t;
constexpr size_t SZ_WIN = (size_t)INC * DMODEL * 2, SZ_WOUT = (size_t)DMODEL * DMODEL * 2, SZ_WFI = (size_t)2 * FFH * DMODEL * 2, SZ_WFO = (size_t)DMODEL * FFH * 2;
constexpr size_t WS_WIN = 0;
constexpr size_t WS_WOUT = WS_WIN + NLAY * SZ_WIN;
constexpr size_t WS_WFI = WS_WOUT + NLAY * SZ_WOUT;
constexpr size_t WS_WFO = WS_WFI + NLAY * SZ_WFI;
constexpr size_t WS_MOD = WS_WFO + NLAY * SZ_WFO;
constexpr size_t WS_ROPE = WS_MOD + (size_t)NLAY * 9 * MODW * 4;
constexpr size_t WS_HF = WS_ROPE + 64 * 16 * 2 * 4;
constexpr size_t WS_HC = WS_HF + (size_t)NLAY * 256 * 8192 * 2;
constexpr size_t WS_F = WS_HC + (size_t)NLAY * 256 * 512 * 4;
constexpr size_t WS_XN = WS_F + (size_t)256 * 8 * 1024 * 16;
constexpr size_t WS_P = WS_XN + (size_t)MT * DMODEL * 2;
constexpr size_t WS_MIX = WS_P + (size_t)MT * INC * 2;
constexpr size_t WS_XC = WS_MIX + (size_t)MT * DMODEL * 2;
constexpr size_t WS_UT = WS_XC + (size_t)MC * DMODEL * 4;
constexpr size_t WS_X2T = WS_UT + (size_t)NB * 256 * SEQ * 2;
constexpr size_t WS_CTL = WS_X2T + (size_t)NB * 256 * SEQ * 2;
constexpr size_t CTL_BYTES = 65536;
constexpr size_t WS_RSS = WS_CTL + CTL_BYTES;
constexpr size_t WS_CVI = WS_RSS + (size_t)4 * MT * 4;
constexpr size_t WS_CVF = WS_CVI + (size_t)NLAY * 9 * INC * 4;
constexpr size_t WS_YT = WS_CVF + (size_t)NLAY * 9 * 2 * FFH * 4;
constexpr size_t WS_ACTC = WS_YT + (size_t)NB * 256 * SEQ * 2;
constexpr size_t WS_END = WS_ACTC + (size_t)MC * FFH * 2;
static_assert(WS_END <= (size_t)4 * NB * SEQ * DMODEL * 4, "workspace must fit 4x the largest tensor");
static_assert((size_t)MT * FFH * 2 <= (size_t)MT * INC * 2 + (size_t)MT * DMODEL * 2, "ACT overlay");
static_assert(WS_ROPE % 256 == 0 && WS_HF % 256 == 0 && WS_F % 256 == 0 && WS_XN % 256 == 0 && WS_P % 256 == 0 && WS_MIX % 256 == 0 && WS_UT % 256 == 0, "alignment");

constexpr int LDS_BYTES = 147456;
constexpr int NA_BIAS_OFF = 98304;

struct KArgs { const float* in[27]; float* out; unsigned char* ws; };

__device__ __forceinline__ void transpose_item(const float* W, int N, int K, bf16_t* WT, int k0, int n0, int drow0, LAS float* scr, int lane) {
#pragma unroll 8
    for (int i = 0; i < 32; ++i) { const int kk = 2 * i + (lane >> 5); scr[kk * 33 + (lane & 31)] = W[(size_t)(k0 + kk) * N + n0 + (lane & 31)]; }
    asm volatile("s_waitcnt lgkmcnt(0)" ::: "memory");
    const int c = lane & 7;
#pragma unroll
    for (int j = 0; j < 4; ++j) { const int n = (lane >> 3) + 8 * j; const LAS float* s = scr + (8 * c) * 33 + n;
        v4u o; o.x = pk2(s[0 * 33], s[1 * 33]); o.y = pk2(s[2 * 33], s[3 * 33]); o.z = pk2(s[4 * 33], s[5 * 33]); o.w = pk2(s[6 * 33], s[7 * 33]);
        *(v4u*)(WT + (size_t)(drow0 + n) * K + k0 + 8 * c) = o; }
    asm volatile("s_waitcnt lgkmcnt(0)" ::: "memory");
}

__device__ __forceinline__ void norm_row(const float* xrow, const float* g, const float* shift, const float* scale, bf16_t* orow, int lane) {
    const f32x4v* xr = (const f32x4v*)xrow + lane;
    f32x4v v[4]; float s = 0.f;
#pragma unroll
    for (int j = 0; j < 4; ++j) { v[j] = xr[64 * j]; s += (v[j].x * v[j].x + v[j].y * v[j].y) + (v[j].z * v[j].z + v[j].w * v[j].w); }
    const float rstd = rsqrtf(wave_sum(s) * (1.f / DMODEL) + NORM_EPS);
    unsigned long long* o8 = (unsigned long long*)orow + lane;
#pragma unroll
    for (int j = 0; j < 4; ++j) { const f32x4v gg = ((const f32x4v*)g)[lane + 64 * j], sh = ((const f32x4v*)shift)[lane + 64 * j], sc = ((const f32x4v*)scale)[lane + 64 * j];
        const f32x4v y = v[j] * rstd * gg * (sc + 1.0f) + sh;
        o8[64 * j] = (unsigned long long)pk2(y.x, y.y) | ((unsigned long long)pk2(y.z, y.w) << 32); }
}

__device__ __forceinline__ void norm_phase(const float* xl, const float* xc, const float* g, const float* mod, int shoff, int scoff, bf16_t* XN, int mrows, int gw, int NGW, int lane) {
    for (int m = gw; m < mrows; m += NGW) {
        const bool lat = m < ML; const int bidx = lat ? (m >> 12) : 8;
        const float* xrow = lat ? xl + (size_t)m * DMODEL : xc + (size_t)(m - ML) * DMODEL;
        norm_row(xrow, g, mod + (size_t)bidx * MODW + shoff, mod + (size_t)bidx * MODW + scoff, XN + (size_t)m * DMODEL, lane);
    }
}

__device__ __forceinline__ void prep0_phase(const float* xl, const float* xc, const float* g, const float* mod, bf16_t* XN, float* RSS, int gw, int NGW, int lane) {
    for (int m = gw; m < MT; m += NGW) {
        const bool lat = m < ML; const int bidx = lat ? (m >> 12) : 8;
        const float* xrow = lat ? xl + (size_t)m * DMODEL : xc + (size_t)(m - ML) * DMODEL;
        const f32x4v* xr = (const f32x4v*)xrow + lane; const f32x4v* sc = (const f32x4v*)(mod + (size_t)bidx * MODW + DMODEL);
        unsigned long long* o8 = (unsigned long long*)(XN + (size_t)m * DMODEL) + lane;
        float s = 0.f;
#pragma unroll
        for (int j = 0; j < 4; ++j) { const f32x4v v = xr[64 * j]; s += (v.x * v.x + v.y * v.y) + (v.z * v.z + v.w * v.w);
            const f32x4v y = v * ((const f32x4v*)g)[lane + 64 * j] * (sc[lane + 64 * j] + 1.0f);
            o8[64 * j] = (unsigned long long)pk2(y.x, y.y) | ((unsigned long long)pk2(y.z, y.w) << 32); }
        const float tot = wave_sum(s);
        if (lane < 4) RSS[(size_t)lane * MT + m] = (lane == 0) ? tot : 0.f;
    }
}

__device__ __forceinline__ void cvec_phase(const bf16_t* Win_t, const bf16_t* Wfi_t, const float* MOD, float* CVI, float* CVF, LAS unsigned char* lds, int bx, int G, int tid, int wid, int lane) {
    LAS float* sh = (LAS float*)lds;
    for (int l = 0; l < NLAY; ++l) {
        __syncthreads();
        for (int i = tid; i < 2 * 9 * 1024; i += 512) { const int which = i / 9216, rem = i % 9216, b = rem >> 10, k = rem & 1023; sh[i] = MOD[((size_t)l * 9 + b) * MODW + (which ? 3 * DMODEL : 0) + k]; }
        __syncthreads();
        for (int row = bx * 8 + wid; row < INC + 2 * FFH; row += G * 8) {
            const int which = row >= INC, n = which ? row - INC : row;
            const bf16_t* wrow = which ? Wfi_t + ((size_t)l * 2 * FFH + n) * DMODEL : Win_t + ((size_t)l * INC + n) * DMODEL;
            const v4u w0 = *(const v4u*)(wrow + lane * 8), w1 = *(const v4u*)(wrow + 512 + lane * 8);
            float wf[16];
            wf[0] = __builtin_bit_cast(float, w0.x << 16); wf[1] = __builtin_bit_cast(float, w0.x & 0xffff0000u); wf[2] = __builtin_bit_cast(float, w0.y << 16); wf[3] = __builtin_bit_cast(float, w0.y & 0xffff0000u);
            wf[4] = __builtin_bit_cast(float, w0.z << 16); wf[5] = __builtin_bit_cast(float, w0.z & 0xffff0000u); wf[6] = __builtin_bit_cast(float, w0.w << 16); wf[7] = __builtin_bit_cast(float, w0.w & 0xffff0000u);
            wf[8] = __builtin_bit_cast(float, w1.x << 16); wf[9] = __builtin_bit_cast(float, w1.x & 0xffff0000u); wf[10] = __builtin_bit_cast(float, w1.y << 16); wf[11] = __builtin_bit_cast(float, w1.y & 0xffff0000u);
            wf[12] = __builtin_bit_cast(float, w1.z << 16); wf[13] = __builtin_bit_cast(float, w1.z & 0xffff0000u); wf[14] = __builtin_bit_cast(float, w1.w << 16); wf[15] = __builtin_bit_cast(float, w1.w & 0xffff0000u);
            float mine = 0.f;
            for (int b = 0; b < 9; ++b) { const LAS float* p = sh + (which * 9 + b) * 1024 + lane * 8; float sacc = 0.f;
#pragma unroll
                for (int i = 0; i < 8; ++i) sacc += wf[i] * p[i] + wf[8 + i] * p[512 + i];
                sacc = wave_sum(sacc); if (lane == b) mine = sacc; }
            if (lane < 9) { if (which) CVF[((size_t)l * 9 + lane) * (2 * FFH) + n] = mine; else CVI[((size_t)l * 9 + lane) * INC + n] = mine; }
        }
    }
    __syncthreads();
}

__device__ __forceinline__ void fbuild_phase(const bf16_t* Hf, bf16_t* F, int gtid, int gthreads) {
    for (int idx = gtid; idx < 256 * 1024; idx += gthreads) {
        const int c = idx >> 10, qi = idx & 1023, B = 8 * (qi - 512) + 4088;
        const bf16_t* h = Hf + (size_t)c * 8192;
        v4u lo = (v4u){0u, 0u, 0u, 0u}, hi;
        if (B >= 0) lo = *(const v4u*)(h + B);
        hi = *(const v4u*)(h + B + 8);
        if (B == 0) lo.x &= 0xffff0000u;
        if (B == -8) hi.x &= 0xffff0000u;
        const unsigned d[8] = {lo.x, lo.y, lo.z, lo.w, hi.x, hi.y, hi.z, hi.w};
#pragma unroll
        for (int r = 0; r < 8; ++r) { unsigned o[4];
#pragma unroll
            for (int j = 0; j < 4; ++j) { const int e0 = r + 8 - 2 * j, e1 = e0 - 1;
                const unsigned a = (d[e0 >> 1] >> (16 * (e0 & 1))) & 0xffffu, b = (d[e1 >> 1] >> (16 * (e1 & 1))) & 0xffffu; o[j] = a | (b << 16); }
            *(v4u*)(F + (((size_t)(c * 8 + r)) * 1024 + qi) * 8) = (v4u){o[0], o[1], o[2], o[3]}; }
    }
}

__device__ __forceinline__ void filter_rows(const KArgs& a, bf16_t* Hf, float* Hc, int gw, int NGW, int lane) {
    constexpr int R = 8;
    for (int it = gw; it < NLAY * (SEQ + CTX) / R; it += NGW) {
        const int l = it / ((SEQ + CTX) / R), rr = (it % ((SEQ + CTX) / R)) * R; const bool isc = rr >= SEQ; const int t0 = isc ? rr - SEQ : rr, L = isc ? CTX : SEQ;
        float tn[R], z[R], h[R], s[R];
#pragma unroll
        for (int r = 0; r < R; ++r) { const int t = t0 + r; tn[r] = (float)t / (float)(L - 1); const float w = 6.283185307179586f * (float)t / (float)L;
            z[r] = 0.f;
            if (lane == 0) z[r] = tn[r];
            else if (lane <= 16) { const float fr = 1e-4f + (float)(lane - 1) * ((15.0f - 1e-4f) / 15.0f); z[r] = cosf(fr * w); }
            else if (lane <= 32) { const float fr = 1e-4f + (float)(lane - 17) * ((15.0f - 1e-4f) / 15.0f); z[r] = -sinf(fr * w); } }
        const float* w1 = a.in[12] + (size_t)l * 33 * 64; const float* w2 = a.in[14] + (size_t)l * 64 * 64; const float* w3 = a.in[16] + (size_t)l * 64 * 64; const float* wo = a.in[18] + (size_t)l * 64 * 512;
        const float om = a.in[19][l * 64 + lane];
#pragma unroll
        for (int r = 0; r < R; ++r) s[r] = a.in[13][l * 64 + lane];
#pragma unroll 3
        for (int k = 0; k < 33; ++k) { const float wv = w1[k * 64 + lane];
#pragma unroll
            for (int r = 0; r < R; ++r) s[r] += __shfl(z[r], k) * wv; }
#pragma unroll
        for (int r = 0; r < R; ++r) { h[r] = sinf(om * s[r]); s[r] = a.in[15][l * 64 + lane]; }
#pragma unroll 4
        for (int k = 0; k < 64; ++k) { const float wv = w2[k * 64 + lane];
#pragma unroll
            for (int r = 0; r < R; ++r) s[r] += __shfl(h[r], k) * wv; }
#pragma unroll
        for (int r = 0; r < R; ++r) { h[r] = sinf(om * s[r]); s[r] = a.in[17][l * 64 + lane]; }
#pragma unroll 4
        for (int k = 0; k < 64; ++k) { const float wv = w3[k * 64 + lane];
#pragma unroll
            for (int r = 0; r < R; ++r) s[r] += __shfl(h[r], k) * wv; }
#pragma unroll
        for (int r = 0; r < R; ++r) h[r] = sinf(om * s[r]);
        float o[R][8];
#pragma unroll
        for (int r = 0; r < R; ++r)
#pragma unroll
            for (int i = 0; i < 8; ++i) o[r][i] = 0.f;
#pragma unroll 2
        for (int k = 0; k < 64; ++k) { float hk[R];
#pragma unroll
            for (int r = 0; r < R; ++r) hk[r] = __shfl(h[r], k);
#pragma unroll
            for (int i = 0; i < 8; ++i) { const float wv = wo[k * 512 + lane + 64 * i];
#pragma unroll
                for (int r = 0; r < R; ++r) o[r][i] += hk[r] * wv; } }
        const float d0 = -4.605170185988091f / 1.5f, d1 = -4.605170185988091f / 0.3f;
#pragma unroll
        for (int i = 0; i < 8; ++i) { const int n = lane + 64 * i, c = n & 255; const bool bwd = n >= 256;
            const float delta = d0 + (float)c * ((d1 - d0) / 255.0f);
#pragma unroll
            for (int r = 0; r < R; ++r) { const int t = t0 + r; const float val = o[r][i] * expf(-tn[r] * fabsf(delta));
                if (!bwd || t > 0) { if (isc) Hc[((size_t)l * 256 + c) * 512 + 256 + (bwd ? -t : t)] = val; else Hf[((size_t)l * 256 + c) * 8192 + 4096 + (bwd ? -t : t)] = (bf16_t)f2bf((t == 0) ? val + a.in[20][l * 256 + c] : val); } } }
    }
}

__device__ __forceinline__ void mod_phase(const KArgs& a, float* MOD, LAS unsigned char* lds, int bx, int G, int tid, int wid, int lane) {
    LAS float* sc = (LAS float*)lds;
    LAS float* red = (LAS float*)(lds + 9 * 1024 * 4);
    for (int i = tid; i < 9 * 1024; i += 512) { const float x = (i < 8 * 1024) ? a.in[1][i] : a.in[3][i - 8 * 1024]; sc[i] = x / (1.0f + __expf(-x)); }
    __syncthreads();
    for (int u = bx; u < NLAY * (MODW / 64); u += G) {
        const int l = u / (MODW / 64), n0 = (u % (MODW / 64)) * 64;
        const float* W = a.in[4] + (size_t)l * DMODEL * MODW + n0 + lane;
        float acc[9];
#pragma unroll
        for (int j = 0; j < 9; ++j) acc[j] = 0.f;
        for (int k = wid * 128; k < wid * 128 + 128; ++k) { const float wv = W[(size_t)k * MODW];
#pragma unroll
            for (int j = 0; j < 9; ++j) acc[j] += sc[j * 1024 + k] * wv; }
#pragma unroll
        for (int j = 0; j < 9; ++j) red[(wid * 9 + j) * 64 + lane] = acc[j];
        __syncthreads();
        for (int i = tid; i < 9 * 64; i += 512) { const int j = i >> 6, c = i & 63; float s = a.in[5][(size_t)l * MODW + n0 + c];
#pragma unroll
            for (int w = 0; w < 8; ++w) s += red[(w * 9 + j) * 64 + c];
            MOD[((size_t)l * 9 + j) * MODW + n0 + c] = s; }
        __syncthreads();
    }
}

__device__ __forceinline__ void hy_prep_unit(const bf16_t* P, const float* cw, const float* cb, bf16_t* UT, bf16_t* X2T, int b, int s0, int c0, LAS unsigned char* lds, int tid) {
    LAS float* in = (LAS float*)lds;
    v4u rawv[4];
#pragma unroll
    for (int q = 0; q < 4; ++q) { const int idx = tid + 512 * q; rawv[q] = (v4u){0u, 0u, 0u, 0u};
        if (idx < 3 * 66 * 8) { const int sec = idx / (66 * 8), rem = idx % (66 * 8), rr = rem >> 3, ch = rem & 7, s = s0 - 1 + rr;
            if (s >= 0 && s < SEQ) rawv[q] = *(const v4u*)(P + (size_t)(b * SEQ + s) * INC + sec * 256 + c0 + ch * 8); } }
#pragma unroll
    for (int q = 0; q < 4; ++q) { const int idx = tid + 512 * q;
        if (idx < 3 * 66 * 8) { const int sec = idx / (66 * 8), rem = idx % (66 * 8), rr = rem >> 3, ch = rem & 7; const v4u raw = rawv[q];
        LAS float* d = in + (sec * 66 + rr) * 65 + ch * 8;
        d[0] = __builtin_bit_cast(float, raw.x << 16); d[1] = __builtin_bit_cast(float, raw.x & 0xffff0000u);
        d[2] = __builtin_bit_cast(float, raw.y << 16); d[3] = __builtin_bit_cast(float, raw.y & 0xffff0000u);
        d[4] = __builtin_bit_cast(float, raw.z << 16); d[5] = __builtin_bit_cast(float, raw.z & 0xffff0000u);
        d[6] = __builtin_bit_cast(float, raw.w << 16); d[7] = __builtin_bit_cast(float, raw.w & 0xffff0000u); } }
    __syncthreads();
    {
        const int c = tid >> 3, k = tid & 7;
        float w[3][3], bb[3];
#pragma unroll
        for (int sec = 0; sec < 3; ++sec) { bb[sec] = cb[sec * 256 + c0 + c];
#pragma unroll
            for (int i = 0; i < 3; ++i) w[sec][i] = cw[i * 768 + sec * 256 + c0 + c]; }
        float vv[8], x2[8];
#pragma unroll
        for (int i = 0; i < 8; ++i) { const int rr = k * 8 + i; float cv[3];
#pragma unroll
            for (int sec = 0; sec < 3; ++sec) { const LAS float* p = in + (sec * 66 + rr) * 65 + c; cv[sec] = w[sec][0] * p[0] + w[sec][1] * p[65] + w[sec][2] * p[130] + bb[sec]; }
            vv[i] = cv[0] * cv[1]; x2[i] = cv[2]; }
        const size_t o = ((size_t)(b * 256 + c0 + c)) * SEQ + s0 + k * 8;
        v4u a; a.x = pk2(vv[0], vv[1]); a.y = pk2(vv[2], vv[3]); a.z = pk2(vv[4], vv[5]); a.w = pk2(vv[6], vv[7]); *(v4u*)(UT + o) = a;
        v4u d; d.x = pk2(x2[0], x2[1]); d.y = pk2(x2[2], x2[3]); d.z = pk2(x2[4], x2[5]); d.w = pk2(x2[6], x2[7]); *(v4u*)(X2T + o) = d;
    }
    __syncthreads();
}

constexpr int HY_PB = 5904;
__device__ __forceinline__ void hy_conv_unit(const bf16_t* UT, const bf16_t* F, bf16_t* YT, int c, LAS unsigned char* lds, int tid, int wid, int lane) {
    LAS bf16_t* U = (LAS bf16_t*)lds;
    { const unsigned z = (unsigned)opq(0);
      for (int i = tid; i < NB * HY_PB / 8; i += 512) ((LAS v4u*)U)[i] = (v4u){z, z, z, z}; }
    __syncthreads();
    { v4u rawu[8];
#pragma unroll
      for (int q = 0; q < 8; ++q) { const int i = tid + 512 * q, b = i >> 9, s = (i & 511) * 8; rawu[q] = *(const v4u*)(UT + ((size_t)(b * 256 + c)) * SEQ + s); }
#pragma unroll
      for (int q = 0; q < 8; ++q) { const int i = tid + 512 * q, b = i >> 9, s = (i & 511) * 8, sp = s + 768; *(LAS v4u*)(U + b * HY_PB + sp + 8 * (sp >> 8)) = rawu[q]; } }
    __syncthreads();
    const int rp = wid & 3, gh = wid >> 2, mp = lane & 31, g = lane >> 5, bq = lane & 7, isub = (lane >> 3) & 3;
    const bf16x8v* F0 = (const bf16x8v*)F + ((size_t)(c * 8 + 2 * rp)) * 1024; const bf16x8v* F1 = F0 + 1024;
    f32x16 acc[2][2];
#pragma unroll
    for (int i = 0; i < 2; ++i)
#pragma unroll
        for (int j = 0; j < 2; ++j)
#pragma unroll
            for (int r = 0; r < 16; ++r) acc[i][j][r] = 0.f;
    const int G0 = 2 * gh, jlo = 64 * G0 - 255, jhi = 64 * (G0 + 1) + 48;
    const LAS bf16_t* Ub = U + bq * HY_PB;
    constexpr int PF = 4;
    bf16x8v a0b[PF], a1b[PF];
    const int qbase = mp - g + 512;
#pragma unroll
    for (int p = 0; p < PF; ++p) { a0b[p] = F0[2 * (jlo + p) + qbase]; a1b[p] = F1[2 * (jlo + p) + qbase]; }
#define HY_STEP(D0, D1) do { const int j = j0 + p; const bf16x8v a0 = a0b[p], a1 = a1b[p]; \
        { int jn = j + PF; jn = jn > jhi ? jhi : jn; a0b[p] = F0[2 * jn + qbase]; a1b[p] = F1[2 * jn + qbase]; } \
        if (D0) { const int sp = 256 * (4 * G0 + isub) + 8 * g + 768 - 16 * j; const bf16x8v bf = *(const LAS bf16x8v*)(Ub + sp + 8 * (sp >> 8)); \
            acc[0][0] = __builtin_amdgcn_mfma_f32_32x32x16_bf16(a0, bf, acc[0][0], 0, 0, 0); acc[1][0] = __builtin_amdgcn_mfma_f32_32x32x16_bf16(a1, bf, acc[1][0], 0, 0, 0); } \
        if (D1) { const int sp = 256 * (4 * (G0 + 1) + isub) + 8 * g + 768 - 16 * j; const bf16x8v bf = *(const LAS bf16x8v*)(Ub + sp + 8 * (sp >> 8)); \
            acc[0][1] = __builtin_amdgcn_mfma_f32_32x32x16_bf16(a0, bf, acc[0][1], 0, 0, 0); acc[1][1] = __builtin_amdgcn_mfma_f32_32x32x16_bf16(a1, bf, acc[1][1], 0, 0, 0); } } while (0)
    for (int j0 = jlo; j0 < jlo + 64; j0 += PF) {
#pragma unroll
        for (int p = 0; p < PF; ++p) HY_STEP(true, false); }
    for (int j0 = jlo + 64; j0 <= jhi - 64; j0 += PF) {
#pragma unroll
        for (int p = 0; p < PF; ++p) HY_STEP(true, true); }
    for (int j0 = jhi - 63; j0 <= jhi; j0 += PF) {
#pragma unroll
        for (int p = 0; p < PF; ++p) HY_STEP(false, true); }
#undef HY_STEP
    __syncthreads();
    LAS bf16_t* Y = (LAS bf16_t*)lds;
    for (int re_ = 0; re_ < PR_HYEPI; ++re_) {
#pragma unroll
    for (int ri = 0; ri < 2; ++ri)
#pragma unroll
        for (int gi = 0; gi < 2; ++gi) { const int r = 2 * rp + ri, I = 4 * (G0 + gi) + isub;
#pragma unroll
            for (int reg = 0; reg < 16; ++reg) { const int m = (reg & 3) + 8 * (reg >> 2) + 4 * g, t = 256 * I + 8 * m + r;
                Y[bq * (SEQ + 136) + t + 8 * I] = (bf16_t)f2bf(acc[ri][gi][reg]); } }
    __syncthreads();
    for (int i = tid; i < NB * SEQ / 8; i += 512) { const int b = i >> 9, t = (i & 511) * 8;
        *(v4u*)(YT + ((size_t)(b * 256 + c)) * SEQ + t) = *(const LAS v4u*)(Y + b * (SEQ + 136) + t + 8 * (t >> 8)); }
    }
    __syncthreads();
}

__device__ __forceinline__ void hy_post_unit(const bf16_t* YT, const bf16_t* X2T, bf16_t* MIX, int b, int t0, LAS unsigned char* lds, int tid) {
    LAS bf16_t* T = (LAS bf16_t*)lds;
#pragma unroll
    for (int k = 0; k < 4; ++k) { const int idx = tid + 512 * k, c = idx >> 3, ch = idx & 7;
        const size_t o = ((size_t)(b * 256 + c)) * SEQ + t0 + ch * 8;
        const v4u y = *(const v4u*)(YT + o), x = *(const v4u*)(X2T + o);
        const unsigned yy[4] = {y.x, y.y, y.z, y.w}, xx[4] = {x.x, x.y, x.z, x.w};
#pragma unroll
        for (int e = 0; e < 4; ++e) { const float lo = __builtin_bit_cast(float, yy[e] << 16) * __builtin_bit_cast(float, xx[e] << 16), hi = __builtin_bit_cast(float, yy[e] & 0xffff0000u) * __builtin_bit_cast(float, xx[e] & 0xffff0000u);
            T[(ch * 8 + 2 * e) * 260 + c] = (bf16_t)f2bf(lo); T[(ch * 8 + 2 * e + 1) * 260 + c] = (bf16_t)f2bf(hi); } }
    __syncthreads();
#pragma unroll
    for (int k = 0; k < 4; ++k) { const int idx = tid + 512 * k, t = idx >> 5, ch = idx & 31;
        const LAS v2u* p = (const LAS v2u*)(T + t * 260 + ch * 8); const v2u a = p[0], d = p[1];
        *(v4u*)(MIX + (size_t)(b * SEQ + t0 + t) * DMODEL + ch * 8) = (v4u){a.x, a.y, d.x, d.y}; }
    __syncthreads();
}

__device__ __forceinline__ void hy_ctx_unit(const bf16_t* P, const float* cw, const float* cb, const float* Hc, const float* skip, bf16_t* MIX, int b, int c0, LAS unsigned char* lds, int tid) {
    LAS float* vv = (LAS float*)lds;
    LAS float* fc = vv + 256 * 17;
    const int c = tid & 15, tq = tid >> 4;
    const bf16_t* Pb = P + (size_t)(ML + b * CTX) * INC;
    float w[3][3], bb[3];
#pragma unroll
    for (int sec = 0; sec < 3; ++sec) { bb[sec] = cb[sec * 256 + c0 + c];
#pragma unroll
        for (int i = 0; i < 3; ++i) w[sec][i] = cw[i * 768 + sec * 256 + c0 + c]; }
#pragma unroll 2
    for (int i = 0; i < 8; ++i) { const int s = tq + 32 * i; float cv[2];
#pragma unroll
        for (int sec = 0; sec < 2; ++sec) { float x = bb[sec];
#pragma unroll
            for (int k = 0; k < 3; ++k) { const int ss = s - 1 + k; if (ss >= 0 && ss < CTX) x += w[sec][k] * bf2f(Pb[(size_t)ss * INC + sec * 256 + c0 + c]); }
            cv[sec] = x; }
        vv[s * 17 + c] = cv[0] * cv[1]; }
    for (int i = tid; i < 16 * 512; i += 512) { const int cc = i >> 9, id = i & 511; float x = (id >= 1) ? Hc[(size_t)(c0 + cc) * 512 + id] : 0.f; if (id == 256) x += skip[c0 + cc]; fc[cc * 513 + id] = x; }
    __syncthreads();
    float acc[8];
#pragma unroll
    for (int i = 0; i < 8; ++i) acc[i] = 0.f;
    const LAS float* fcc = fc + c * 513 + 256 + tq;
    for (int s = 0; s < CTX; ++s) { const float v = vv[s * 17 + c];
#pragma unroll
        for (int i = 0; i < 8; ++i) acc[i] += v * fcc[32 * i - s]; }
#pragma unroll 2
    for (int i = 0; i < 8; ++i) { const int t = tq + 32 * i; float x = bb[2];
#pragma unroll
        for (int k = 0; k < 3; ++k) { const int ss = t - 1 + k; if (ss >= 0 && ss < CTX) x += w[2][k] * bf2f(Pb[(size_t)ss * INC + 512 + c0 + c]); }
        MIX[(size_t)(ML + b * CTX + t) * DMODEL + c0 + c] = (bf16_t)f2bf(x * acc[i]); }
    __syncthreads();
}

__global__ void __launch_bounds__(512, 2) hybrid_fwd(KArgs a) {
    extern __shared__ __attribute__((aligned(16))) unsigned char lds_raw[];
    LAS unsigned char* lds = (LAS unsigned char*)lds_raw;
    cg::grid_group grid = cg::this_grid();
    const int tid = threadIdx.x, lane = tid & 63, wid = __builtin_amdgcn_readfirstlane(tid >> 6);
    const int G = gridDim.x, bx = blockIdx.x, gw = bx * 8 + wid, NGW = G * 8, gtid = bx * 512 + tid, gthreads = G * 512;
    unsigned char* ws = a.ws;
    bf16_t* Win_t = (bf16_t*)(ws + WS_WIN); bf16_t* Wout_t = (bf16_t*)(ws + WS_WOUT); bf16_t* Wfi_t = (bf16_t*)(ws + WS_WFI); bf16_t* Wfo_t = (bf16_t*)(ws + WS_WFO);
    float* MOD = (float*)(ws + WS_MOD); float* ROPE = (float*)(ws + WS_ROPE); bf16_t* Hf = (bf16_t*)(ws + WS_HF); float* Hc = (float*)(ws + WS_HC);
    bf16_t* F = (bf16_t*)(ws + WS_F); bf16_t* XN = (bf16_t*)(ws + WS_XN); bf16_t* P = (bf16_t*)(ws + WS_P); bf16_t* MIX = (bf16_t*)(ws + WS_MIX); bf16_t* ACT = (bf16_t*)(ws + WS_P);
    float* XC = (float*)(ws + WS_XC); bf16_t* UT = (bf16_t*)(ws + WS_UT); bf16_t* X2T = (bf16_t*)(ws + WS_X2T); bf16_t* YT = (bf16_t*)(ws + WS_YT);
    float* XL = a.out;
    float* RSS = (float*)(ws + WS_RSS); float* CVI = (float*)(ws + WS_CVI); float* CVF = (float*)(ws + WS_CVF);
    volatile LAS unsigned* xst = (volatile LAS unsigned*)(lds + LDS_BYTES - 64);
    if (tid < 16) xst[tid] = 0u;
    __syncthreads();
    XcdBarrier xbar = xcd_barrier_post((unsigned*)(ws + WS_CTL), xst);

    for (int rp0_ = 0; rp0_ < PR_P0; ++rp0_) {
        LAS float* scr = (LAS float*)(lds + 65536 + wid * 8704);
        constexpr int I_IN = (DMODEL / 64) * (INC / 32), I_OUT = (DMODEL / 64) * (DMODEL / 32), I_FI = (DMODEL / 64) * (2 * FFH / 32), I_FO = (FFH / 64) * (DMODEL / 32);
        constexpr int I_L = I_IN + I_OUT + I_FI + I_FO;
        for (int it = gw; it < NLAY * I_L; it += NGW) {
            const int l = it / I_L; int r = it % I_L;
            if (r < I_IN) { const int nblk = INC / 32, kb = r / nblk, n0 = (r % nblk) * 32; const int pn = n0 >> 8, wc = (n0 & 255) >> 6, bj = (n0 & 63) >> 5;
                transpose_item(a.in[8] + (size_t)l * DMODEL * INC, INC, DMODEL, Win_t + (size_t)l * INC * DMODEL, kb * 64, n0, pn * 256 + bj * 128 + wc * 32, scr, lane); continue; }
            r -= I_IN;
            if (r < I_OUT) { const int nblk = DMODEL / 32, kb = r / nblk, n0 = (r % nblk) * 32;
                transpose_item(a.in[9] + (size_t)l * DMODEL * DMODEL, DMODEL, DMODEL, Wout_t + (size_t)l * DMODEL * DMODEL, kb * 64, n0, n0, scr, lane); continue; }
            r -= I_OUT;
            if (r < I_FI) { const int nblk = 2 * FFH / 32, kb = r / nblk, n0 = (r % nblk) * 32; const int half = n0 / FFH, idx = n0 % FFH, pn = idx >> 7, jj = idx & 127;
                transpose_item(a.in[24] + (size_t)l * DMODEL * 2 * FFH, 2 * FFH, DMODEL, Wfi_t + (size_t)l * 2 * FFH * DMODEL, kb * 64, n0, pn * 256 + half * 128 + jj, scr, lane); continue; }
            r -= I_FI;
            { const int nblk = DMODEL / 32, kb = r / nblk, n0 = (r % nblk) * 32;
                transpose_item(a.in[25] + (size_t)l * FFH * DMODEL, DMODEL, FFH, Wfo_t + (size_t)l * DMODEL * FFH, kb * 64, n0, n0, scr, lane); }
        }
        __syncthreads();
        mod_phase(a, MOD, lds, bx, G, opq(tid), wid, opq(lane));
        filter_rows(a, Hf, Hc, gw, NGW, opq(lane));
        for (int i = gtid; i < 64 * 16; i += gthreads) { const int pos = i >> 4, f = i & 15; const float inv = powf(10000.0f, -(float)f / 16.0f), ang = (float)pos * inv; ROPE[2 * i] = cosf(ang); ROPE[2 * i + 1] = sinf(ang); }
    }
    grid.sync();
    prep0_phase(a.in[0], a.in[2], a.in[6], MOD, XN, RSS, gw, NGW, opq(lane));
    fbuild_phase(Hf, F, opq(gtid), gthreads);
    cvec_phase(Win_t, Wfi_t, MOD, CVI, CVF, lds, bx, G, opq(tid), wid, opq(lane));
    GSYNC();

#pragma nounroll
    for (int l = 0; l < NLAY; ++l) {
        const bool last = (l == NLAY - 1);
        const float* modl = MOD + (size_t)l * 9 * MODW;
        const float* xl_in = (l == 0) ? a.in[0] : XL; const float* xc_in = (l == 0) ? a.in[2] : XC;
        { pg8::Gemm g{XN, Win_t + (size_t)l * INC * DMODEL, MT, INC, DMODEL}; pg8::StaticOrder S; S.init(MT, INC, G, bx);
          pg8::EpiInProj E{P, a.in[21] + l * 64, a.in[22] + l * 64, ROPE, RSS, CVI + (size_t)l * 9 * INC};
          pg8::gemm_phase<pg8::EpiInProj, pg8::StaticOrder, true, true>(lds, g, S, E); }
        GSYNC();
        {
            const attn_body::bf16* Pb = (const attn_body::bf16*)P; attn_body::bf16* Mb = (attn_body::bf16*)MIX;
            unsigned* cbase = (unsigned*)(ws + WS_CTL) + 4096 + 2048 * l;
            unsigned* ctrA = cbase; unsigned* ctrB = cbase + 64; unsigned* ctrC = cbase + 128; unsigned* cnt4c = cbase + 192; unsigned* cnt6c = cbase + 192 + 8 * 64; unsigned* tmo = (unsigned*)(ws + WS_CTL) + XB_TMO;
            float fixm;
            { const int ln_ = opq(lane); float mq = fabsf(a.in[21][l * 64 + ln_]), mk = fabsf(a.in[22][l * 64 + ln_]);
#pragma unroll
              for (int o_ = 1; o_ < 64; o_ <<= 1) { mq = fmaxf(mq, __shfl_xor(mq, o_)); mk = fmaxf(mk, __shfl_xor(mk, o_)); }
              fixm = fminf(64.0f * QSCALE * 1.015f * mq * mk, 60.0f); }
            const bf16_t* ACTCv = (const bf16_t*)(ws + WS_ACTC) - (size_t)ML * FFH;
            for (int u = bx; u < NB * 64 * 4; u += G) { const int b = u & 7, cgp = (u >> 3) & 3, sc = u >> 5;
                hy_prep_unit(P, a.in[10] + (size_t)l * 3 * 768, a.in[11] + (size_t)l * 768, UT, X2T, b, sc * 64, cgp * 64, lds, opq(tid)); }
            sb_arrive(ctrA, opq(tid));
            if (!last) { for (int vv_ = bx; vv_ < 256; vv_ += G) { const int v = (G == 256) ? (vv_ >= 240 ? vv_ - 240 : (vv_ < 208 ? vv_ + 16 : 1000)) : vv_; if (v >= 224) continue;
                if (v < 64) { const int b = v & 7, h = v >> 3, kvh = h >> 2;
                    attn_body::attn_unit<8, 2>(Pb + (size_t)(ML + b * CTX) * INC + 768 + h * 64, Pb + 1280 + kvh * 64, Pb + 1408 + kvh * 64,
                        Mb + (size_t)(ML + b * CTX) * DMODEL + 256 + h * 64, ML + b * CTX, 0, 0, 4, 0, 0, nullptr, (char*)lds_raw, fixm);
                } else if (v < 96) { const int w = v - 64, b = w & 7, h = w >> 3;
                    attn_body::attn_unit<8, 0>(Pb + (size_t)(ML + b * CTX) * INC + 1536 + h * 64, Pb + 1792 + h * 64, Pb + 2048 + h * 64,
                        Mb + (size_t)(ML + b * CTX) * DMODEL + 768 + h * 64, ML + b * CTX, 0, 0, 4, 0, 0, nullptr, (char*)lds_raw);
                } else { const int w = v - 96, b = w & 7, cgp = w >> 3;
                    hy_ctx_unit(P, a.in[10] + (size_t)l * 3 * 768, a.in[11] + (size_t)l * 768, Hc + (size_t)l * 256 * 512, a.in[20] + l * 256, MIX, b, cgp * 16, lds, opq(tid)); }
            }
              sb_arrive(ctrC, opq(tid)); }
#define GQA_UNIT(u) do { const int b = (u) & 7, idx = (u) >> 3, h = idx >> 4, qb = idx & 15, kvh = h >> 2; \
                attn_body::attn_unit<8, 2>(Pb + (size_t)(b * SEQ + qb * 256) * INC + 768 + h * 64, Pb + 1280 + kvh * 64, Pb + 1408 + kvh * 64, \
                    Mb + (size_t)(b * SEQ + qb * 256) * DMODEL + 256 + h * 64, ML + b * CTX, b * SEQ, 1 << 20, 68, 0, 0, nullptr, (char*)lds_raw, fixm); } while (0)
            for (int u = bx; u < 512; u += G) GQA_UNIT(u);
            if (!last) for (int v = bx; v < 32; v += G) { const int pb = v >> 2;
                sb_wait(ctrC, (unsigned)G, tmo, opq(tid));
                pg8::Gemm g{MIX, Wout_t + (size_t)l * DMODEL * DMODEL, MT, DMODEL, DMODEL}; pg8::OneUnit S{ML / 256 + pb, v & 3};
                pg8::EpiResid E{xl_in, xc_in, XL, XC, modl + 2 * DMODEL, XN, RSS, a.in[7] + l * DMODEL, modl + 4 * DMODEL, 1, (LAS float*)(lds + 131072)};
                pg8::gemm_phase<pg8::EpiResid, pg8::OneUnit, true, true>(lds, g, S, E);
                sb_arrive(cnt4c + 64 * pb, opq(tid)); }
            sb_wait(ctrA, (unsigned)G, tmo, opq(tid));
            for (int c = bx; c < 256; c += G) hy_conv_unit(UT, F, YT, c, lds, opq(tid), wid, opq(lane));
            sb_arrive(ctrB, opq(tid));
            if (!last) for (int v = bx; v < 208; v += G) if (v >= 32) { const int w = v - 32, pb = w / 22, pn = w % 22;
                sb_wait(cnt4c + 64 * pb, 4u, tmo, opq(tid));
                pg8::Gemm g{XN, Wfi_t + (size_t)l * 2 * FFH * DMODEL, MT, 2 * FFH, DMODEL}; pg8::OneUnit S{ML / 256 + pb, pn};
                pg8::EpiSwiglu E{(bf16_t*)ACTCv, RSS, CVF + (size_t)l * 9 * 2 * FFH};
                pg8::gemm_phase<pg8::EpiSwiglu, pg8::OneUnit, true, true>(lds, g, S, E);
                sb_arrive(cnt6c + 64 * pb, opq(tid)); }
            for (int u = 512 + bx; u < 1024; u += G) GQA_UNIT(u);
#undef GQA_UNIT
            const bool bal = (!last && G == 256);
            const int n_na = !bal ? ((512 - bx + G - 1) / G) : (bx >= 240 ? 4 : (bx >= 208 ? 1 : 2));
            for (int ii = 0; ii < n_na; ++ii) {
                const int v = !bal ? (bx + ii * G) : (ii < 2 ? bx + ii * 256 : 256 + 208 + 2 * (bx - 240) + (ii - 2));
                const int b = v & 7, idx = v >> 3, h = idx >> 4, qg = idx & 15;
                int r0 = 4 * qg - 4; r0 = r0 < 0 ? 0 : (r0 > 56 ? 56 : r0);
                LAS float* bias = (LAS float*)(lds + NA_BIAS_OFF);
                for (int i = opq(tid); i < 15 * 31; i += 512) bias[i] = a.in[23][((size_t)l * 4 + h) * 465 + i] * LOG2E;
                __syncthreads();
                attn_body::attn_unit<8, 1>(Pb + (size_t)(b * SEQ + qg * 256) * INC + 1536 + h * 64, Pb + 1792 + h * 64, Pb + 2048 + h * 64,
                    Mb + (size_t)(b * SEQ + qg * 256) * DMODEL + 768 + h * 64, ML + b * CTX, b * SEQ + r0 * 64, 63 - r0, 16, r0, 4 * qg, (const float*)(lds_raw + NA_BIAS_OFF), (char*)lds_raw);
            }
            if (!last) for (int v = bx; v < 240; v += G) if (v >= 208) { const int w = v - 208, pb = w >> 2;
                sb_wait(cnt6c + 64 * pb, 22u, tmo, opq(tid));
                pg8::Gemm g{ACTCv, Wfo_t + (size_t)l * DMODEL * FFH, MT, DMODEL, FFH}; pg8::OneUnit S{ML / 256 + pb, w & 3};
                pg8::EpiResid E{XL, XC, XL, XC, modl + 5 * DMODEL, XN, RSS, a.in[6] + (l + 1) * DMODEL, MOD + (size_t)(l + 1) * 9 * MODW + DMODEL, 1, (LAS float*)(lds + 131072)};
                pg8::gemm_phase<pg8::EpiResid, pg8::OneUnit, true, true>(lds, g, S, E); }
            sb_wait(ctrB, (unsigned)G, tmo, opq(tid));
            for (int u = bx; u < NB * 64; u += G) hy_post_unit(YT, X2T, MIX, u & 7, (u >> 3) * 64, lds, opq(tid));
        }
        GSYNC();
        const int mrows = ML;
        if (!last) fbuild_phase(Hf + (size_t)(l + 1) * 256 * 8192, F, opq(gtid), gthreads);
        { pg8::Gemm g{MIX, Wout_t + (size_t)l * DMODEL * DMODEL, mrows, DMODEL, DMODEL}; pg8::StaticOrder S; S.init(mrows, DMODEL, G, bx);
          pg8::EpiResid E{xl_in, xc_in, XL, XC, modl + 2 * DMODEL, XN, RSS, a.in[7] + l * DMODEL, modl + 4 * DMODEL, 1, (LAS float*)(lds + 131072)};
          pg8::gemm_phase<pg8::EpiResid, pg8::StaticOrder, true, true>(lds, g, S, E); }
        GSYNC();
        { pg8::Gemm g{XN, Wfi_t + (size_t)l * 2 * FFH * DMODEL, mrows, 2 * FFH, DMODEL}; pg8::StaticOrder S; S.init(mrows, 2 * FFH, G, bx);
          pg8::EpiSwiglu E{ACT, RSS, CVF + (size_t)l * 9 * 2 * FFH};
          for (int rf_ = 0; rf_ < PR_FFI; ++rf_) pg8::gemm_phase<pg8::EpiSwiglu, pg8::StaticOrder, true, true>(lds, g, S, E); }
        GSYNC();
        { pg8::Gemm g{ACT, Wfo_t + (size_t)l * DMODEL * FFH, mrows, DMODEL, FFH}; pg8::StaticOrder S; S.init(mrows, DMODEL, G, bx);
          pg8::EpiResid E{XL, XC, XL, XC, modl + 5 * DMODEL, XN, RSS, a.in[6] + (last ? l : l + 1) * DMODEL, MOD + (size_t)(last ? l : l + 1) * 9 * MODW + DMODEL, last ? 0 : 1, (LAS float*)(lds + 131072)};
          pg8::gemm_phase<pg8::EpiResid, pg8::StaticOrder, true, true>(lds, g, S, E); }
        GSYNC();
    }
    for (int m = gw; m < ML; m += NGW) { const int lane_o = opq(lane); f32x4v* xr = (f32x4v*)(XL + (size_t)m * DMODEL) + lane_o; f32x4v v[4]; float s = 0.f;
#pragma unroll
        for (int j = 0; j < 4; ++j) { v[j] = xr[64 * j]; s += (v[j].x * v[j].x + v[j].y * v[j].y) + (v[j].z * v[j].z + v[j].w * v[j].w); }
        const float rstd = rsqrtf(wave_sum(s) * (1.f / DMODEL) + NORM_EPS);
#pragma unroll
        for (int j = 0; j < 4; ++j) xr[64 * j] = v[j] * rstd * ((const f32x4v*)a.in[26])[lane_o + 64 * j]; }
}

extern "C" void kernel_launch(void* const* d_in, const int* in_sizes, int n_in, void* d_out, int out_size, void* d_ws, size_t ws_size, hipStream_t stream) {
    static int grid_blocks = 0;
    if (grid_blocks == 0) {
        if (n_in != 27 || ws_size < WS_END) { fprintf(stderr, "kernel_launch: expected 27 inputs and >= %zu bytes of workspace (got %d, %zu)\n", (size_t)WS_END, n_in, ws_size); grid_blocks = -1; return; }
        int dev = 0, cus = 0, per_cu = 0;
        hipGetDevice(&dev); hipDeviceGetAttribute(&cus, hipDeviceAttributeMultiprocessorCount, dev);
        hipFuncSetAttribute((const void*)hybrid_fwd, hipFuncAttributeMaxDynamicSharedMemorySize, LDS_BYTES);
        hipOccupancyMaxActiveBlocksPerMultiprocessor(&per_cu, (const void*)hybrid_fwd, 512, LDS_BYTES);
        if (per_cu < 1) per_cu = 1;
        grid_blocks = cus * per_cu;
        (void)hipGetLastError();
    }
    if (grid_blocks < 0) return;
    if (hipMemsetAsync((char*)d_ws + WS_CTL, 0, CTL_BYTES, stream) != hipSuccess) { fprintf(stderr, "kernel_launch: memset of the barrier words failed\n"); return; }
    KArgs a{};
    for (int i = 0; i < 27; ++i) a.in[i] = (const float*)d_in[i];
    a.out = (float*)d_out; a.ws = (unsigned char*)d_ws;
    void* args[] = {&a};
    hipError_t e = hipLaunchCooperativeKernel((const void*)hybrid_fwd, dim3(grid_blocks), dim3(512), args, LDS_BYTES, stream);
    if (e != hipSuccess) fprintf(stderr, "cooperative launch failed: %s (grid %d)\n", hipGetErrorString(e), grid_blocks);
}
```

```cpp
#include <hip/hip_runtime.h>
#include <hip/hip_bf16.h>
#include <hip/hip_cooperative_groups.h>
#include <cstdio>
#include <cstdint>
#include <cmath>
namespace cg = cooperative_groups;
#ifndef PR_SYNC
#define PR_SYNC 1
#endif
#ifndef PR_MIX
#define PR_MIX 1
#endif
#ifndef PR_HY
#define PR_HY 1
#endif
#ifndef PR_HYEPI
#define PR_HYEPI 1
#endif
#ifndef PR_P0
#define PR_P0 1
#endif
#ifndef PR_NA
#define PR_NA 1
#endif
#ifndef PR_NORM
#define PR_NORM 1
#endif
#ifndef PR_FFI
#define PR_FFI 1
#endif
#ifndef PR_GQA
#define PR_GQA 1
#endif
#define GSYNC() do { for (int s_ = 0; s_ < PR_SYNC; ++s_) xcd_barrier(xbar); } while (0)

constexpr int DMODEL = 1024, NB = 8, SEQ = 4096, NLAY = 4, CTX = 256;
constexpr int ML = NB * SEQ, MC = NB * CTX, MT = ML + MC;
constexpr int INC = 2304, FFH = 2816, MODW = 6 * DMODEL;
constexpr float NORM_EPS = 1e-6f;
constexpr float QSCALE = 0.125f * 1.4426950408889634f;
constexpr float LOG2E = 1.4426950408889634f;

#define LAS __attribute__((address_space(3)))
#define GAS __attribute__((address_space(1)))
typedef unsigned v4u __attribute__((ext_vector_type(4)));
typedef unsigned v2u __attribute__((ext_vector_type(2)));
typedef float f32x16 __attribute__((ext_vector_type(16)));
typedef float f32x4v __attribute__((ext_vector_type(4)));
typedef short bf16x8v __attribute__((ext_vector_type(8)));

__device__ __forceinline__ unsigned f2bf(float f) { unsigned u = __builtin_bit_cast(unsigned, f); return (u + 0x7fffu + ((u >> 16) & 1u)) >> 16; }
__device__ __forceinline__ unsigned pk2(float lo, float hi) { return f2bf(lo) | (f2bf(hi) << 16); }
__device__ __forceinline__ float bf2f(unsigned short u) { return __builtin_bit_cast(float, (unsigned)u << 16); }
__device__ __forceinline__ int opq(int v) { asm volatile("" : "+v"(v)); return v; }
__device__ __forceinline__ float wave_sum(float v) {
#pragma unroll
    for (int o = 1; o < 64; o <<= 1) v += __shfl_xor(v, o);
    return v;
}

namespace pg8 {
#define PG8_LAS __attribute__((address_space(3)))
typedef unsigned short bf16_t;
typedef short bf16x8 __attribute__((ext_vector_type(8)));
typedef float f32x4 __attribute__((ext_vector_type(4)));
typedef unsigned u32x4 __attribute__((ext_vector_type(4)));
constexpr int BM = 256, BK = 64, HALF = 128, HTB = HALF * BK * 2  , STAGE_BYTES = 8 * HTB, NXCD = 8, WGM = 8;

__host__ __device__ __forceinline__ int lds_byte(int r, int c) { const int st = (r >> 4) * 2 + (c >> 5), rr = r & 15, cc = c & 31, ob = rr * 64 + cc * 2; return st * 1024 + (ob ^ (((ob >> 9) & 1) << 5)); }
__host__ __device__ __forceinline__ void stage_rc(int b, int& R, int& C) { const int st = b / 1024, sb = b % 1024, swz = sb ^ (((sb >> 9) & 1) << 5); R = (st >> 1) * 16 + swz / 64; C = (st & 1) * 32 + (swz % 64) / 2; }
__host__ __device__ __forceinline__ int perm32(int rho) { const int n = rho >> 4, i = rho & 15; return 8 * (i >> 2) + 4 * n + (i & 3); }

struct Unit { int pm, pn; };
struct Gemm { const bf16_t* A; const bf16_t* Bt; int M, N, K; };

struct StaticOrder {
    int nM, nN, nwg, G, c;
    __host__ __device__ void init(int M, int N, int G_, int c_) { nM = M / BM; nN = N / BM; nwg = nM * nN; G = G_; c = c_; }
    __host__ __device__ bool next(int i, Unit& u) const {
        const long L = (long)i * G + c; if (L >= nwg) return false;
        int wgid = (int)L; { const int q = nwg / NXCD, r = nwg % NXCD, xcd = wgid % NXCD, off = wgid / NXCD; wgid = (xcd < r ? xcd * (q + 1) : r * (q + 1) + (xcd - r) * q) + off; }
        const int nig = WGM * nN, gid = wgid / nig, fm = gid * WGM, gsz = (nM - fm) < WGM ? (nM - fm) : WGM;
        u.pm = fm + ((wgid % nig) % gsz); u.pn = (wgid % nig) / gsz; return true;
    }
    __device__ __forceinline__ void a_ready(const Unit&) const {}
    __device__ __forceinline__ void done(const Unit&) const {}
};

struct OneUnit { int pm, pn;
    __host__ __device__ bool next(int i, Unit& u) const { if (i > 0) return false; u.pm = pm; u.pn = pn; return true; }
    __device__ __forceinline__ void a_ready(const Unit&) const {}
    __device__ __forceinline__ void done(const Unit&) const {} };
__device__ __forceinline__ unsigned cvt_pk_bf16(float lo, float hi) { unsigned r; asm volatile("v_cvt_pk_bf16_f32 %0, %1, %2" : "=v"(r) : "v"(lo), "v"(hi)); return r; }

__device__ __forceinline__ void rows_rstd(const float* RSS, int rowbase, int fq, float (&rs)[2][4]) {
    float part[2][4];
#pragma unroll
    for (int ai = 0; ai < 2; ++ai)
#pragma unroll
        for (int m = 0; m < 4; ++m) part[ai][m] = RSS[(size_t)fq * MT + rowbase + ai * HALF + m * 16];
#pragma unroll
    for (int ai = 0; ai < 2; ++ai)
#pragma unroll
        for (int m = 0; m < 4; ++m) { float ss = part[ai][m]; ss += __shfl_xor(ss, 16); ss += __shfl_xor(ss, 32); rs[ai][m] = rsqrtf(ss * (1.0f / DMODEL) + NORM_EPS); }
}

struct EpiInProj {
    static constexpr bool PERM = true, AFTER_DRAIN = false;
    bf16_t* P; const float* gq; const float* gk; const float* rope;
    const float* RSS; const float* cv;
    __device__ __forceinline__ void operator()(const f32x4 (&acc)[2][2][4][2], const Unit& u, int wr, int wc, int fr, int fq) const {
        asm volatile("" : "+v"(fr), "+v"(fq));
        const int pn = u.pn;
        int mode = 0;
        if (pn == 3 || pn == 4) mode = 1; else if (pn == 5) mode = (wc < 2) ? 2 : 0; else if (pn == 6) mode = 3;
        const int colbase = pn * 256 + 64 * wc + 8 * fq;
        const int bidx_ = (u.pm * BM < ML) ? ((u.pm * BM) >> 12) : 8;
        f32x4 cvv[2][2];
#pragma unroll
        for (int bj = 0; bj < 2; ++bj)
#pragma unroll
            for (int n = 0; n < 2; ++n) cvv[bj][n] = *(const f32x4*)(cv + (size_t)bidx_ * INC + pn * 256 + 128 * bj + 32 * wc + 8 * fq + 4 * n);
        float rsv[2][4]; rows_rstd(RSS, u.pm * BM + wr * 64 + fr, fq, rsv);
        float gv[2][2][4];
        if (mode == 1 || mode == 2) { const float* g = (mode == 1) ? gq : gk;
#pragma unroll
            for (int bj = 0; bj < 2; ++bj)
#pragma unroll
                for (int n = 0; n < 2; ++n) { const f32x4 t = *(const f32x4*)(g + 32 * bj + 8 * fq + 4 * n); gv[bj][n][0] = t[0]; gv[bj][n][1] = t[1]; gv[bj][n][2] = t[2]; gv[bj][n][3] = t[3]; } }
#pragma unroll
        for (int ai = 0; ai < 2; ++ai)
#pragma unroll
            for (int m = 0; m < 4; ++m) {
                const int row = u.pm * BM + ai * HALF + wr * 64 + m * 16 + fr;
                const float rs_ = rsv[ai][m];
                float v[2][2][4];
#pragma unroll
                for (int bj = 0; bj < 2; ++bj)
#pragma unroll
                    for (int n = 0; n < 2; ++n)
#pragma unroll
                        for (int j = 0; j < 4; ++j) v[bj][n][j] = acc[ai][bj][m][n][j] * rs_ + cvv[bj][n][j];
                if (mode == 1 || mode == 2) {
                    float ss = 0.f;
#pragma unroll
                    for (int bj = 0; bj < 2; ++bj)
#pragma unroll
                        for (int n = 0; n < 2; ++n)
#pragma unroll
                            for (int j = 0; j < 4; ++j) ss += v[bj][n][j] * v[bj][n][j];
                    ss += __shfl_xor(ss, 16); ss += __shfl_xor(ss, 32);
                    const float rstd = rsqrtf(ss * (1.0f / 64.0f) + NORM_EPS);
#pragma unroll
                    for (int bj = 0; bj < 2; ++bj)
#pragma unroll
                        for (int n = 0; n < 2; ++n)
#pragma unroll
                            for (int j = 0; j < 4; ++j) v[bj][n][j] = v[bj][n][j] * rstd * gv[bj][n][j];
                    if (row < ML) {
                        const int s = row & (SEQ - 1); const int pos = (fq < 2) ? (s >> 6) : (s & 63);
                        const float* rp = rope + (pos * 16 + (fq & 1) * 8) * 2;
#pragma unroll
                        for (int n = 0; n < 2; ++n) { const f32x4 c0 = *(const f32x4*)(rp + 8 * n), c1 = *(const f32x4*)(rp + 8 * n + 4);
                            const float cs[4] = {c0[0], c0[2], c1[0], c1[2]}, sn[4] = {c0[1], c0[3], c1[1], c1[3]};
#pragma unroll
                            for (int j = 0; j < 4; ++j) { const float x1 = v[0][n][j], x2 = v[1][n][j]; v[0][n][j] = x1 * cs[j] - x2 * sn[j]; v[1][n][j] = x1 * sn[j] + x2 * cs[j]; } }
                    }
                }
                if (mode == 1 || mode == 3) {
#pragma unroll
                    for (int bj = 0; bj < 2; ++bj)
#pragma unroll
                        for (int n = 0; n < 2; ++n)
#pragma unroll
                            for (int j = 0; j < 4; ++j) v[bj][n][j] *= QSCALE;
                }
                bf16_t* rowp = P + (size_t)row * INC + colbase;
#pragma unroll
                for (int bj = 0; bj < 2; ++bj) { u32x4 w; w.x = cvt_pk_bf16(v[bj][0][0], v[bj][0][1]); w.y = cvt_pk_bf16(v[bj][0][2], v[bj][0][3]); w.z = cvt_pk_bf16(v[bj][1][0], v[bj][1][1]); w.w = cvt_pk_bf16(v[bj][1][2], v[bj][1][3]);
                    *(u32x4*)(rowp + 32 * bj) = w; }
            }
    }
};

struct EpiResid {
    static constexpr bool PERM = true, AFTER_DRAIN = false;
    const float* rin_l; const float* rin_c; float* rout_l; float* rout_c; const float* gate;
    bf16_t* XNo; float* RSS; const float* gnext; const float* scnext; int wantA;
    PG8_LAS float* xs;
    __device__ __forceinline__ void operator()(const f32x4 (&acc)[2][2][4][2], const Unit& u, int wr, int wc, int fr, int fq) const {
        asm volatile("" : "+v"(fr), "+v"(fq));
        const int row0 = u.pm * BM; const bool lat = row0 < ML;
        const int bidx = lat ? (row0 >> 12) : 8;
        const float* rin = lat ? rin_l : rin_c - (size_t)ML * DMODEL; float* rout = lat ? rout_l : rout_c - (size_t)ML * DMODEL;
        const int col0 = u.pn * BM + wc * 32 + 8 * fq;
        f32x4 gt[2][2], gs[2][2];
#pragma unroll
        for (int bj = 0; bj < 2; ++bj)
#pragma unroll
            for (int n = 0; n < 2; ++n) { gt[bj][n] = *(const f32x4*)(gate + (size_t)bidx * MODW + col0 + bj * HALF + 4 * n);
                if (wantA) gs[bj][n] = *(const f32x4*)(gnext + col0 + bj * HALF + 4 * n) * (*(const f32x4*)(scnext + (size_t)bidx * MODW + col0 + bj * HALF + 4 * n) + 1.0f);
                else gs[bj][n] = (f32x4){0.f, 0.f, 0.f, 0.f}; }
#pragma unroll
        for (int ai = 0; ai < 2; ++ai)
#pragma unroll
            for (int mp2 = 0; mp2 < 2; ++mp2) {
                f32x4 xi[2][2][2];
#pragma unroll
                for (int q = 0; q < 2; ++q) { const size_t ro = (size_t)(row0 + ai * HALF + wr * 64 + (2 * mp2 + q) * 16 + fr) * DMODEL + col0;
#pragma unroll
                    for (int bj = 0; bj < 2; ++bj)
#pragma unroll
                        for (int n = 0; n < 2; ++n) xi[q][bj][n] = *(const f32x4*)(rin + ro + bj * HALF + 4 * n); }
#pragma unroll
                for (int q = 0; q < 2; ++q) { const int m = 2 * mp2 + q; const int row = row0 + ai * HALF + wr * 64 + m * 16 + fr; const size_t ro = (size_t)row * DMODEL + col0;
                    float ss = 0.f;
#pragma unroll
                    for (int bj = 0; bj < 2; ++bj) { f32x4 xn[2];
#pragma unroll
                        for (int n = 0; n < 2; ++n) { xn[n] = xi[q][bj][n] + gt[bj][n] * acc[ai][bj][m][n];
                            *(f32x4*)(rout + ro + bj * HALF + 4 * n) = xn[n];
                            ss += (xn[n][0] * xn[n][0] + xn[n][1] * xn[n][1]) + (xn[n][2] * xn[n][2] + xn[n][3] * xn[n][3]); }
                        if (wantA) { const f32x4 a0 = xn[0] * gs[bj][0], a1 = xn[1] * gs[bj][1];
                            u32x4 w; w.x = cvt_pk_bf16(a0[0], a0[1]); w.y = cvt_pk_bf16(a0[2], a0[3]); w.z = cvt_pk_bf16(a1[0], a1[1]); w.w = cvt_pk_bf16(a1[2], a1[3]);
                            *(u32x4*)(XNo + ro + bj * HALF) = w; } }
                    if (wantA) { ss += __shfl_xor(ss, 16); ss += __shfl_xor(ss, 32);
                        if (fq == 0) xs[(ai * HALF + wr * 64 + m * 16 + fr) * 4 + wc] = ss; } } }
        if (wantA) {
            asm volatile("s_waitcnt lgkmcnt(0)\n\ts_barrier" ::: "memory");
            const int t = (wr * 4 + wc) * 64 + fq * 16 + fr;
            if (t < 256) { const f32x4 p = *(const PG8_LAS f32x4*)(xs + 4 * t); RSS[(size_t)u.pn * MT + row0 + t] = (p[0] + p[1]) + (p[2] + p[3]); }
        }
    }
};

struct EpiSwiglu {
    static constexpr bool PERM = true, AFTER_DRAIN = false;
    bf16_t* ACT; const float* RSS; const float* cv;
    __device__ __forceinline__ void operator()(const f32x4 (&acc)[2][2][4][2], const Unit& u, int wr, int wc, int fr, int fq) const {
        asm volatile("" : "+v"(fr), "+v"(fq));
        const int col0 = u.pn * HALF + wc * 32 + 8 * fq;
        const int bidx_ = (u.pm * BM < ML) ? ((u.pm * BM) >> 12) : 8;
        f32x4 cvv[2][2];
#pragma unroll
        for (int bj = 0; bj < 2; ++bj)
#pragma unroll
            for (int n = 0; n < 2; ++n) cvv[bj][n] = *(const f32x4*)(cv + (size_t)bidx_ * (2 * FFH) + u.pn * 256 + 128 * bj + 32 * wc + 8 * fq + 4 * n);
        float rsv[2][4]; rows_rstd(RSS, u.pm * BM + wr * 64 + fr, fq, rsv);
#pragma unroll
        for (int ai = 0; ai < 2; ++ai)
#pragma unroll
            for (int m = 0; m < 4; ++m) { const int row = u.pm * BM + ai * HALF + wr * 64 + m * 16 + fr;
                const float rs_ = rsv[ai][m];
                float o[2][4];
#pragma unroll
                for (int n = 0; n < 2; ++n)
#pragma unroll
                    for (int j = 0; j < 4; ++j) { const float g = acc[ai][0][m][n][j] * rs_ + cvv[0][n][j], uu = acc[ai][1][m][n][j] * rs_ + cvv[1][n][j];
                        o[n][j] = g * __builtin_amdgcn_rcpf(1.0f + __expf(-g)) * uu; }
                u32x4 w; w.x = cvt_pk_bf16(o[0][0], o[0][1]); w.y = cvt_pk_bf16(o[0][2], o[0][3]); w.z = cvt_pk_bf16(o[1][0], o[1][1]); w.w = cvt_pk_bf16(o[1][2], o[1][3]);
                *(u32x4*)(ACT + (size_t)row * FFH + col0) = w; }
    }
};

template <class Epi, class Sched, bool ALIGN_EPI = false, bool SP2 = false>
__device__ __forceinline__ void gemm_phase(PG8_LAS unsigned char* lds, const Gemm g, const Sched& S, const Epi& E) {
    int tid_o = threadIdx.x; asm volatile("" : "+v"(tid_o));
    const int tid = tid_o, wid = __builtin_amdgcn_readfirstlane(tid >> 6), lane = tid & 63, wr = wid >> 2, wc = wid & 3, fr = lane & 15, fq = lane >> 4;
    const int K = g.K, nt = K / BK;
    unsigned voffA[2], voffB[2];
#pragma unroll
    for (int i = 0; i < 2; ++i) { int R, C; stage_rc(tid * 16 + i * 8192, R, C); const int Rb = Epi::PERM ? ((R & ~31) + perm32(R & 31)) : R;
        voffA[i] = (unsigned)(R * K + C) * 2u; voffB[i] = (unsigned)(Rb * K + C) * 2u; }
    const size_t kstep = (size_t)(BK * 2);
    const size_t hstep = (size_t)HALF * K * 2;
    const size_t tstep = 2 * hstep;
    const unsigned ldsw = (unsigned)wid * 1024u;
    const int aoff = lds_byte(wr * 64 + fr, fq * 8), boff = lds_byte(wc * 32 + fr, fq * 8);
#define PG8_SA(b, h) (((b) * 2 + (h)) * HTB)
#define PG8_SB(b, h) ((4 + (b) * 2 + (h)) * HTB)
#define PG8_STAGE(bufoff, gbase, voff) do { _Pragma("unroll") for (int _i = 0; _i < 2; ++_i) \
        __builtin_amdgcn_global_load_lds((const unsigned*)((const char*)(gbase) + (voff)[_i]), (PG8_LAS unsigned*)(lds + (bufoff) + ldsw + _i * 8192), 16, 0, 0); } while (0)
#define PG8_LDA(dst, b, h) do { _Pragma("unroll") for (int m = 0; m < 4; ++m) _Pragma("unroll") for (int k = 0; k < 2; ++k) dst[m][k] = *(const PG8_LAS bf16x8*)(lds + PG8_SA(b, h) + aoff + m * 2048 + k * 1024); } while (0)
#define PG8_LDB(dst, b, h) do { _Pragma("unroll") for (int n = 0; n < 2; ++n) _Pragma("unroll") for (int k = 0; k < 2; ++k) dst[n][k] = *(const PG8_LAS bf16x8*)(lds + PG8_SB(b, h) + boff + n * 2048 + k * 1024); } while (0)
#define PG8_MMA(ai, bj, At, Bt) do { __builtin_amdgcn_s_setprio(1); _Pragma("unroll") for (int m = 0; m < 4; ++m) _Pragma("unroll") for (int n = 0; n < 2; ++n) _Pragma("unroll") for (int k = 0; k < 2; ++k) \
        acc[ai][bj][m][n] = __builtin_amdgcn_mfma_f32_16x16x32_bf16(Bt[n][k], At[m][k], acc[ai][bj][m][n], 0, 0, 0); __builtin_amdgcn_s_setprio(0); } while (0)
#define PG8_WAIT_V(n) asm volatile("s_waitcnt vmcnt(" #n ")" ::: "memory")
#define PG8_WAIT_L(n) asm volatile("s_waitcnt lgkmcnt(" #n ")" ::: "memory")
#define PG8_BAR __builtin_amdgcn_s_barrier()
#define PG8_SCHED __builtin_amdgcn_sched_barrier(0)
    Unit cur, nxt; int ui = 0;
    if (!S.next(0, cur)) return;
    f32x4 acc[2][2][4][2];
#pragma unroll
    for (int a = 0; a < 2; ++a)
#pragma unroll
        for (int b = 0; b < 2; ++b)
#pragma unroll
            for (int m = 0; m < 4; ++m)
#pragma unroll
                for (int n = 0; n < 2; ++n) acc[a][b][m][n] = (f32x4){0.f, 0.f, 0.f, 0.f};
    bf16x8 At[4][2], B0[2][2], B1[2][2];
    const char* cA = (const char*)g.A + (size_t)cur.pm * tstep; const char* cB = (const char*)g.Bt + (size_t)cur.pn * tstep;
    S.a_ready(cur);
    if constexpr (SP2) {
        PG8_STAGE(PG8_SB(0, 0), cB, voffB); PG8_STAGE(PG8_SB(0, 1), cB + hstep, voffB); PG8_STAGE(PG8_SA(0, 0), cA, voffA); PG8_STAGE(PG8_SA(0, 1), cA + hstep, voffA);
        if (wr == 1) PG8_BAR;
        PG8_WAIT_V(2); PG8_BAR;
        PG8_STAGE(PG8_SB(1, 0), cB + kstep, voffB); PG8_STAGE(PG8_SA(1, 0), cA + kstep, voffA); PG8_STAGE(PG8_SB(1, 1), cB + hstep + kstep, voffB);
        PG8_WAIT_V(6); PG8_BAR;
    } else {
        PG8_STAGE(PG8_SB(0, 0), cB, voffB); PG8_STAGE(PG8_SA(0, 0), cA, voffA); PG8_STAGE(PG8_SB(0, 1), cB + hstep, voffB); PG8_STAGE(PG8_SA(0, 1), cA + hstep, voffA);
        if (wr == 1) PG8_BAR;
        PG8_WAIT_V(4); PG8_BAR;
        PG8_STAGE(PG8_SB(1, 0), cB + kstep, voffB); PG8_STAGE(PG8_SA(1, 0), cA + kstep, voffA); PG8_STAGE(PG8_SB(1, 1), cB + hstep + kstep, voffB);
        PG8_WAIT_V(6); PG8_BAR;
    }
    for (;;) {
        const bool has_next = S.next(ui + 1, nxt);
        const char* nA = has_next ? (const char*)g.A + (size_t)nxt.pm * tstep : cA; const char* nB = has_next ? (const char*)g.Bt + (size_t)nxt.pn * tstep : cB;
        for (int t = 0; t < nt; t += 2) {
            const bool last = (t == nt - 2);
            const char* a1 = cA + (size_t)(t + 1) * kstep;
            const char* a2 = last ? nA : cA + (size_t)(t + 2) * kstep; const char* b2 = last ? nB : cB + (size_t)(t + 2) * kstep;
            const char* a3 = a2 + kstep; const char* b3 = b2 + kstep;
            if (last && has_next) S.a_ready(nxt);
            if constexpr (SP2) {
            PG8_LDB(B0, 0, 0); PG8_LDB(B1, 0, 1); PG8_SCHED; PG8_LDA(At, 0, 0); PG8_STAGE(PG8_SA(1, 1), a1 + hstep, voffA);
            PG8_WAIT_V(8); PG8_WAIT_L(0); PG8_BAR; PG8_MMA(0, 0, At, B0); PG8_MMA(0, 1, At, B1); PG8_BAR; PG8_SCHED;
            PG8_LDA(At, 0, 1); PG8_STAGE(PG8_SB(0, 0), b2, voffB); PG8_STAGE(PG8_SB(0, 1), b2 + hstep, voffB); PG8_STAGE(PG8_SA(0, 0), a2, voffA);
            PG8_WAIT_V(8); PG8_WAIT_L(0); PG8_BAR; PG8_MMA(1, 0, At, B0); PG8_MMA(1, 1, At, B1); PG8_BAR; PG8_SCHED;
            PG8_LDB(B0, 1, 0); PG8_LDB(B1, 1, 1); PG8_SCHED; PG8_LDA(At, 1, 0); PG8_STAGE(PG8_SA(0, 1), a2 + hstep, voffA);
            PG8_WAIT_V(8); PG8_WAIT_L(0); PG8_BAR; PG8_MMA(0, 0, At, B0); PG8_MMA(0, 1, At, B1); PG8_BAR; PG8_SCHED;
            PG8_LDA(At, 1, 1); PG8_STAGE(PG8_SB(1, 0), b3, voffB); PG8_STAGE(PG8_SB(1, 1), b3 + hstep, voffB); PG8_STAGE(PG8_SA(1, 0), a3, voffA);
            PG8_WAIT_V(8); PG8_WAIT_L(0); PG8_BAR; PG8_MMA(1, 0, At, B0); PG8_MMA(1, 1, At, B1); PG8_BAR; PG8_SCHED;
            } else {
            PG8_LDB(B0, 0, 0); PG8_SCHED; PG8_LDA(At, 0, 0); PG8_STAGE(PG8_SA(1, 1), a1 + hstep, voffA);
            PG8_WAIT_L(8); PG8_BAR; PG8_WAIT_L(0); PG8_MMA(0, 0, At, B0); PG8_BAR; PG8_SCHED;
            PG8_LDB(B1, 0, 1); PG8_STAGE(PG8_SB(0, 0), b2, voffB);
            PG8_BAR; PG8_WAIT_L(0); PG8_MMA(0, 1, At, B1); PG8_BAR;
            PG8_LDA(At, 0, 1); PG8_STAGE(PG8_SA(0, 0), a2, voffA);
            PG8_BAR; PG8_WAIT_L(0); PG8_MMA(1, 0, At, B0); PG8_BAR; PG8_SCHED;
            PG8_STAGE(PG8_SB(0, 1), b2 + hstep, voffB);
            PG8_WAIT_V(6); PG8_BAR; PG8_MMA(1, 1, At, B1); PG8_BAR;
            PG8_LDB(B0, 1, 0); PG8_SCHED; PG8_LDA(At, 1, 0); PG8_STAGE(PG8_SA(0, 1), a2 + hstep, voffA);
            PG8_WAIT_L(8); PG8_BAR; PG8_WAIT_L(0); PG8_MMA(0, 0, At, B0); PG8_BAR; PG8_SCHED;
            PG8_LDB(B1, 1, 1); PG8_STAGE(PG8_SB(1, 0), b3, voffB);
            PG8_BAR; PG8_WAIT_L(0); PG8_MMA(0, 1, At, B1); PG8_BAR;
            PG8_LDA(At, 1, 1); PG8_STAGE(PG8_SA(1, 0), a3, voffA);
            PG8_BAR; PG8_WAIT_L(0); PG8_MMA(1, 0, At, B0); PG8_BAR; PG8_SCHED;
            PG8_STAGE(PG8_SB(1, 1), b3 + hstep, voffB);
            PG8_WAIT_V(6); PG8_BAR; PG8_MMA(1, 1, At, B1); PG8_BAR;
            }
        }
        if constexpr (ALIGN_EPI) { if (wr == 0) PG8_BAR; }
        if constexpr (!Epi::AFTER_DRAIN) { E(acc, cur, wr, wc, fr, fq); S.done(cur); }
        if (!has_next) break;
#pragma unroll
        for (int a = 0; a < 2; ++a)
#pragma unroll
            for (int b = 0; b < 2; ++b)
#pragma unroll
                for (int m = 0; m < 4; ++m)
#pragma unroll
                    for (int n = 0; n < 2; ++n) acc[a][b][m][n] = (f32x4){0.f, 0.f, 0.f, 0.f};
        cur = nxt; cA = nA; cB = nB; ++ui;
        if constexpr (ALIGN_EPI) { if (wr == 1) PG8_BAR; }
    }
    PG8_WAIT_V(0);
    if constexpr (!ALIGN_EPI) { if (wr == 0) PG8_BAR; }
    PG8_BAR;
    if constexpr (Epi::AFTER_DRAIN) { E.fused(acc, cur, wr, wc, fr, fq, lds, wid, lane); S.done(cur); }
#undef PG8_SA
#undef PG8_SB
#undef PG8_STAGE
#undef PG8_LDA
#undef PG8_LDB
#undef PG8_MMA
#undef PG8_WAIT_V
#undef PG8_WAIT_L
#undef PG8_BAR
#undef PG8_SCHED
}
}

namespace attn_body {
using bf16=__hip_bfloat16;
using bf16x8=__attribute__((ext_vector_type(8)))short;
using s16x4=__attribute__((ext_vector_type(4)))short;
using f32x16=__attribute__((ext_vector_type(16)))float;
using u32x4=__attribute__((ext_vector_type(4)))unsigned;
constexpr int D=64, PP=2304, OP=1024;
constexpr int NW=8,QBLK=32,QB=QBLK*NW,KVBLK=64;
__device__ __forceinline__ int crow(int r,int hi){return (r&3)+8*(r>>2)+4*hi;}
#define SBAR() __builtin_amdgcn_sched_barrier(0)
__device__ __forceinline__ void cmask(f32x16&p0,f32x16&p1,int jb,int qrel,int hi){
  const float NEG=-INFINITY; int kb=64*jb+4*hi;
  #pragma unroll
  for(int r=0;r<16;++r){int kv=kb+(r&3)+8*(r>>2); if(kv>qrel)p0[r]=NEG; if(kv+32>qrel)p1[r]=NEG;}
}

constexpr int NSLOT=3, SLOTB=8192;
constexpr int LDS_K=0, LDS_V=NSLOT*SLOTB, LDS_WS=2*NSLOT*SLOTB, LDS_OST=LDS_WS+NW*64*4, LDS_BYTES=LDS_OST+NW*4096;
constexpr float C2=0.125f*1.4426950408889634f;

__device__ __forceinline__ void na_hook(f32x16&p0,f32x16&p1,int t,int r0,int qrow,int qcol,int hi,const float*bias){
  if(t<4)return;
  const float NEG=-INFINITY; const int kr=r0+t-4; int rs=qrow-4; rs=rs<0?0:(rs>56?56:rs);
  if(kr<rs||kr>rs+7){
    #pragma unroll
    for(int r=0;r<16;++r){p0[r]=NEG;p1[r]=NEG;}
    return; }
  int cs=qcol-8; cs=cs<0?0:(cs>48?48:cs);
  const float*bt=bias+(kr-qrow+7)*31+15-qcol;
  #pragma unroll
  for(int r=0;r<16;++r){ const int kc=(r&3)+8*(r>>2)+4*hi;
    const bool v0=(unsigned)(kc-cs)<16u, v1=(unsigned)(kc+32-cs)<16u;
    const float b0=v0?bt[kc]:0.f, b1=v1?bt[kc+32]:0.f;
    p0[r]=v0?p0[r]+b0:NEG; p1[r]=v1?p1[r]+b1:NEG; }
}
__device__ __forceinline__ void glds16(const void*gsrc,unsigned lds_dst){unsigned keep;
  asm volatile("s_mov_b32 %0, m0\n\ts_mov_b32 m0, %2\n\ts_nop 0\n\tglobal_load_lds_dwordx4 %1, off\n\ts_mov_b32 m0, %0":"=&s"(keep):"v"(gsrc),"s"(lds_dst):"memory");}
__device__ __forceinline__ float max3f(float a,float b,float c){float r;asm("v_max3_f32 %0, %1, %2, %3":"=v"(r):"v"(a),"v"(b),"v"(c));return r;}
__device__ __forceinline__ float max2f(float a,float b){float r;asm("v_max_f32_e32 %0, %1, %2":"=v"(r):"v"(a),"v"(b));return r;}
__device__ __forceinline__ float fadd_s(float a,float b){float r;asm("v_add_f32_e32 %0, %1, %2":"=v"(r):"v"(a),"v"(b));return r;}
__device__ __forceinline__ float fsub_s(float a,float b){float r;asm("v_sub_f32_e32 %0, %1, %2":"=v"(r):"v"(a),"v"(b));return r;}
typedef float f32x2_t __attribute__((ext_vector_type(2))); typedef __bf16 bf16x2_t __attribute__((ext_vector_type(2)));
__device__ __forceinline__ unsigned cvtpk_s(float lo,float hi){f32x2_t v={lo,hi};bf16x2_t b=__builtin_convertvector(v,bf16x2_t);return __builtin_bit_cast(unsigned,b);}
#define WAIT_BAR(N) asm volatile("s_waitcnt vmcnt(" #N ") lgkmcnt(0)\n\ts_barrier":::"memory")

__device__ __forceinline__ void qkt(f32x16&p0,f32x16&p1,const char*Kslot,const bf16x8*qr,const f32x16&negm,int r32,int hi){
  const char*kb=Kslot+hi*1024+r32*16;
  #pragma unroll
  for(int d0=0;d0<4;++d0){
    const bf16x8 b0=*reinterpret_cast<const bf16x8*>(kb+d0*2048);
    const bf16x8 b1=*reinterpret_cast<const bf16x8*>(kb+d0*2048+512);
    if(d0==0){p0=__builtin_amdgcn_mfma_f32_32x32x16_bf16(b0,qr[0],negm,0,0,0);p1=__builtin_amdgcn_mfma_f32_32x32x16_bf16(b1,qr[0],negm,0,0,0);}
    else{p0=__builtin_amdgcn_mfma_f32_32x32x16_bf16(b0,qr[d0],p0,0,0,0);p1=__builtin_amdgcn_mfma_f32_32x32x16_bf16(b1,qr[d0],p1,0,0,0);}}
}
typedef __attribute__((address_space(3))) const char* lds_cptr;
typedef short v4i16_t __attribute__((ext_vector_type(4)));
__device__ __forceinline__ void kload8(bf16x8*kf,lds_cptr kp){
  kf[0]=*(const __attribute__((address_space(3))) bf16x8*)(kp);      kf[1]=*(const __attribute__((address_space(3))) bf16x8*)(kp+512);
  kf[2]=*(const __attribute__((address_space(3))) bf16x8*)(kp+2048); kf[3]=*(const __attribute__((address_space(3))) bf16x8*)(kp+2560);
  kf[4]=*(const __attribute__((address_space(3))) bf16x8*)(kp+4096); kf[5]=*(const __attribute__((address_space(3))) bf16x8*)(kp+4608);
  kf[6]=*(const __attribute__((address_space(3))) bf16x8*)(kp+6144); kf[7]=*(const __attribute__((address_space(3))) bf16x8*)(kp+6656);
}
__device__ __forceinline__ void kload2(bf16x8*kf,lds_cptr kp,int j){ kf[2*j]=*(const __attribute__((address_space(3))) bf16x8*)(kp+j*2048); kf[2*j+1]=*(const __attribute__((address_space(3))) bf16x8*)(kp+j*2048+512); }
__device__ __forceinline__ s16x4 vtr(lds_cptr p){ return __builtin_bit_cast(s16x4,__builtin_amdgcn_ds_read_tr16_b64_v4i16((__attribute__((address_space(3))) v4i16_t*)p)); }
__device__ __forceinline__ float rowmax(const f32x16&p0,const f32x16&p1){
  float a=max3f(p0[0],p0[1],p1[0]),b=max3f(p0[2],p0[3],p1[1]);a=max3f(a,p1[2],p1[3]);
  #pragma unroll
  for(int r=4;r<16;r+=4){a=max3f(a,p0[r],p0[r+1]);b=max3f(b,p0[r+2],p0[r+3]);a=max3f(a,p1[r],p1[r+1]);b=max3f(b,p1[r+2],p1[r+3]);}
  const float m=max2f(a,b);
  auto rr=__builtin_amdgcn_permlane32_swap(__float_as_uint(m),__float_as_uint(m),false,false);
  return max2f(__uint_as_float(rr[0]),__uint_as_float(rr[1]));
}
__device__ __forceinline__ void pv(f32x16*o,int vb,bf16x8 pa0,bf16x8 pa1,bf16x8 pa2,bf16x8 pa3){
  #pragma unroll
  for(int d0=0;d0<2;++d0){s16x4 lo[4],hi[4];
    #pragma unroll
    for(int ks=0;ks<4;++ks){
      asm volatile("ds_read_b64_tr_b16 %0,%1 offset:%c2":"=&v"(lo[ks]):"v"(vb),"i"(d0*4096+ks*1024):"memory");
      asm volatile("ds_read_b64_tr_b16 %0,%1 offset:%c2":"=&v"(hi[ks]):"v"(vb),"i"(d0*4096+ks*1024+512):"memory");}
    asm volatile("s_waitcnt lgkmcnt(0)":::"memory");SBAR();
    #define PK(k) (bf16x8){lo[k][0],lo[k][1],lo[k][2],lo[k][3],hi[k][0],hi[k][1],hi[k][2],hi[k][3]}
    o[d0]=__builtin_amdgcn_mfma_f32_32x32x16_bf16(pa0,PK(0),o[d0],0,0,0);
    o[d0]=__builtin_amdgcn_mfma_f32_32x32x16_bf16(pa1,PK(1),o[d0],0,0,0);
    o[d0]=__builtin_amdgcn_mfma_f32_32x32x16_bf16(pa2,PK(2),o[d0],0,0,0);
    o[d0]=__builtin_amdgcn_mfma_f32_32x32x16_bf16(pa3,PK(3),o[d0],0,0,0);
    #undef PK
  }
}

#ifndef ATTN_STORE16
#define ATTN_STORE16(p,v) (*(u32x4*)(p)=(v))
#endif
template<int THRL,int MODE> __device__ __forceinline__ void attn_unit(const bf16*Qu,const bf16*__restrict__ Kb,const bf16*__restrict__ Vb,bf16*Ou,int krow_c,int krow_l,int tclamp,int NT,int na_r0,int na_qrow0,const float*na_bias,char*shm,float fixm=0.f){
  int tid_o=threadIdx.x; asm volatile("":"+v"(tid_o)); const int tid=tid_o,lane=tid&63,r32=lane&31,hi=lane>>5; const int wid=__builtin_amdgcn_readfirstlane(tid>>6);
  const bf16*Qw=Qu+(long)(wid*QBLK)*PP;
  const bf16*Kh=Kb,*Vh=Vb;
  #define KROW(t) (((t)<4)?(krow_c+64*(t)):(krow_l+64*(((t)-4)<tclamp?((t)-4):tclamp)))
  const unsigned lds0=(unsigned)(uintptr_t)shm;
  float*wsf=(float*)(shm+LDS_WS)+wid*64;
  const bf16*ksrc=Kh+(long)lane*PP+wid*8;
  const bf16*vsrc=Vh+(long)(16*(wid&3)+(lane>>2))*PP+(wid>>2)*32+(lane&3)*8;
  const unsigned kdst=lds0+LDS_K+wid*1024, vdst=lds0+LDS_V+wid*1024;
  #define DMA_K(t,slot) glds16(ksrc+(long)KROW(t)*PP,(unsigned)__builtin_amdgcn_readfirstlane(kdst+(slot)))
  #define DMA_V(t,slot) glds16(vsrc+(long)KROW(t)*PP,(unsigned)__builtin_amdgcn_readfirstlane(vdst+(slot)))
  const int vb0=(int)(lds0+LDS_V)+((lane>>4)&1)*32+(lane&3)*8+(4*hi+((lane&15)>>2))*64;
  const char*Kbase=shm+LDS_K; bf16x8 kf[8];
  const lds_cptr shm3=(lds_cptr)shm; const lds_cptr kp0=shm3+LDS_K+hi*1024+r32*16; const lds_cptr vp0=shm3+LDS_V+((lane>>4)&1)*32+(lane&3)*8+(4*hi+((lane&15)>>2))*64;
  DMA_K(0,0);DMA_V(0,0);DMA_K(1,SLOTB);
  bf16x8 qr[4];
  #pragma unroll
  for(int d0=0;d0<4;++d0)qr[d0]=*reinterpret_cast<const bf16x8*>(&Qw[(long)r32*PP+d0*16+hi*8]);
  float mhat=0.f,l_reg=0.f;f32x16 o[2];o[0]=f32x16{};o[1]=f32x16{};f32x16 negm=f32x16{};asm volatile("":"+v"(negm));
  const int na_qrow=na_qrow0+(wid>>1), na_qcol=32*(wid&1)+r32;
  #define CMASK(P0,P1,t) do{ if(MODE==1) na_hook(P0,P1,(t),na_r0,na_qrow,na_qcol,hi,na_bias); }while(0)
  bool resc=false;
  #define START(P0,P1) do{ const float rm=(MODE==2)?fixm:rowmax(P0,P1); resc=false; \
    { const float dl=rm; mhat=fadd_s(mhat,dl); \
      _Pragma("unroll") for(int r=0;r<16;++r){P0[r]=fsub_s(P0[r],dl);P1[r]=fsub_s(P1[r],dl);} \
      _Pragma("unroll") for(int r=0;r<16;++r)negm[r]=-mhat; asm volatile("":"+v"(negm)); } \
    _Pragma("unroll") for(int r=0;r<16;++r)P0[r]=__builtin_amdgcn_exp2f(P0[r]); }while(0)
  #define RESC() do{ if(resc){ asm volatile("s_waitcnt lgkmcnt(0)":::"memory"); \
      _Pragma("unroll") for(int d_=0;d_<2;++d_) _Pragma("unroll") for(int r=0;r<16;++r)o[d_][r]*=wsf[crow(r,hi)]; } }while(0)
  f32x16 pA0,pA1,pB0,pB1;
  int sl_prev=0,sl_cur=0,sl_next=SLOTB;
  #define ROT() do{sl_prev=sl_cur;sl_cur=sl_next;sl_next=(sl_next==(NSLOT-1)*SLOTB)?0:sl_next+SLOTB;}while(0)
  DMA_K(2,2*SLOTB);
  WAIT_BAR(3);
  qkt(pA0,pA1,Kbase,qr,negm,r32,hi);asm volatile("s_nop 15\n\ts_nop 7":"+v"(pA0),"+v"(pA1));CMASK(pA0,pA1,0);
  START(pA0,pA1);
  _Pragma("unroll") for(int r=0;r<16;++r)pA1[r]=__builtin_amdgcn_exp2f(pA1[r]);
  WAIT_BAR(0);
  DMA_K(3,0);DMA_V(1,SLOTB);
  ROT();
  kload8(kf,kp0+sl_cur);
  WAIT_BAR(2);
  s16x4 vlo[8],vhi[8]; u32x4 pw0,pw1,pw2,pw3;
  #define PKW(P,B) cvtpk_s(P[B],P[B+1])
  #define PAF(k) __builtin_bit_cast(bf16x8,pw##k)
  #define VFR(i) (bf16x8){vlo[i][0],vlo[i][1],vlo[i][2],vlo[i][3],vhi[i][0],vhi[i][1],vhi[i][2],vhi[i][3]}
  #define PIN(x) asm volatile("":"+v"(x))
  #define MX3(a,b,c) __builtin_fmaxf(__builtin_fmaxf((a),(b)),(c))
  #define GAPA(MF,A0,A1,A2,A3,W0,W1,PW) do{ MF; sacc2+=(f32x2_t){A0,A1}; sacc2+=(f32x2_t){A2,A3}; PIN(sacc2); W0; W1; PIN(PW); SBAR(); }while(0)
  #define EX(v) __builtin_amdgcn_exp2f(v)
  #define GAPB(MF,X,B) do{ MF; X[B]=EX(X[B]); X[B+1]=EX(X[B+1]); X[B+2]=EX(X[B+2]); X[B+3]=EX(X[B+3]); PIN(X); SBAR(); }while(0)
  #define VRD(i) do{ vlo[i]=vtr(vp_+(((i)>>2)*4096+((i)&3)*1024)); vhi[i]=vtr(vp_+(((i)>>2)*4096+((i)&3)*1024+512)); }while(0)
  #define KRD(G,j) do{ if(G){ kload2(kf,kp0+sl_next,j); SBAR(); } }while(0)
  #define STEP(C0,C1,P0,P1,t,GK,GV,GL) do{ SBAR(); \
    const lds_cptr vp_=vp0+sl_prev; \
    VRD(0); SBAR(); f32x2_t sacc2={P0[0],P0[1]}; \
    GAPA(C0=__builtin_amdgcn_mfma_f32_32x32x16_bf16(kf[0],qr[0],negm,0,0,0), P0[2],P0[3],P0[4],P0[5],     pw0[0]=PKW(P0,0), pw0[1]=PKW(P0,2), pw0); \
    VRD(4); SBAR(); GAPA(C1=__builtin_amdgcn_mfma_f32_32x32x16_bf16(kf[1],qr[0],negm,0,0,0), P0[6],P0[7],P0[8],P0[9],     pw0[2]=PKW(P0,4), pw0[3]=PKW(P0,6), pw0); \
    VRD(1); SBAR(); GAPA(C0=__builtin_amdgcn_mfma_f32_32x32x16_bf16(kf[2],qr[1],C0,0,0,0),   P0[10],P0[11],P0[12],P0[13], pw1[0]=PKW(P0,8), pw1[1]=PKW(P0,10), pw1); \
    VRD(5); SBAR(); GAPA(C1=__builtin_amdgcn_mfma_f32_32x32x16_bf16(kf[3],qr[1],C1,0,0,0),   P0[14],P0[15],P1[0],P1[1],   pw1[2]=PKW(P0,12),pw1[3]=PKW(P0,14), pw1); \
    VRD(2); SBAR(); GAPA(C0=__builtin_amdgcn_mfma_f32_32x32x16_bf16(kf[4],qr[2],C0,0,0,0),   P1[2],P1[3],P1[4],P1[5],     pw2[0]=PKW(P1,0), pw2[1]=PKW(P1,2), pw2); \
    VRD(6); SBAR(); GAPA(C1=__builtin_amdgcn_mfma_f32_32x32x16_bf16(kf[5],qr[2],C1,0,0,0),   P1[6],P1[7],P1[8],P1[9],     pw2[2]=PKW(P1,4), pw2[3]=PKW(P1,6), pw2); \
    VRD(3); SBAR(); GAPA(C0=__builtin_amdgcn_mfma_f32_32x32x16_bf16(kf[6],qr[3],C0,0,0,0),   P1[10],P1[11],P1[12],P1[13], pw3[0]=PKW(P1,8), pw3[1]=PKW(P1,10), pw3); \
    VRD(7); SBAR(); GAPA(C1=__builtin_amdgcn_mfma_f32_32x32x16_bf16(kf[7],qr[3],C1,0,0,0),   P1[14],P1[15],0.f,0.f,       pw3[2]=PKW(P1,12),pw3[3]=PKW(P1,14), pw3); \
    l_reg+=(sacc2[0]+sacc2[1]); \
    if(GK){DMA_K((t)+3,sl_cur);} if(GV){DMA_V((t)+1,sl_next);} \
    CMASK(C0,C1,t); \
    resc=false; if(MODE!=2){ float a=MX3(C0[0],C0[1],C1[0]),b=MX3(C0[2],C0[3],C1[1]); a=MX3(a,C1[2],C1[3]); \
      _Pragma("unroll") for(int r=4;r<16;r+=4){a=MX3(a,C0[r],C0[r+1]);b=MX3(b,C0[r+2],C0[r+3]);a=MX3(a,C1[r],C1[r+1]);b=MX3(b,C1[r+2],C1[r+3]);} \
      float rm=__builtin_fmaxf(a,b); { auto rr=__builtin_amdgcn_permlane32_swap(__float_as_uint(rm),__float_as_uint(rm),false,false); rm=__builtin_fmaxf(__uint_as_float(rr[0]),__uint_as_float(rr[1])); } \
      resc=false; \
      if(__builtin_expect(__any(rm>(float)THRL),0)){ const float dl=__builtin_fmaxf(rm,0.f); mhat+=dl; \
        _Pragma("unroll") for(int r=0;r<16;++r){C0[r]-=dl;C1[r]-=dl;} \
        _Pragma("unroll") for(int r=0;r<16;++r)negm[r]=-mhat; asm volatile("":"+v"(negm)); \
        const float f=__builtin_amdgcn_exp2f(-dl); l_reg*=f; if(hi==0)wsf[r32]=f; resc=true; } } \
    SBAR(); \
    GAPB(o[0]=__builtin_amdgcn_mfma_f32_32x32x16_bf16(PAF(0),VFR(0),o[0],0,0,0), C0,0); \
    GAPB(o[1]=__builtin_amdgcn_mfma_f32_32x32x16_bf16(PAF(0),VFR(4),o[1],0,0,0), C0,4); \
    KRD(GL,0); GAPB(o[0]=__builtin_amdgcn_mfma_f32_32x32x16_bf16(PAF(1),VFR(1),o[0],0,0,0), C0,8); \
    KRD(GL,1); GAPB(o[1]=__builtin_amdgcn_mfma_f32_32x32x16_bf16(PAF(1),VFR(5),o[1],0,0,0), C0,12); \
    KRD(GL,2); GAPB(o[0]=__builtin_amdgcn_mfma_f32_32x32x16_bf16(PAF(2),VFR(2),o[0],0,0,0), C1,0); \
    KRD(GL,3); GAPB(o[1]=__builtin_amdgcn_mfma_f32_32x32x16_bf16(PAF(2),VFR(6),o[1],0,0,0), C1,4); \
    GAPB(o[0]=__builtin_amdgcn_mfma_f32_32x32x16_bf16(PAF(3),VFR(3),o[0],0,0,0), C1,8); \
    GAPB(o[1]=__builtin_amdgcn_mfma_f32_32x32x16_bf16(PAF(3),VFR(7),o[1],0,0,0), C1,12); \
    }while(0)
  int t=1;
  for(;t+5<NT;t+=2){
    STEP(pB0,pB1,pA0,pA1,t,true,true,true);     WAIT_BAR(2); RESC(); ROT();
    STEP(pA0,pA1,pB0,pB1,t+1,true,true,true);   WAIT_BAR(2); RESC(); ROT();
  }
  #define ENDW(tt) do{ if((tt)+3<NT){WAIT_BAR(2);} else if((tt)+2<NT){WAIT_BAR(1);} else {WAIT_BAR(0);} }while(0)
  for(;t+1<NT;t+=2){
    STEP(pB0,pB1,pA0,pA1,t,(t+3<NT),(t+1<NT),(t+1<NT));       ENDW(t);   RESC(); ROT();
    STEP(pA0,pA1,pB0,pB1,t+1,(t+4<NT),(t+2<NT),(t+2<NT));     ENDW(t+1); RESC(); ROT();
  }
  STEP(pB0,pB1,pA0,pA1,NT-1,false,false,false); RESC();
  { float sacc=pB0[0]+pB0[1]; _Pragma("unroll") for(int r=2;r<16;++r)sacc+=pB0[r]; _Pragma("unroll") for(int r=0;r<16;++r)sacc+=pB1[r]; l_reg+=sacc;
    pw0=(u32x4){PKW(pB0,0),PKW(pB0,2),PKW(pB0,4),PKW(pB0,6)};pw1=(u32x4){PKW(pB0,8),PKW(pB0,10),PKW(pB0,12),PKW(pB0,14)};pw2=(u32x4){PKW(pB1,0),PKW(pB1,2),PKW(pB1,4),PKW(pB1,6)};pw3=(u32x4){PKW(pB1,8),PKW(pB1,10),PKW(pB1,12),PKW(pB1,14)};
    SBAR(); pv(o,vb0+sl_cur,PAF(0),PAF(1),PAF(2),PAF(3)); }
  #undef PKW
  #undef PAF
  #undef VFR
  #undef PIN
  #undef MX3
  #undef GAPA
  #undef GAPB
  #undef EX
  #undef VRD
  #undef KRD
  #undef STEP
  #undef ENDW
  {auto rr=__builtin_amdgcn_permlane32_swap(__float_as_uint(l_reg),__float_as_uint(l_reg),false,false);l_reg=__uint_as_float(rr[0])+__uint_as_float(rr[1]);}
  if(hi==0)wsf[32+r32]=l_reg;asm volatile("s_waitcnt lgkmcnt(0)":::"memory");
  float rli[16];
  #pragma unroll
  for(int r=0;r<16;++r)rli[r]=__builtin_amdgcn_rcpf(wsf[32+crow(r,hi)]);
  bf16*Ow=Ou+(long)(wid*QBLK)*OP;
  { bf16*stg=(bf16*)(shm+LDS_OST)+wid*2048;
    #pragma unroll
    for(int r=0;r<16;++r){const int orow=crow(r,hi);
      #pragma unroll
      for(int d0=0;d0<2;++d0)stg[orow*64+d0*32+r32]=__float2bfloat16(o[d0][r]*rli[r]);}
    asm volatile("s_waitcnt lgkmcnt(0)":::"memory");
    #pragma unroll
    for(int i=0;i<4;++i){const int row=i*8+(lane>>3),ch=lane&7; const u32x4 v=*(const u32x4*)(stg+row*64+ch*8); ATTN_STORE16(Ow+(long)row*OP+ch*8,v);} }
  asm volatile("s_waitcnt lgkmcnt(0)\n\ts_barrier":::"memory");
  #undef DMA_K
  #undef KROW
  #undef DMA_V
  #undef CMASK
  #undef START
  #undef RESC
  #undef ROT
}
#undef SBAR
#undef WAIT_BAR
}

#define XB_TMO      128
#define XB_XCNT(j)  (256  + 64 * (j))
#define XB_XSUB(j)  (1280 + 64 * (j))
#define XB_XGEN(j)  (2304 + 64 * (j))
#define XB_TOP      3328
#define XB_TOPGEN   3392
#define XCD_BAR_WORDS 3456
#define XB_SPIN_CAP (1u << 18)

__device__ __forceinline__ unsigned xb_ld(unsigned* p)              { return __hip_atomic_load(p, __ATOMIC_RELAXED, __HIP_MEMORY_SCOPE_AGENT); }
__device__ __forceinline__ unsigned xb_add(unsigned* p, unsigned v) { return __hip_atomic_fetch_add(p, v, __ATOMIC_RELAXED, __HIP_MEMORY_SCOPE_AGENT); }
__device__ __forceinline__ unsigned xb_xcc_id() { return (unsigned)__builtin_amdgcn_s_getreg((3 << 11) | 20) & 0xFu; }
#define XB_SPIN(cond, bar) do { unsigned _sp = 0; while (cond) { __builtin_amdgcn_s_sleep(1); \
    if ((++_sp & 255u) == 0u) { if (xb_ld(&(bar)[XB_TMO])) break; if (_sp > XB_SPIN_CAP) { atomicAdd(&(bar)[XB_TMO], 1u); break; } } } } while (0)

struct XcdBarrier {
    unsigned* bar; unsigned x;
    volatile LAS unsigned* st;
};

__device__ __forceinline__ XcdBarrier xcd_barrier_post(unsigned* bar, volatile LAS unsigned* st) {
    XcdBarrier b; b.bar = bar; b.x = xb_xcc_id(); b.st = st;
    if (threadIdx.x == 0) (void)xb_add(&bar[XB_XCNT(b.x)], 1u);
    return b;
}
__device__ __forceinline__ void xcd_barrier_complete(unsigned* bar, unsigned x, unsigned& nloc, unsigned& nx) {
    const unsigned G = gridDim.x * gridDim.y * gridDim.z;
    unsigned sum, cnt, mine, sp = 0u;
    for (;;) {
        sum = 0u; cnt = 0u; mine = 0u;
#pragma unroll
        for (unsigned j = 0; j < 16; ++j) { const unsigned c = xb_ld(&bar[XB_XCNT(j)]); sum += c; cnt += (c > 0u) ? 1u : 0u; mine = (j == x) ? c : mine; }
        if (sum == G) break;
        __builtin_amdgcn_s_sleep(1);
        if ((++sp & 255u) == 0u) { if (xb_ld(&bar[XB_TMO])) break; if (sp > XB_SPIN_CAP) { atomicAdd(&bar[XB_TMO], 1u); break; } }
    }
    nloc = mine > 0u ? mine : 1u; nx = cnt > 0u ? cnt : 1u;
}

__device__ __forceinline__ void xcd_barrier(const XcdBarrier& b) {
    asm volatile("s_waitcnt vmcnt(0)" ::: "memory");
    __syncthreads();
    if (threadIdx.x == 0) {
        unsigned* bar = b.bar;
        __builtin_amdgcn_s_waitcnt(0);
        unsigned nloc = b.st[0], nx = b.st[1];
        if (nloc == 0u) { xcd_barrier_complete(bar, b.x, nloc, nx); b.st[0] = nloc; b.st[1] = nx; }
        const unsigned old = xb_add(&bar[XB_XSUB(b.x)], 1u);
        const unsigned gen = old / nloc;
        if (old + 1u == (gen + 1u) * nloc) {
            __builtin_amdgcn_fence(__ATOMIC_RELEASE, "agent");
            asm volatile("s_waitcnt vmcnt(0)" ::: "memory");
            const unsigned og = xb_add(&bar[XB_TOP], 1u);
            const unsigned tg = og / nx;
            if (og + 1u == (tg + 1u) * nx) xb_add(&bar[XB_TOPGEN], 1u);
            else XB_SPIN(xb_ld(&bar[XB_TOPGEN]) == tg, bar);
            __builtin_amdgcn_fence(__ATOMIC_ACQUIRE, "agent");
            xb_add(&bar[XB_XGEN(b.x)], 1u);
            asm volatile("s_waitcnt vmcnt(0)" ::: "memory");
        } else {
            XB_SPIN(xb_ld(&bar[XB_XGEN(b.x)]) == gen, bar);
            __builtin_amdgcn_fence(__ATOMIC_ACQUIRE, "agent");
            asm volatile("s_waitcnt vmcnt(0)" ::: "memory");
        }
    }
    __syncthreads();
}

__device__ __forceinline__ void sb_arrive(unsigned* ctr, int tid) {
    asm volatile("s_waitcnt vmcnt(0)" ::: "memory");
    __syncthreads();
    if (tid == 0) { __builtin_amdgcn_fence(__ATOMIC_RELEASE, "agent"); asm volatile("s_waitcnt vmcnt(0)" ::: "memory"); (void)xb_add(ctr, 1u); }
}
__device__ __forceinline__ void sb_wait(unsigned* ctr, unsigned need, unsigned* tmo, int tid) {
    if (tid == 0) { unsigned sp = 0u;
        while (xb_ld(ctr) < need) { __builtin_amdgcn_s_sleep(2); if (((++sp) & 1023u) == 0u) { if (xb_ld(tmo)) break; if (sp > (1u << 22)) { atomicAdd(tmo, 1u); break; } } }
        __builtin_amdgcn_fence(__ATOMIC_ACQUIRE, "agent"); asm volatile("s_waitcnt vmcnt(0)" ::: "memory"); }
    __syncthreads();
}

typedef unsigned short bf16_t;
constexpr size_t SZ_WIN = (size_t)INC * DMODEL * 2, SZ_WOUT = (size_t)DMODEL * DMODEL * 2, SZ_WFI = (size_t)2 * FFH * DMODEL * 2, SZ_WFO = (size_t)DMODEL * FFH * 2;
constexpr size_t WS_WIN = 0;
constexpr size_t WS_WOUT = WS_WIN + NLAY * SZ_WIN;
constexpr size_t WS_WFI = WS_WOUT + NLAY * SZ_WOUT;
constexpr size_t WS_WFO = WS_WFI + NLAY * SZ_WFI;
constexpr size_t WS_MOD = WS_WFO + NLAY * SZ_WFO;
constexpr size_t WS_ROPE = WS_MOD + (size_t)NLAY * 9 * MODW * 4;
constexpr size_t WS_HF = WS_ROPE + 64 * 16 * 2 * 4;
constexpr size_t WS_HC = WS_HF + (size_t)NLAY * 256 * 8192 * 2;
constexpr size_t WS_F = WS_HC + (size_t)NLAY * 256 * 512 * 4;
constexpr size_t WS_XN = WS_F + (size_t)256 * 8 * 1024 * 16;
constexpr size_t WS_P = WS_XN + (size_t)MT * DMODEL * 2;
constexpr size_t WS_MIX = WS_P + (size_t)MT * INC * 2;
constexpr size_t WS_XC = WS_MIX + (size_t)MT * DMODEL * 2;
constexpr size_t WS_UT = WS_XC + (size_t)MC * DMODEL * 4;
constexpr size_t WS_X2T = WS_UT + (size_t)NB * 256 * SEQ * 2;
constexpr size_t WS_CTL = WS_X2T + (size_t)NB * 256 * SEQ * 2;
constexpr size_t CTL_BYTES = 65536;
constexpr size_t WS_RSS = WS_CTL + CTL_BYTES;
constexpr size_t WS_CVI = WS_RSS + (size_t)4 * MT * 4;
constexpr size_t WS_CVF = WS_CVI + (size_t)NLAY * 9 * INC * 4;
constexpr size_t WS_YT = WS_CVF + (size_t)NLAY * 9 * 2 * FFH * 4;
constexpr size_t WS_ACTC = WS_YT + (size_t)NB * 256 * SEQ * 2;
constexpr size_t WS_END = WS_ACTC + (size_t)MC * FFH * 2;
static_assert(WS_END <= (size_t)4 * NB * SEQ * DMODEL * 4, "workspace must fit 4x the largest tensor");
static_assert((size_t)MT * FFH * 2 <= (size_t)MT * INC * 2 + (size_t)MT * DMODEL * 2, "ACT overlay");
static_assert(WS_ROPE % 256 == 0 && WS_HF % 256 == 0 && WS_F % 256 == 0 && WS_XN % 256 == 0 && WS_P % 256 == 0 && WS_MIX % 256 == 0 && WS_UT % 256 == 0, "alignment");

constexpr int LDS_BYTES = 147456;
constexpr int NA_BIAS_OFF = 98304;

struct KArgs { const float* in[27]; float* out; unsigned char* ws; };

__device__ __forceinline__ void transpose_item(const float* W, int N, int K, bf16_t* WT, int k0, int n0, int drow0, LAS float* scr, int lane) {
#pragma unroll 8
    for (int i = 0; i < 32; ++i) { const int kk = 2 * i + (lane >> 5); scr[kk * 33 + (lane & 31)] = W[(size_t)(k0 + kk) * N + n0 + (lane & 31)]; }
    asm volatile("s_waitcnt lgkmcnt(0)" ::: "memory");
    const int c = lane & 7;
#pragma unroll
    for (int j = 0; j < 4; ++j) { const int n = (lane >> 3) + 8 * j; const LAS float* s = scr + (8 * c) * 33 + n;
        v4u o; o.x = pk2(s[0 * 33], s[1 * 33]); o.y = pk2(s[2 * 33], s[3 * 33]); o.z = pk2(s[4 * 33], s[5 * 33]); o.w = pk2(s[6 * 33], s[7 * 33]);
        *(v4u*)(WT + (size_t)(drow0 + n) * K + k0 + 8 * c) = o; }
    asm volatile("s_waitcnt lgkmcnt(0)" ::: "memory");
}

__device__ __forceinline__ void norm_row(const float* xrow, const float* g, const float* shift, const float* scale, bf16_t* orow, int lane) {
    const f32x4v* xr = (const f32x4v*)xrow + lane;
    f32x4v v[4]; float s = 0.f;
#pragma unroll
    for (int j = 0; j < 4; ++j) { v[j] = xr[64 * j]; s += (v[j].x * v[j].x + v[j].y * v[j].y) + (v[j].z * v[j].z + v[j].w * v[j].w); }
    const float rstd = rsqrtf(wave_sum(s) * (1.f / DMODEL) + NORM_EPS);
    unsigned long long* o8 = (unsigned long long*)orow + lane;
#pragma unroll
    for (int j = 0; j < 4; ++j) { const f32x4v gg = ((const f32x4v*)g)[lane + 64 * j], sh = ((const f32x4v*)shift)[lane + 64 * j], sc = ((const f32x4v*)scale)[lane + 64 * j];
        const f32x4v y = v[j] * rstd * gg * (sc + 1.0f) + sh;
        o8[64 * j] = (unsigned long long)pk2(y.x, y.y) | ((unsigned long long)pk2(y.z, y.w) << 32); }
}

__device__ __forceinline__ void norm_phase(const float* xl, const float* xc, const float* g, const float* mod, int shoff, int scoff, bf16_t* XN, int mrows, int gw, int NGW, int lane) {
    for (int m = gw; m < mrows; m += NGW) {
        const bool lat = m < ML; const int bidx = lat ? (m >> 12) : 8;
        const float* xrow = lat ? xl + (size_t)m * DMODEL : xc + (size_t)(m - ML) * DMODEL;
        norm_row(xrow, g, mod + (size_t)bidx * MODW + shoff, mod + (size_t)bidx * MODW + scoff, XN + (size_t)m * DMODEL, lane);
    }
}

__device__ __forceinline__ void prep0_phase(const float* xl, const float* xc, const float* g, const float* mod, bf16_t* XN, float* RSS, int gw, int NGW, int lane) {
    for (int m0 = gw; m0 < MT; m0 += 2 * NGW) {
        const int m1 = (m0 + NGW < MT) ? m0 + NGW : m0;
        const int ms[2] = {m0, m1}; f32x4v v[2][4];
#pragma unroll
        for (int q = 0; q < 2; ++q) { const int m = ms[q]; const float* xrow = (m < ML) ? xl + (size_t)m * DMODEL : xc + (size_t)(m - ML) * DMODEL;
#pragma unroll
            for (int j = 0; j < 4; ++j) v[q][j] = ((const f32x4v*)xrow)[lane + 64 * j]; }
#pragma unroll
        for (int q = 0; q < 2; ++q) { const int m = ms[q]; if (q == 1 && m1 == m0) break;
            const int bidx = (m < ML) ? (m >> 12) : 8; const f32x4v* sc = (const f32x4v*)(mod + (size_t)bidx * MODW + DMODEL);
            unsigned long long* o8 = (unsigned long long*)(XN + (size_t)m * DMODEL) + lane; float s = 0.f;
#pragma unroll
            for (int j = 0; j < 4; ++j) { const f32x4v x = v[q][j]; s += (x.x * x.x + x.y * x.y) + (x.z * x.z + x.w * x.w);
                const f32x4v y = x * ((const f32x4v*)g)[lane + 64 * j] * (sc[lane + 64 * j] + 1.0f);
                o8[64 * j] = (unsigned long long)pk2(y.x, y.y) | ((unsigned long long)pk2(y.z, y.w) << 32); }
            const float tot = wave_sum(s);
            if (lane < 4) RSS[(size_t)lane * MT + m] = (lane == 0) ? tot : 0.f; }
    }
}

__device__ __forceinline__ void cvec_phase(const bf16_t* Win_t, const bf16_t* Wfi_t, const float* MOD, float* CVI, float* CVF, LAS unsigned char* lds, int bx, int G, int tid, int wid, int lane) {
    LAS float* sh = (LAS float*)lds;
    for (int l = 0; l < NLAY; ++l) {
        __syncthreads();
        for (int i = tid; i < 2 * 9 * 1024; i += 512) { const int which = i / 9216, rem = i % 9216, b = rem >> 10, k = rem & 1023; sh[i] = MOD[((size_t)l * 9 + b) * MODW + (which ? 3 * DMODEL : 0) + k]; }
        __syncthreads();
        for (int row = bx * 8 + wid; row < INC + 2 * FFH; row += G * 8) {
            const int which = row >= INC, n = which ? row - INC : row;
            const bf16_t* wrow = which ? Wfi_t + ((size_t)l * 2 * FFH + n) * DMODEL : Win_t + ((size_t)l * INC + n) * DMODEL;
            const v4u w0 = *(const v4u*)(wrow + lane * 8), w1 = *(const v4u*)(wrow + 512 + lane * 8);
            float wf[16];
            wf[0] = __builtin_bit_cast(float, w0.x << 16); wf[1] = __builtin_bit_cast(float, w0.x & 0xffff0000u); wf[2] = __builtin_bit_cast(float, w0.y << 16); wf[3] = __builtin_bit_cast(float, w0.y & 0xffff0000u);
            wf[4] = __builtin_bit_cast(float, w0.z << 16); wf[5] = __builtin_bit_cast(float, w0.z & 0xffff0000u); wf[6] = __builtin_bit_cast(float, w0.w << 16); wf[7] = __builtin_bit_cast(float, w0.w & 0xffff0000u);
            wf[8] = __builtin_bit_cast(float, w1.x << 16); wf[9] = __builtin_bit_cast(float, w1.x & 0xffff0000u); wf[10] = __builtin_bit_cast(float, w1.y << 16); wf[11] = __builtin_bit_cast(float, w1.y & 0xffff0000u);
            wf[12] = __builtin_bit_cast(float, w1.z << 16); wf[13] = __builtin_bit_cast(float, w1.z & 0xffff0000u); wf[14] = __builtin_bit_cast(float, w1.w << 16); wf[15] = __builtin_bit_cast(float, w1.w & 0xffff0000u);
            float mine = 0.f;
            for (int b = 0; b < 9; ++b) { const LAS float* p = sh + (which * 9 + b) * 1024 + lane * 8; float sacc = 0.f;
#pragma unroll
                for (int i = 0; i < 8; ++i) sacc += wf[i] * p[i] + wf[8 + i] * p[512 + i];
                sacc = wave_sum(sacc); if (lane == b) mine = sacc; }
            if (lane < 9) { if (which) CVF[((size_t)l * 9 + lane) * (2 * FFH) + n] = mine; else CVI[((size_t)l * 9 + lane) * INC + n] = mine; }
        }
    }
    __syncthreads();
}

__device__ __forceinline__ void fbuild_phase(const bf16_t* Hf, bf16_t* F, int gtid, int gthreads) {
    for (int idx = gtid; idx < 256 * 1024; idx += gthreads) {
        const int c = idx >> 10, qi = idx & 1023, B = 8 * (qi - 512) + 4088;
        const bf16_t* h = Hf + (size_t)c * 8192;
        v4u lo = (v4u){0u, 0u, 0u, 0u}, hi;
        if (B >= 0) lo = *(const v4u*)(h + B);
        hi = *(const v4u*)(h + B + 8);
        if (B == 0) lo.x &= 0xffff0000u;
        if (B == -8) hi.x &= 0xffff0000u;
        const unsigned d[8] = {lo.x, lo.y, lo.z, lo.w, hi.x, hi.y, hi.z, hi.w};
#pragma unroll
        for (int r = 0; r < 8; ++r) { unsigned o[4];
#pragma unroll
            for (int j = 0; j < 4; ++j) { const int e0 = r + 8 - 2 * j, e1 = e0 - 1;
                const unsigned a = (d[e0 >> 1] >> (16 * (e0 & 1))) & 0xffffu, b = (d[e1 >> 1] >> (16 * (e1 & 1))) & 0xffffu; o[j] = a | (b << 16); }
            *(v4u*)(F + (((size_t)(c * 8 + r)) * 1024 + qi) * 8) = (v4u){o[0], o[1], o[2], o[3]}; }
    }
}

__device__ __forceinline__ void filter_rows(const KArgs& a, bf16_t* Hf, float* Hc, int gw, int NGW, int lane) {
    constexpr int R = 8;
    for (int it = gw; it < NLAY * (SEQ + CTX) / R; it += NGW) {
        const int l = it / ((SEQ + CTX) / R), rr = (it % ((SEQ + CTX) / R)) * R; const bool isc = rr >= SEQ; const int t0 = isc ? rr - SEQ : rr, L = isc ? CTX : SEQ;
        float tn[R], z[R], h[R], s[R];
#pragma unroll
        for (int r = 0; r < R; ++r) { const int t = t0 + r; tn[r] = (float)t / (float)(L - 1); const float w = 6.283185307179586f * (float)t / (float)L;
            z[r] = 0.f;
            if (lane == 0) z[r] = tn[r];
            else if (lane <= 16) { const float fr = 1e-4f + (float)(lane - 1) * ((15.0f - 1e-4f) / 15.0f); z[r] = cosf(fr * w); }
            else if (lane <= 32) { const float fr = 1e-4f + (float)(lane - 17) * ((15.0f - 1e-4f) / 15.0f); z[r] = -sinf(fr * w); } }
        const float* w1 = a.in[12] + (size_t)l * 33 * 64; const float* w2 = a.in[14] + (size_t)l * 64 * 64; const float* w3 = a.in[16] + (size_t)l * 64 * 64; const float* wo = a.in[18] + (size_t)l * 64 * 512;
        const float om = a.in[19][l * 64 + lane];
#pragma unroll
        for (int r = 0; r < R; ++r) s[r] = a.in[13][l * 64 + lane];
#pragma unroll 3
        for (int k = 0; k < 33; ++k) { const float wv = w1[k * 64 + lane];
#pragma unroll
            for (int r = 0; r < R; ++r) s[r] += __shfl(z[r], k) * wv; }
#pragma unroll
        for (int r = 0; r < R; ++r) { h[r] = sinf(om * s[r]); s[r] = a.in[15][l * 64 + lane]; }
#pragma unroll 4
        for (int k = 0; k < 64; ++k) { const float wv = w2[k * 64 + lane];
#pragma unroll
            for (int r = 0; r < R; ++r) s[r] += __shfl(h[r], k) * wv; }
#pragma unroll
        for (int r = 0; r < R; ++r) { h[r] = sinf(om * s[r]); s[r] = a.in[17][l * 64 + lane]; }
#pragma unroll 4
        for (int k = 0; k < 64; ++k) { const float wv = w3[k * 64 + lane];
#pragma unroll
            for (int r = 0; r < R; ++r) s[r] += __shfl(h[r], k) * wv; }
#pragma unroll
        for (int r = 0; r < R; ++r) h[r] = sinf(om * s[r]);
        float o[R][8];
#pragma unroll
        for (int r = 0; r < R; ++r)
#pragma unroll
            for (int i = 0; i < 8; ++i) o[r][i] = 0.f;
#pragma unroll 2
        for (int k = 0; k < 64; ++k) { float hk[R];
#pragma unroll
            for (int r = 0; r < R; ++r) hk[r] = __shfl(h[r], k);
#pragma unroll
            for (int i = 0; i < 8; ++i) { const float wv = wo[k * 512 + lane + 64 * i];
#pragma unroll
                for (int r = 0; r < R; ++r) o[r][i] += hk[r] * wv; } }
        const float d0 = -4.605170185988091f / 1.5f, d1 = -4.605170185988091f / 0.3f;
#pragma unroll
        for (int i = 0; i < 8; ++i) { const int n = lane + 64 * i, c = n & 255; const bool bwd = n >= 256;
            const float delta = d0 + (float)c * ((d1 - d0) / 255.0f);
#pragma unroll
            for (int r = 0; r < R; ++r) { const int t = t0 + r; const float val = o[r][i] * expf(-tn[r] * fabsf(delta));
                if (!bwd || t > 0) { if (isc) Hc[((size_t)l * 256 + c) * 512 + 256 + (bwd ? -t : t)] = val; else Hf[((size_t)l * 256 + c) * 8192 + 4096 + (bwd ? -t : t)] = (bf16_t)f2bf((t == 0) ? val + a.in[20][l * 256 + c] : val); } } }
    }
}

__device__ __forceinline__ void mod_phase(const KArgs& a, float* MOD, LAS unsigned char* lds, int bx, int G, int tid, int wid, int lane) {
    LAS float* sc = (LAS float*)lds;
    LAS float* red = (LAS float*)(lds + 9 * 1024 * 4);
    for (int i = tid; i < 9 * 1024; i += 512) { const float x = (i < 8 * 1024) ? a.in[1][i] : a.in[3][i - 8 * 1024]; sc[i] = x / (1.0f + __expf(-x)); }
    __syncthreads();
    for (int u = bx; u < NLAY * (MODW / 64); u += G) {
        const int l = u / (MODW / 64), n0 = (u % (MODW / 64)) * 64;
        const float* W = a.in[4] + (size_t)l * DMODEL * MODW + n0 + lane;
        float acc[9];
#pragma unroll
        for (int j = 0; j < 9; ++j) acc[j] = 0.f;
        for (int k = wid * 128; k < wid * 128 + 128; ++k) { const float wv = W[(size_t)k * MODW];
#pragma unroll
            for (int j = 0; j < 9; ++j) acc[j] += sc[j * 1024 + k] * wv; }
#pragma unroll
        for (int j = 0; j < 9; ++j) red[(wid * 9 + j) * 64 + lane] = acc[j];
        __syncthreads();
        for (int i = tid; i < 9 * 64; i += 512) { const int j = i >> 6, c = i & 63; float s = a.in[5][(size_t)l * MODW + n0 + c];
#pragma unroll
            for (int w = 0; w < 8; ++w) s += red[(w * 9 + j) * 64 + c];
            MOD[((size_t)l * 9 + j) * MODW + n0 + c] = s; }
        __syncthreads();
    }
}

__device__ __forceinline__ void hy_prep_unit(const bf16_t* P, const float* cw, const float* cb, bf16_t* UT, bf16_t* X2T, int b, int s0, int c0, LAS unsigned char* lds, int tid) {
    LAS float* in = (LAS float*)lds;
    v4u rawv[4];
#pragma unroll
    for (int q = 0; q < 4; ++q) { const int idx = tid + 512 * q; rawv[q] = (v4u){0u, 0u, 0u, 0u};
        if (idx < 3 * 66 * 8) { const int sec = idx / (66 * 8), rem = idx % (66 * 8), rr = rem >> 3, ch = rem & 7, s = s0 - 1 + rr;
            if (s >= 0 && s < SEQ) rawv[q] = *(const v4u*)(P + (size_t)(b * SEQ + s) * INC + sec * 256 + c0 + ch * 8); } }
#pragma unroll
    for (int q = 0; q < 4; ++q) { const int idx = tid + 512 * q;
        if (idx < 3 * 66 * 8) { const int sec = idx / (66 * 8), rem = idx % (66 * 8), rr = rem >> 3, ch = rem & 7; const v4u raw = rawv[q];
        LAS float* d = in + (sec * 66 + rr) * 65 + ch * 8;
        d[0] = __builtin_bit_cast(float, raw.x << 16); d[1] = __builtin_bit_cast(float, raw.x & 0xffff0000u);
        d[2] = __builtin_bit_cast(float, raw.y << 16); d[3] = __builtin_bit_cast(float, raw.y & 0xffff0000u);
        d[4] = __builtin_bit_cast(float, raw.z << 16); d[5] = __builtin_bit_cast(float, raw.z & 0xffff0000u);
        d[6] = __builtin_bit_cast(float, raw.w << 16); d[7] = __builtin_bit_cast(float, raw.w & 0xffff0000u); } }
    __syncthreads();
    {
        const int c = tid >> 3, k = tid & 7;
        float w[3][3], bb[3];
#pragma unroll
        for (int sec = 0; sec < 3; ++sec) { bb[sec] = cb[sec * 256 + c0 + c];
#pragma unroll
            for (int i = 0; i < 3; ++i) w[sec][i] = cw[i * 768 + sec * 256 + c0 + c]; }
        float vv[8], x2[8];
#pragma unroll
        for (int i = 0; i < 8; ++i) { const int rr = k * 8 + i; float cv[3];
#pragma unroll
            for (int sec = 0; sec < 3; ++sec) { const LAS float* p = in + (sec * 66 + rr) * 65 + c; cv[sec] = w[sec][0] * p[0] + w[sec][1] * p[65] + w[sec][2] * p[130] + bb[sec]; }
            vv[i] = cv[0] * cv[1]; x2[i] = cv[2]; }
        const size_t o = ((size_t)(b * 256 + c0 + c)) * SEQ + s0 + k * 8;
        v4u a; a.x = pk2(vv[0], vv[1]); a.y = pk2(vv[2], vv[3]); a.z = pk2(vv[4], vv[5]); a.w = pk2(vv[6], vv[7]); *(v4u*)(UT + o) = a;
        v4u d; d.x = pk2(x2[0], x2[1]); d.y = pk2(x2[2], x2[3]); d.z = pk2(x2[4], x2[5]); d.w = pk2(x2[6], x2[7]); *(v4u*)(X2T + o) = d;
    }
    __syncthreads();
}

constexpr int HY_PB = 5904;
__device__ __forceinline__ void hy_conv_unit(const bf16_t* UT, const bf16_t* F, bf16_t* YT, int c, LAS unsigned char* lds, int tid, int wid, int lane) {
    LAS bf16_t* U = (LAS bf16_t*)lds;
    { const unsigned z = (unsigned)opq(0);
      for (int i = tid; i < NB * HY_PB / 8; i += 512) ((LAS v4u*)U)[i] = (v4u){z, z, z, z}; }
    __syncthreads();
    { v4u rawu[8];
#pragma unroll
      for (int q = 0; q < 8; ++q) { const int i = tid + 512 * q, b = i >> 9, s = (i & 511) * 8; rawu[q] = *(const v4u*)(UT + ((size_t)(b * 256 + c)) * SEQ + s); }
#pragma unroll
      for (int q = 0; q < 8; ++q) { const int i = tid + 512 * q, b = i >> 9, s = (i & 511) * 8, sp = s + 768; *(LAS v4u*)(U + b * HY_PB + sp + 8 * (sp >> 8)) = rawu[q]; } }
    __syncthreads();
    const int rp = wid & 3, gh = wid >> 2, mp = lane & 31, g = lane >> 5, bq = lane & 7, isub = (lane >> 3) & 3;
    const bf16x8v* F0 = (const bf16x8v*)F + ((size_t)(c * 8 + 2 * rp)) * 1024; const bf16x8v* F1 = F0 + 1024;
    f32x16 acc[2][2];
#pragma unroll
    for (int i = 0; i < 2; ++i)
#pragma unroll
        for (int j = 0; j < 2; ++j)
#pragma unroll
            for (int r = 0; r < 16; ++r) acc[i][j][r] = 0.f;
    const int G0 = 2 * gh, jlo = 64 * G0 - 255, jhi = 64 * (G0 + 1) + 48;
    const LAS bf16_t* Ub = U + bq * HY_PB;
    constexpr int PF = 4;
    bf16x8v a0b[PF], a1b[PF];
    const int qbase = mp - g + 512;
#pragma unroll
    for (int p = 0; p < PF; ++p) { a0b[p] = F0[2 * (jlo + p) + qbase]; a1b[p] = F1[2 * (jlo + p) + qbase]; }
#define HY_STEP(D0, D1) do { const int j = j0 + p; const bf16x8v a0 = a0b[p], a1 = a1b[p]; \
        { int jn = j + PF; jn = jn > jhi ? jhi : jn; a0b[p] = F0[2 * jn + qbase]; a1b[p] = F1[2 * jn + qbase]; } \
        if (D0) { const int sp = 256 * (4 * G0 + isub) + 8 * g + 768 - 16 * j; const bf16x8v bf = *(const LAS bf16x8v*)(Ub + sp + 8 * (sp >> 8)); \
            acc[0][0] = __builtin_amdgcn_mfma_f32_32x32x16_bf16(a0, bf, acc[0][0], 0, 0, 0); acc[1][0] = __builtin_amdgcn_mfma_f32_32x32x16_bf16(a1, bf, acc[1][0], 0, 0, 0); } \
        if (D1) { const int sp = 256 * (4 * (G0 + 1) + isub) + 8 * g + 768 - 16 * j; const bf16x8v bf = *(const LAS bf16x8v*)(Ub + sp + 8 * (sp >> 8)); \
            acc[0][1] = __builtin_amdgcn_mfma_f32_32x32x16_bf16(a0, bf, acc[0][1], 0, 0, 0); acc[1][1] = __builtin_amdgcn_mfma_f32_32x32x16_bf16(a1, bf, acc[1][1], 0, 0, 0); } } while (0)
    for (int j0 = jlo; j0 < jlo + 64; j0 += PF) {
#pragma unroll
        for (int p = 0; p < PF; ++p) HY_STEP(true, false); }
    for (int j0 = jlo + 64; j0 <= jhi - 64; j0 += PF) {
#pragma unroll
        for (int p = 0; p < PF; ++p) HY_STEP(true, true); }
    for (int j0 = jhi - 63; j0 <= jhi; j0 += PF) {
#pragma unroll
        for (int p = 0; p < PF; ++p) HY_STEP(false, true); }
#undef HY_STEP
    __syncthreads();
    LAS bf16_t* Y = (LAS bf16_t*)lds;
    for (int re_ = 0; re_ < PR_HYEPI; ++re_) {
#pragma unroll
    for (int ri = 0; ri < 2; ++ri)
#pragma unroll
        for (int gi = 0; gi < 2; ++gi) { const int r = 2 * rp + ri, I = 4 * (G0 + gi) + isub;
#pragma unroll
            for (int reg = 0; reg < 16; ++reg) { const int m = (reg & 3) + 8 * (reg >> 2) + 4 * g, t = 256 * I + 8 * m + r;
                Y[bq * (SEQ + 136) + t + 8 * I] = (bf16_t)f2bf(acc[ri][gi][reg]); } }
    __syncthreads();
    for (int i = tid; i < NB * SEQ / 8; i += 512) { const int b = i >> 9, t = (i & 511) * 8;
        *(v4u*)(YT + ((size_t)(b * 256 + c)) * SEQ + t) = *(const LAS v4u*)(Y + b * (SEQ + 136) + t + 8 * (t >> 8)); }
    }
    __syncthreads();
}

__device__ __forceinline__ void hy_post_unit(const bf16_t* YT, const bf16_t* X2T, bf16_t* MIX, int b, int t0, LAS unsigned char* lds, int tid) {
    LAS bf16_t* T = (LAS bf16_t*)lds;
    v4u yv[4], xv[4];
#pragma unroll
    for (int k = 0; k < 4; ++k) { const int idx = tid + 512 * k, c = idx >> 3, ch = idx & 7; const size_t o = ((size_t)(b * 256 + c)) * SEQ + t0 + ch * 8; yv[k] = *(const v4u*)(YT + o); xv[k] = *(const v4u*)(X2T + o); }
#pragma unroll
    for (int k = 0; k < 4; ++k) { const int idx = tid + 512 * k, c = idx >> 3, ch = idx & 7;
        const v4u y = yv[k], x = xv[k];
        const unsigned yy[4] = {y.x, y.y, y.z, y.w}, xx[4] = {x.x, x.y, x.z, x.w};
#pragma unroll
        for (int e = 0; e < 4; ++e) { const float lo = __builtin_bit_cast(float, yy[e] << 16) * __builtin_bit_cast(float, xx[e] << 16), hi = __builtin_bit_cast(float, yy[e] & 0xffff0000u) * __builtin_bit_cast(float, xx[e] & 0xffff0000u);
            T[(ch * 8 + 2 * e) * 260 + c] = (bf16_t)f2bf(lo); T[(ch * 8 + 2 * e + 1) * 260 + c] = (bf16_t)f2bf(hi); } }
    __syncthreads();
#pragma unroll
    for (int k = 0; k < 4; ++k) { const int idx = tid + 512 * k, t = idx >> 5, ch = idx & 31;
        const LAS v2u* p = (const LAS v2u*)(T + t * 260 + ch * 8); const v2u a = p[0], d = p[1];
        *(v4u*)(MIX + (size_t)(b * SEQ + t0 + t) * DMODEL + ch * 8) = (v4u){a.x, a.y, d.x, d.y}; }
    __syncthreads();
}

__device__ __forceinline__ void hy_ctx_unit(const bf16_t* P, const float* cw, const float* cb, const float* Hc, const float* skip, bf16_t* MIX, int b, int c0, LAS unsigned char* lds, int tid) {
    LAS float* vv = (LAS float*)lds;
    LAS float* fc = vv + 256 * 17;
    const int c = tid & 15, tq = tid >> 4;
    const bf16_t* Pb = P + (size_t)(ML + b * CTX) * INC;
    float w[3][3], bb[3];
#pragma unroll
    for (int sec = 0; sec < 3; ++sec) { bb[sec] = cb[sec * 256 + c0 + c];
#pragma unroll
        for (int i = 0; i < 3; ++i) w[sec][i] = cw[i * 768 + sec * 256 + c0 + c]; }
#pragma unroll 2
    for (int i = 0; i < 8; ++i) { const int s = tq + 32 * i; float cv[2];
#pragma unroll
        for (int sec = 0; sec < 2; ++sec) { float x = bb[sec];
#pragma unroll
            for (int k = 0; k < 3; ++k) { const int ss = s - 1 + k; if (ss >= 0 && ss < CTX) x += w[sec][k] * bf2f(Pb[(size_t)ss * INC + sec * 256 + c0 + c]); }
            cv[sec] = x; }
        vv[s * 17 + c] = cv[0] * cv[1]; }
    for (int i = tid; i < 16 * 512; i += 512) { const int cc = i >> 9, id = i & 511; float x = (id >= 1) ? Hc[(size_t)(c0 + cc) * 512 + id] : 0.f; if (id == 256) x += skip[c0 + cc]; fc[cc * 513 + id] = x; }
    __syncthreads();
    float acc[8];
#pragma unroll
    for (int i = 0; i < 8; ++i) acc[i] = 0.f;
    const LAS float* fcc = fc + c * 513 + 256 + tq;
    for (int s = 0; s < CTX; ++s) { const float v = vv[s * 17 + c];
#pragma unroll
        for (int i = 0; i < 8; ++i) acc[i] += v * fcc[32 * i - s]; }
#pragma unroll 2
    for (int i = 0; i < 8; ++i) { const int t = tq + 32 * i; float x = bb[2];
#pragma unroll
        for (int k = 0; k < 3; ++k) { const int ss = t - 1 + k; if (ss >= 0 && ss < CTX) x += w[2][k] * bf2f(Pb[(size_t)ss * INC + 512 + c0 + c]); }
        MIX[(size_t)(ML + b * CTX + t) * DMODEL + c0 + c] = (bf16_t)f2bf(x * acc[i]); }
    __syncthreads();
}

__global__ void __launch_bounds__(512, 2) hybrid_fwd(KArgs a) {
    extern __shared__ __attribute__((aligned(16))) unsigned char lds_raw[];
    LAS unsigned char* lds = (LAS unsigned char*)lds_raw;
    cg::grid_group grid = cg::this_grid();
    const int tid = threadIdx.x, lane = tid & 63, wid = __builtin_amdgcn_readfirstlane(tid >> 6);
    const int G = gridDim.x, bx = blockIdx.x, gw = bx * 8 + wid, NGW = G * 8, gtid = bx * 512 + tid, gthreads = G * 512;
    unsigned char* ws = a.ws;
    bf16_t* Win_t = (bf16_t*)(ws + WS_WIN); bf16_t* Wout_t = (bf16_t*)(ws + WS_WOUT); bf16_t* Wfi_t = (bf16_t*)(ws + WS_WFI); bf16_t* Wfo_t = (bf16_t*)(ws + WS_WFO);
    float* MOD = (float*)(ws + WS_MOD); float* ROPE = (float*)(ws + WS_ROPE); bf16_t* Hf = (bf16_t*)(ws + WS_HF); float* Hc = (float*)(ws + WS_HC);
    bf16_t* F = (bf16_t*)(ws + WS_F); bf16_t* XN = (bf16_t*)(ws + WS_XN); bf16_t* P = (bf16_t*)(ws + WS_P); bf16_t* MIX = (bf16_t*)(ws + WS_MIX); bf16_t* ACT = (bf16_t*)(ws + WS_P);
    float* XC = (float*)(ws + WS_XC); bf16_t* UT = (bf16_t*)(ws + WS_UT); bf16_t* X2T = (bf16_t*)(ws + WS_X2T); bf16_t* YT = (bf16_t*)(ws + WS_YT);
    float* XL = a.out;
    float* RSS = (float*)(ws + WS_RSS); float* CVI = (float*)(ws + WS_CVI); float* CVF = (float*)(ws + WS_CVF);
    volatile LAS unsigned* xst = (volatile LAS unsigned*)(lds + LDS_BYTES - 64);
    if (tid < 16) xst[tid] = 0u;
    __syncthreads();
    XcdBarrier xbar = xcd_barrier_post((unsigned*)(ws + WS_CTL), xst);

    for (int rp0_ = 0; rp0_ < PR_P0; ++rp0_) {
        LAS float* scr = (LAS float*)(lds + 65536 + wid * 8704);
        constexpr int I_IN = (DMODEL / 64) * (INC / 32), I_OUT = (DMODEL / 64) * (DMODEL / 32), I_FI = (DMODEL / 64) * (2 * FFH / 32), I_FO = (FFH / 64) * (DMODEL / 32);
        constexpr int I_L = I_IN + I_OUT + I_FI + I_FO;
        for (int it = gw; it < NLAY * I_L; it += NGW) {
            const int l = it / I_L; int r = it % I_L;
            if (r < I_IN) { const int nblk = INC / 32, kb = r / nblk, n0 = (r % nblk) * 32; const int pn = n0 >> 8, wc = (n0 & 255) >> 6, bj = (n0 & 63) >> 5;
                transpose_item(a.in[8] + (size_t)l * DMODEL * INC, INC, DMODEL, Win_t + (size_t)l * INC * DMODEL, kb * 64, n0, pn * 256 + bj * 128 + wc * 32, scr, lane); continue; }
            r -= I_IN;
            if (r < I_OUT) { const int nblk = DMODEL / 32, kb = r / nblk, n0 = (r % nblk) * 32;
                transpose_item(a.in[9] + (size_t)l * DMODEL * DMODEL, DMODEL, DMODEL, Wout_t + (size_t)l * DMODEL * DMODEL, kb * 64, n0, n0, scr, lane); continue; }
            r -= I_OUT;
            if (r < I_FI) { const int nblk = 2 * FFH / 32, kb = r / nblk, n0 = (r % nblk) * 32; const int half = n0 / FFH, idx = n0 % FFH, pn = idx >> 7, jj = idx & 127;
                transpose_item(a.in[24] + (size_t)l * DMODEL * 2 * FFH, 2 * FFH, DMODEL, Wfi_t + (size_t)l * 2 * FFH * DMODEL, kb * 64, n0, pn * 256 + half * 128 + jj, scr, lane); continue; }
            r -= I_FI;
            { const int nblk = DMODEL / 32, kb = r / nblk, n0 = (r % nblk) * 32;
                transpose_item(a.in[25] + (size_t)l * FFH * DMODEL, DMODEL, FFH, Wfo_t + (size_t)l * DMODEL * FFH, kb * 64, n0, n0, scr, lane); }
        }
        __syncthreads();
        mod_phase(a, MOD, lds, bx, G, opq(tid), wid, opq(lane));
        filter_rows(a, Hf, Hc, gw, NGW, opq(lane));
        for (int i = gtid; i < 64 * 16; i += gthreads) { const int pos = i >> 4, f = i & 15; const float inv = powf(10000.0f, -(float)f / 16.0f), ang = (float)pos * inv; ROPE[2 * i] = cosf(ang); ROPE[2 * i + 1] = sinf(ang); }
    }
    grid.sync();
    prep0_phase(a.in[0], a.in[2], a.in[6], MOD, XN, RSS, gw, NGW, opq(lane));
    fbuild_phase(Hf, F, opq(gtid), gthreads);
    cvec_phase(Win_t, Wfi_t, MOD, CVI, CVF, lds, bx, G, opq(tid), wid, opq(lane));
    GSYNC();

#pragma nounroll
    for (int l = 0; l < NLAY; ++l) {
        const bool last = (l == NLAY - 1);
        const float* modl = MOD + (size_t)l * 9 * MODW;
        const float* xl_in = (l == 0) ? a.in[0] : XL; const float* xc_in = (l == 0) ? a.in[2] : XC;
        { pg8::Gemm g{XN, Win_t + (size_t)l * INC * DMODEL, MT, INC, DMODEL}; pg8::StaticOrder S; S.init(MT, INC, G, bx);
          pg8::EpiInProj E{P, a.in[21] + l * 64, a.in[22] + l * 64, ROPE, RSS, CVI + (size_t)l * 9 * INC};
          pg8::gemm_phase<pg8::EpiInProj, pg8::StaticOrder, true, true>(lds, g, S, E); }
        GSYNC();
        {
            const attn_body::bf16* Pb = (const attn_body::bf16*)P; attn_body::bf16* Mb = (attn_body::bf16*)MIX;
            unsigned* cbase = (unsigned*)(ws + WS_CTL) + 4096 + 2048 * l;
            unsigned* ctrA = cbase; unsigned* ctrB = cbase + 64; unsigned* ctrC = cbase + 128; unsigned* cnt4c = cbase + 192; unsigned* cnt6c = cbase + 192 + 8 * 64; unsigned* tmo = (unsigned*)(ws + WS_CTL) + XB_TMO;
            float fixm;
            { const int ln_ = opq(lane); float mq = fabsf(a.in[21][l * 64 + ln_]), mk = fabsf(a.in[22][l * 64 + ln_]);
#pragma unroll
              for (int o_ = 1; o_ < 64; o_ <<= 1) { mq = fmaxf(mq, __shfl_xor(mq, o_)); mk = fmaxf(mk, __shfl_xor(mk, o_)); }
              fixm = fminf(64.0f * QSCALE * 1.015f * mq * mk, 60.0f); }
            const bf16_t* ACTCv = (const bf16_t*)(ws + WS_ACTC) - (size_t)ML * FFH;
            for (int u = bx; u < NB * 64 * 4; u += G) { const int b = u & 7, cgp = (u >> 3) & 3, sc = u >> 5;
                hy_prep_unit(P, a.in[10] + (size_t)l * 3 * 768, a.in[11] + (size_t)l * 768, UT, X2T, b, sc * 64, cgp * 64, lds, opq(tid)); }
            sb_arrive(ctrA, opq(tid));
            if (!last) { for (int vv_ = bx; vv_ < 256; vv_ += G) { const int v = (G == 256) ? (vv_ >= 240 ? vv_ - 240 : (vv_ < 208 ? vv_ + 16 : 1000)) : vv_; if (v >= 224) continue;
                if (v < 64) { const int b = v & 7, h = v >> 3, kvh = h >> 2;
                    attn_body::attn_unit<8, 2>(Pb + (size_t)(ML + b * CTX) * INC + 768 + h * 64, Pb + 1280 + kvh * 64, Pb + 1408 + kvh * 64,
                        Mb + (size_t)(ML + b * CTX) * DMODEL + 256 + h * 64, ML + b * CTX, 0, 0, 4, 0, 0, nullptr, (char*)lds_raw, fixm);
                } else if (v < 96) { const int w = v - 64, b = w & 7, h = w >> 3;
                    attn_body::attn_unit<8, 0>(Pb + (size_t)(ML + b * CTX) * INC + 1536 + h * 64, Pb + 1792 + h * 64, Pb + 2048 + h * 64,
                        Mb + (size_t)(ML + b * CTX) * DMODEL + 768 + h * 64, ML + b * CTX, 0, 0, 4, 0, 0, nullptr, (char*)lds_raw);
                } else { const int w = v - 96, b = w & 7, cgp = w >> 3;
                    hy_ctx_unit(P, a.in[10] + (size_t)l * 3 * 768, a.in[11] + (size_t)l * 768, Hc + (size_t)l * 256 * 512, a.in[20] + l * 256, MIX, b, cgp * 16, lds, opq(tid)); }
            }
              sb_arrive(ctrC, opq(tid)); }
#define GQA_UNIT(u) do { const int b = (u) & 7, idx = (u) >> 3, h = idx >> 4, qb = idx & 15, kvh = h >> 2; \
                attn_body::attn_unit<8, 2>(Pb + (size_t)(b * SEQ + qb * 256) * INC + 768 + h * 64, Pb + 1280 + kvh * 64, Pb + 1408 + kvh * 64, \
                    Mb + (size_t)(b * SEQ + qb * 256) * DMODEL + 256 + h * 64, ML + b * CTX, b * SEQ, 1 << 20, 68, 0, 0, nullptr, (char*)lds_raw, fixm); } while (0)
            for (int u = bx; u < 512; u += G) GQA_UNIT(u);
            if (!last) for (int v = bx; v < 32; v += G) { const int pb = v >> 2;
                sb_wait(ctrC, (unsigned)G, tmo, opq(tid));
                pg8::Gemm g{MIX, Wout_t + (size_t)l * DMODEL * DMODEL, MT, DMODEL, DMODEL}; pg8::OneUnit S{ML / 256 + pb, v & 3};
                pg8::EpiResid E{xl_in, xc_in, XL, XC, modl + 2 * DMODEL, XN, RSS, a.in[7] + l * DMODEL, modl + 4 * DMODEL, 1, (LAS float*)(lds + 131072)};
                pg8::gemm_phase<pg8::EpiResid, pg8::OneUnit, true, true>(lds, g, S, E);
                sb_arrive(cnt4c + 64 * pb, opq(tid)); }
            sb_wait(ctrA, (unsigned)G, tmo, opq(tid));
            for (int c = bx; c < 256; c += G) hy_conv_unit(UT, F, YT, c, lds, opq(tid), wid, opq(lane));
            sb_arrive(ctrB, opq(tid));
            if (!last) for (int v = bx; v < 208; v += G) if (v >= 32) { const int w = v - 32, pb = w / 22, pn = w % 22;
                sb_wait(cnt4c + 64 * pb, 4u, tmo, opq(tid));
                pg8::Gemm g{XN, Wfi_t + (size_t)l * 2 * FFH * DMODEL, MT, 2 * FFH, DMODEL}; pg8::OneUnit S{ML / 256 + pb, pn};
                pg8::EpiSwiglu E{(bf16_t*)ACTCv, RSS, CVF + (size_t)l * 9 * 2 * FFH};
                pg8::gemm_phase<pg8::EpiSwiglu, pg8::OneUnit, true, true>(lds, g, S, E);
                sb_arrive(cnt6c + 64 * pb, opq(tid)); }
            for (int u = 512 + bx; u < 1024; u += G) GQA_UNIT(u);
#undef GQA_UNIT
            const bool bal = (!last && G == 256);
            const int n_na = !bal ? ((512 - bx + G - 1) / G) : (bx >= 240 ? 4 : (bx >= 208 ? 1 : 2));
            for (int ii = 0; ii < n_na; ++ii) {
                const int v = !bal ? (bx + ii * G) : (ii < 2 ? bx + ii * 256 : 256 + 208 + 2 * (bx - 240) + (ii - 2));
                const int b = v & 7, idx = v >> 3, h = idx >> 4, qg = idx & 15;
                int r0 = 4 * qg - 4; r0 = r0 < 0 ? 0 : (r0 > 56 ? 56 : r0);
                LAS float* bias = (LAS float*)(lds + NA_BIAS_OFF);
                for (int i = opq(tid); i < 15 * 31; i += 512) bias[i] = a.in[23][((size_t)l * 4 + h) * 465 + i] * LOG2E;
                __syncthreads();
                attn_body::attn_unit<8, 1>(Pb + (size_t)(b * SEQ + qg * 256) * INC + 1536 + h * 64, Pb + 1792 + h * 64, Pb + 2048 + h * 64,
                    Mb + (size_t)(b * SEQ + qg * 256) * DMODEL + 768 + h * 64, ML + b * CTX, b * SEQ + r0 * 64, 63 - r0, 16, r0, 4 * qg, (const float*)(lds_raw + NA_BIAS_OFF), (char*)lds_raw);
            }
            if (!last) for (int v = bx; v < 240; v += G) if (v >= 208) { const int w = v - 208, pb = w >> 2;
                sb_wait(cnt6c + 64 * pb, 22u, tmo, opq(tid));
                pg8::Gemm g{ACTCv, Wfo_t + (size_t)l * DMODEL * FFH, MT, DMODEL, FFH}; pg8::OneUnit S{ML / 256 + pb, w & 3};
                pg8::EpiResid E{XL, XC, XL, XC, modl + 5 * DMODEL, XN, RSS, a.in[6] + (l + 1) * DMODEL, MOD + (size_t)(l + 1) * 9 * MODW + DMODEL, 1, (LAS float*)(lds + 131072)};
                pg8::gemm_phase<pg8::EpiResid, pg8::OneUnit, true, true>(lds, g, S, E); }
            sb_wait(ctrB, (unsigned)G, tmo, opq(tid));
            for (int u = bx; u < NB * 64; u += G) hy_post_unit(YT, X2T, MIX, u & 7, (u >> 3) * 64, lds, opq(tid));
        }
        GSYNC();
        const int mrows = ML;
        if (!last) fbuild_phase(Hf + (size_t)(l + 1) * 256 * 8192, F, opq(gtid), gthreads);
        { pg8::Gemm g{MIX, Wout_t + (size_t)l * DMODEL * DMODEL, mrows, DMODEL, DMODEL}; pg8::StaticOrder S; S.init(mrows, DMODEL, G, bx);
          pg8::EpiResid E{xl_in, xc_in, XL, XC, modl + 2 * DMODEL, XN, RSS, a.in[7] + l * DMODEL, modl + 4 * DMODEL, 1, (LAS float*)(lds + 131072)};
          pg8::gemm_phase<pg8::EpiResid, pg8::StaticOrder, true, true>(lds, g, S, E); }
        GSYNC();
        { pg8::Gemm g{XN, Wfi_t + (size_t)l * 2 * FFH * DMODEL, mrows, 2 * FFH, DMODEL}; pg8::StaticOrder S; S.init(mrows, 2 * FFH, G, bx);
          pg8::EpiSwiglu E{ACT, RSS, CVF + (size_t)l * 9 * 2 * FFH};
          for (int rf_ = 0; rf_ < PR_FFI; ++rf_) pg8::gemm_phase<pg8::EpiSwiglu, pg8::StaticOrder, true, true>(lds, g, S, E); }
        GSYNC();
        { pg8::Gemm g{ACT, Wfo_t + (size_t)l * DMODEL * FFH, mrows, DMODEL, FFH}; pg8::StaticOrder S; S.init(mrows, DMODEL, G, bx);
          pg8::EpiResid E{XL, XC, XL, XC, modl + 5 * DMODEL, XN, RSS, a.in[6] + (last ? l : l + 1) * DMODEL, MOD + (size_t)(last ? l : l + 1) * 9 * MODW + DMODEL, last ? 0 : 1, (LAS float*)(lds + 131072)};
          pg8::gemm_phase<pg8::EpiResid, pg8::StaticOrder, true, true>(lds, g, S, E); }
        GSYNC();
    }
    for (int m = gw; m < ML; m += NGW) { const int lane_o = opq(lane); f32x4v* xr = (f32x4v*)(XL + (size_t)m * DMODEL) + lane_o; f32x4v v[4]; float s = 0.f;
#pragma unroll
        for (int j = 0; j < 4; ++j) { v[j] = xr[64 * j]; s += (v[j].x * v[j].x + v[j].y * v[j].y) + (v[j].z * v[j].z + v[j].w * v[j].w); }
        const float rstd = rsqrtf(wave_sum(s) * (1.f / DMODEL) + NORM_EPS);
#pragma unroll
        for (int j = 0; j < 4; ++j) xr[64 * j] = v[j] * rstd * ((const f32x4v*)a.in[26])[lane_o + 64 * j]; }
}

extern "C" void kernel_launch(void* const* d_in, const int* in_sizes, int n_in, void* d_out, int out_size, void* d_ws, size_t ws_size, hipStream_t stream) {
    static int grid_blocks = 0;
    if (grid_blocks == 0) {
        if (n_in != 27 || ws_size < WS_END) { fprintf(stderr, "kernel_launch: expected 27 inputs and >= %zu bytes of workspace (got %d, %zu)\n", (size_t)WS_END, n_in, ws_size); grid_blocks = -1; return; }
        int dev = 0, cus = 0, per_cu = 0;
        hipGetDevice(&dev); hipDeviceGetAttribute(&cus, hipDeviceAttributeMultiprocessorCount, dev);
        hipFuncSetAttribute((const void*)hybrid_fwd, hipFuncAttributeMaxDynamicSharedMemorySize, LDS_BYTES);
        hipOccupancyMaxActiveBlocksPerMultiprocessor(&per_cu, (const void*)hybrid_fwd, 512, LDS_BYTES);
        if (per_cu < 1) per_cu = 1;
        grid_blocks = cus * per_cu;
        (void)hipGetLastError();
    }
    if (grid_blocks < 0) return;
    if (hipMemsetAsync((char*)d_ws + WS_CTL, 0, CTL_BYTES, stream) != hipSuccess) { fprintf(stderr, "kernel_launch: memset of the barrier words failed\n"); return; }
    KArgs a{};
    for (int i = 0; i < 27; ++i) a.in[i] = (const float*)d_in[i];
    a.out = (float*)d_out; a.ws = (unsigned char*)d_ws;
    void* args[] = {&a};
    hipError_t e = hipLaunchCooperativeKernel((const void*)hybrid_fwd, dim3(grid_blocks), dim3(512), args, LDS_BYTES, stream);
    if (e != hipSuccess) fprintf(stderr, "cooperative launch failed: %s (grid %d)\n", hipGetErrorString(e), grid_blocks);
}
```
